# Optimizing an MI355X kernel written in HIP

```python
import math
import jax, jax.numpy as jnp
from jax import lax
import numpy as np

D_MODEL = 1024
BATCH = 8
SEQ = 4096
DEPTH = 4

HEAD_DIM = 64
H_DIL = 6
H_MLA = 6
H_MOBA = 4
D_DIL = H_DIL * HEAD_DIM
MLA_NOPE = 64
MLA_ROPE = 32
MLA_V = 64
MLA_Q_LORA = 384
MLA_KV_LORA = 128
D_MLA = H_MLA * MLA_V
D_MOBA = H_MOBA * HEAD_DIM
D_MIX = D_DIL + D_MLA + D_MOBA
DILATED_PATTERNS = ((128, 1), (512, 4), (2048, 16))
MOBA_BLOCK = 256
MOBA_TOPK = 3
MOBA_QBLK = 64
DENSE_QBLK = 128
NUM_BUCKETS = 32
MAX_EXACT = 16
REL_MAX_DISTANCE = 2048
ROPE_THETA = 10000.0
D_FF = 4 * D_MODEL
EPS = 1e-6
SPLIT_SIZES = (D_DIL, D_DIL, D_DIL, MLA_Q_LORA, MLA_KV_LORA, MLA_ROPE, D_MOBA, D_MOBA, D_MOBA)
D_IN = D_DIL * 3 + MLA_Q_LORA + MLA_KV_LORA + MLA_ROPE + D_MOBA * 3

kernel_name = 'hybrid_dilated_mla_moba_block'


def rmsnorm(x, g):
    xf = x.astype(jnp.float32)
    y = xf * lax.rsqrt(jnp.mean(xf * xf, axis=-1, keepdims=True) + EPS)
    return (y * g.astype(jnp.float32)).astype(x.dtype)


def t5_bucket(dist):
    n = jnp.maximum(dist, 0)
    nf = jnp.maximum(n, 1).astype(jnp.float32)
    large = MAX_EXACT + (jnp.log(nf / MAX_EXACT) / math.log(REL_MAX_DISTANCE / MAX_EXACT)
                         * (NUM_BUCKETS - MAX_EXACT)).astype(jnp.int32)
    large = jnp.minimum(large, NUM_BUCKETS - 1)
    return jnp.where(n < MAX_EXACT, n, large)


def rope(x, cos, sin):
    half = x.shape[-1] // 2
    xf = x.astype(jnp.float32)
    x1, x2 = xf[..., :half], xf[..., half:]
    return jnp.concatenate([x1 * cos - x2 * sin, x2 * cos + x1 * sin], axis=-1).astype(x.dtype)


def banded_attention(q, k, v, bias, span):
    N, H, L, dh = q.shape
    nb = -(-L // span)
    pad = nb * span - L
    padw = ((0, 0), (0, 0), (0, pad), (0, 0))
    qb = jnp.pad(q, padw).reshape(N, H, nb, span, dh)
    kb = jnp.pad(k, padw).reshape(N, H, nb, span, dh)
    vb = jnp.pad(v, padw).reshape(N, H, nb, span, dh)
    shift = ((0, 0), (0, 0), (1, 0), (0, 0), (0, 0))
    kk = jnp.concatenate([jnp.pad(kb, shift)[:, :, :-1], kb], axis=3)
    vv = jnp.concatenate([jnp.pad(vb, shift)[:, :, :-1], vb], axis=3)
    s = jnp.einsum('nhiqd,nhikd->nhiqk', qb, kk).astype(jnp.float32) * (dh ** -0.5)
    s = s + bias[None, :, None].astype(jnp.float32)
    a = jnp.arange(span)[:, None]
    j = jnp.arange(2 * span)[None, :]
    diff = span + a - j
    in_band = (diff >= 0) & (diff <= span)
    has_prev = (jnp.arange(nb) > 0)[:, None, None] | (j >= span)[None]
    mask = in_band[None] & has_prev
    s = jnp.where(mask, s, -jnp.inf)
    lse = jax.nn.logsumexp(s, axis=-1)
    p = jnp.exp(s - lse[..., None]).astype(v.dtype)
    o = jnp.einsum('nhiqk,nhikd->nhiqd', p, vv).reshape(N, H, nb * span, dh)[:, :, :L]
    return o, lse.reshape(N, H, nb * span)[:, :, :L]


def dilated_mixture(q, k, v, bias_tab):
    B, S, H, dh = q.shape
    outs, lses = [], []
    for window, dil in DILATED_PATTERNS:
        L = S // dil
        span = window // dil

        def to_sub(t):
            return t.reshape(B, L, dil, H, dh).transpose(0, 2, 3, 1, 4).reshape(B * dil, H, L, dh)

        diff = span + jnp.arange(span)[:, None] - jnp.arange(2 * span)[None, :]
        bias = bias_tab[t5_bucket(diff * dil)].transpose(2, 0, 1)
        o, lse = banded_attention(to_sub(q), to_sub(k), to_sub(v), bias, span)
        outs.append(o.reshape(B, dil, H, L, dh).transpose(0, 3, 1, 2, 4).reshape(B, S, H, dh))
        lses.append(lse.reshape(B, dil, H, L).transpose(0, 3, 1, 2).reshape(B, S, H))
    wts = jax.nn.softmax(jnp.stack(lses), axis=0)
    out = jnp.sum(wts[..., None] * jnp.stack(outs).astype(jnp.float32), axis=0)
    return out.astype(q.dtype)


def causal_attention(q, k, v, scale):
    B, H, S, dq = q.shape
    nq = S // DENSE_QBLK
    qb = q.reshape(B, H, nq, DENSE_QBLK, dq).transpose(2, 0, 1, 3, 4)
    kpos = jnp.arange(S)

    def blk(args):
        qblk, i = args
        qpos = i * DENSE_QBLK + jnp.arange(DENSE_QBLK)
        s = jnp.einsum('bhqd,bhkd->bhqk', qblk, k).astype(jnp.float32) * scale
        s = jnp.where(kpos[None, :] <= qpos[:, None], s, -jnp.inf)
        p = jax.nn.softmax(s, axis=-1).astype(v.dtype)
        return jnp.einsum('bhqk,bhkd->bhqd', p, v)

    o = lax.map(blk, (qb, jnp.arange(nq)))
    return o.transpose(1, 2, 0, 3, 4).reshape(B, H, S, v.shape[-1])


def mla_attention(c_q, c_kv, k_r, g_q, g_kv, w_uq, w_ukv, cos, sin):
    B, S, _ = c_q.shape
    q = (rmsnorm(c_q, g_q) @ w_uq).reshape(B, S, H_MLA, MLA_NOPE + MLA_ROPE)
    q = jnp.concatenate([q[..., :MLA_NOPE], rope(q[..., MLA_NOPE:], cos, sin)], axis=-1)
    kv = (rmsnorm(c_kv, g_kv) @ w_ukv).reshape(B, S, H_MLA, MLA_NOPE + MLA_V)
    k_rope = jnp.broadcast_to(rope(k_r[:, :, None, :], cos, sin), (B, S, H_MLA, MLA_ROPE))
    k = jnp.concatenate([kv[..., :MLA_NOPE], k_rope], axis=-1)
    v = kv[..., MLA_NOPE:]
    o = causal_attention(q.transpose(0, 2, 1, 3), k.transpose(0, 2, 1, 3), v.transpose(0, 2, 1, 3),
                         (MLA_NOPE + MLA_ROPE) ** -0.5)
    return o.transpose(0, 2, 1, 3).reshape(B, S, D_MLA)


def moba_attention(q, k, v, bias_tab):
    B, H, S, dh = q.shape
    nblk = -(-S // MOBA_BLOCK)
    padw = ((0, 0), (0, 0), (0, nblk * MOBA_BLOCK - S), (0, 0))
    kb = jnp.pad(k, padw).reshape(B, H, nblk, MOBA_BLOCK, dh)
    vb = jnp.pad(v, padw).reshape(B, H, nblk, MOBA_BLOCK, dh)
    kmean = jnp.mean(kb.astype(jnp.float32), axis=3)
    topk = min(MOBA_TOPK, nblk)
    nq = S // MOBA_QBLK
    qc = q.reshape(B, H, nq, MOBA_QBLK, dh).transpose(2, 0, 1, 3, 4)
    bi = jnp.arange(B)[:, None, None, None]
    hi = jnp.arange(H)[None, :, None, None]
    hi5 = jnp.arange(H)[None, :, None, None, None]
    bias_h = bias_tab.T
    scale = dh ** -0.5
    offs = jnp.arange(MOBA_BLOCK)

    def blk(args):
        qblk, c = args
        q0 = c * MOBA_QBLK
        qpos = q0 + jnp.arange(MOBA_QBLK)
        j = q0 // MOBA_BLOCK
        gate = jnp.einsum('bhqd,bhnd->bhqn', qblk.astype(jnp.float32), kmean)
        gate = jnp.where(jnp.arange(nblk) < j, gate, -jnp.inf)
        gval, idx = lax.top_k(gate, topk)
        sel_ok = gval > -jnp.inf
        kg = kb[bi, hi, idx]
        vg = vb[bi, hi, idx]
        s_sel = jnp.einsum('bhqd,bhqnkd->bhqnk', qblk, kg).astype(jnp.float32) * scale
        kpos_sel = idx[..., None] * MOBA_BLOCK + offs
        s_sel = s_sel + bias_h[hi5, t5_bucket(qpos[None, None, :, None, None] - kpos_sel)].astype(jnp.float32)
        s_sel = jnp.where(sel_ok[..., None], s_sel, -jnp.inf).reshape(B, H, MOBA_QBLK, topk * MOBA_BLOCK)
        k_own = lax.dynamic_index_in_dim(kb, j, axis=2, keepdims=False)
        v_own = lax.dynamic_index_in_dim(vb, j, axis=2, keepdims=False)
        rel_own = qpos[:, None] - (j * MOBA_BLOCK + offs)[None, :]
        s_own = jnp.einsum('bhqd,bhkd->bhqk', qblk, k_own).astype(jnp.float32) * scale
        s_own = s_own + bias_h[:, t5_bucket(rel_own)][None].astype(jnp.float32)
        s_own = jnp.where(rel_own >= 0, s_own, -jnp.inf)
        p = jax.nn.softmax(jnp.concatenate([s_own, s_sel], axis=-1), axis=-1).astype(v.dtype)
        p_sel = p[..., MOBA_BLOCK:].reshape(B, H, MOBA_QBLK, topk, MOBA_BLOCK)
        return (jnp.einsum('bhqk,bhkd->bhqd', p[..., :MOBA_BLOCK], v_own)
                + jnp.einsum('bhqnk,bhqnkd->bhqd', p_sel, vg))

    o = lax.map(blk, (qc, jnp.arange(nq)))
    return o.transpose(1, 2, 0, 3, 4).reshape(B, H, S, dh)


def setup_inputs(seed: int = 0) -> dict:
    key = jax.random.key(seed)
    ks = jax.random.split(key, 14)
    nrm = jax.random.normal
    f32 = jnp.float32
    return {
        'x': nrm(ks[0], (BATCH, SEQ, D_MODEL), f32),
        'g_attn': 1.0 + 0.05 * nrm(ks[1], (DEPTH, D_MODEL), f32),
        'w_in': nrm(ks[2], (DEPTH, D_MODEL, D_IN), f32) * D_MODEL ** -0.5,
        'g_q_lora': 1.0 + 0.05 * nrm(ks[3], (DEPTH, MLA_Q_LORA), f32),
        'g_kv_lora': 1.0 + 0.05 * nrm(ks[4], (DEPTH, MLA_KV_LORA), f32),
        'w_uq': nrm(ks[5], (DEPTH, MLA_Q_LORA, H_MLA * (MLA_NOPE + MLA_ROPE)), f32) * MLA_Q_LORA ** -0.5,
        'w_ukv': nrm(ks[6], (DEPTH, MLA_KV_LORA, H_MLA * (MLA_NOPE + MLA_V)), f32) * MLA_KV_LORA ** -0.5,
        'rel_bias': 0.5 * nrm(ks[7], (NUM_BUCKETS, H_DIL + H_MOBA), f32),
        'g_mix': 1.0 + 0.05 * nrm(ks[8], (DEPTH, D_MIX), f32),
        'w_o': nrm(ks[9], (DEPTH, D_MIX, D_MODEL), f32) * D_MIX ** -0.5,
        'g_mlp': 1.0 + 0.05 * nrm(ks[10], (DEPTH, D_MODEL), f32),
        'w_up': nrm(ks[11], (DEPTH, D_MODEL, D_FF), f32) * D_MODEL ** -0.5,
        'w_down': nrm(ks[12], (DEPTH, D_FF, D_MODEL), f32) * D_FF ** -0.5,
        'g_final': 1.0 + 0.05 * nrm(ks[13], (D_MODEL,), f32),
    }


def reference(x, g_attn, w_in, g_q_lora, g_kv_lora, w_uq, w_ukv, rel_bias, g_mix, w_o, g_mlp,
              w_up, w_down, g_final):
    B, S, _ = x.shape
    inv_freq = ROPE_THETA ** (-jnp.arange(0, MLA_ROPE, 2, dtype=jnp.float32) / MLA_ROPE)
    ang = jnp.arange(S, dtype=jnp.float32)[:, None] * inv_freq[None, :]
    cos = jnp.cos(ang)[:, None, :]
    sin = jnp.sin(ang)[:, None, :]
    bias_dil = rel_bias[:, :H_DIL]
    bias_moba = rel_bias[:, H_DIL:]
    points = []
    acc = 0
    for size in SPLIT_SIZES[:-1]:
        acc += size
        points.append(acc)
    for l in range(DEPTH):
        h = rmsnorm(x, g_attn[l])
        proj = h @ w_in[l]
        q_a, k_a, v_a, c_q, c_kv, k_r, q_c, k_c, v_c = jnp.split(proj, points, axis=-1)
        o_a = dilated_mixture(q_a.reshape(B, S, H_DIL, HEAD_DIM), k_a.reshape(B, S, H_DIL, HEAD_DIM),
                              v_a.reshape(B, S, H_DIL, HEAD_DIM), bias_dil).reshape(B, S, D_DIL)
        o_b = mla_attention(c_q, c_kv, k_r, g_q_lora[l], g_kv_lora[l], w_uq[l], w_ukv[l], cos, sin)
        o_c = moba_attention(q_c.reshape(B, S, H_MOBA, HEAD_DIM).transpose(0, 2, 1, 3),
                             k_c.reshape(B, S, H_MOBA, HEAD_DIM).transpose(0, 2, 1, 3),
                             v_c.reshape(B, S, H_MOBA, HEAD_DIM).transpose(0, 2, 1, 3),
                             bias_moba).transpose(0, 2, 1, 3).reshape(B, S, D_MOBA)
        gm = g_mix[l]
        mixed = jnp.concatenate([rmsnorm(o_a, gm[:D_DIL]),
                                 rmsnorm(o_b, gm[D_DIL:D_DIL + D_MLA]),
                                 rmsnorm(o_c, gm[D_DIL + D_MLA:])], axis=-1)
        x = x + mixed @ w_o[l]
        h = rmsnorm(x, g_mlp[l])
        x = x + jnp.square(jax.nn.relu(h @ w_up[l])) @ w_down[l]
    return rmsnorm(x, g_final)
```

```cpp
#include <hip/hip_runtime.h>
#include <cstdio>
#include <cstdint>

#define LAS __attribute__((address_space(3)))
#define GAS __attribute__((address_space(1)))
typedef unsigned short bf16;
typedef short bf16x8 __attribute__((ext_vector_type(8)));
typedef float f32x4 __attribute__((ext_vector_type(4)));
typedef float f32x2 __attribute__((ext_vector_type(2)));
typedef unsigned u32x4 __attribute__((ext_vector_type(4)));
typedef unsigned u32x2 __attribute__((ext_vector_type(2)));
typedef int i32x4 __attribute__((ext_vector_type(4)));
typedef int i32x8 __attribute__((ext_vector_type(8)));

#ifndef FP8_DOWN
#define FP8_DOWN 1
#endif
#ifndef MK_PER_PHASE
#define MK_PER_PHASE 0
#endif

constexpr int NB = 8, SEQ = 4096, DM = 1024, DEPTH = 4, M = NB * SEQ, DFF = 4096;
constexpr int DIN = 2464, PP = 2560  , QP = 1536  ;
constexpr int H_DIL = 6, H_MLA = 6, H_MOBA = 4;
constexpr int C_QA = 0, C_KA = 384, C_VA = 768, C_CQ = 1152, C_CKV = 1536, C_KR = 1664, C_QC = 1728, C_KC = 1984, C_VC = 2240;
constexpr int Q_NOPE = 0, Q_ROPE = 384, Q_KV = 768;
constexpr int O_A = 0, O_B = 384, O_C = 768;
constexpr float EPS = 1e-6f;
constexpr float LOG2E = 1.4426950408889634f;
constexpr float QS_64 = 0.125f * LOG2E;
constexpr float QS_96 = 0.10206207261596575f * LOG2E;

constexpr size_t MiB = 1u << 20;
constexpr size_t WS_CTL = 0, CTL_ZERO_BYTES = 1 * MiB;
constexpr size_t WS_SSQ = 1 * MiB;
constexpr size_t WS_ROPE = 7 * MiB;
constexpr size_t WS_TMOBA = 7 * MiB + 512 * 1024;
constexpr size_t WS_TDIL = WS_TMOBA + 64 * 1024;
constexpr size_t WS_KMEAN = 7 * MiB + 768 * 1024;
constexpr size_t WS_W = 8 * MiB, W_STRIDE = 25 * MiB;
constexpr size_t W_IN = 0, W_MLA = 5 * MiB, W_O = 6 * MiB + 512 * 1024, W_UP = 8 * MiB + 512 * 1024, W_DOWN = 16 * MiB + 512 * 1024;
constexpr size_t WS_ROWSC = 108 * MiB;
constexpr size_t WS_XB = 112 * MiB;
constexpr size_t WS_PROJ = 176 * MiB;
constexpr size_t WS_QM = 336 * MiB;
constexpr size_t WS_O = 432 * MiB;
constexpr size_t WS_U = WS_PROJ;
constexpr size_t WS_END = 496 * MiB;
static_assert(WS_PROJ + (size_t)M * PP * 2 == WS_QM && WS_QM + (size_t)M * QP * 2 == WS_O && WS_U + (size_t)M * DFF * 2 <= WS_O && WS_O + (size_t)M * DM * 2 == WS_END, "ws map");
static_assert(WS_W + DEPTH * W_STRIDE <= WS_XB && WS_XB + (size_t)M * DM * 2 == WS_PROJ, "ws map 2");
constexpr int CW_Q = 1024;
constexpr int CW_BAR = 16384;
constexpr int N_PHASES = 30;

constexpr int RING_BYTES = 131072;
constexpr int LDSCTL_OFF = RING_BYTES, MISC_OFF = LDSCTL_OFF + 320;
constexpr int RS_OFF = 132096;
constexpr int LDS_BYTES = 147456;
constexpr int NWAVES = 8;

#define LDS_WAIT() asm volatile("s_waitcnt lgkmcnt(0)" ::: "memory")
#define VM_WAIT() asm volatile("s_waitcnt vmcnt(0)" ::: "memory")
typedef __bf16 bf16x2_t __attribute__((ext_vector_type(2)));
__device__ __forceinline__ unsigned cvt_pk_bf16(float lo, float hi) { const f32x2 v = {lo, hi}; const bf16x2_t b = __builtin_convertvector(v, bf16x2_t); return __builtin_bit_cast(unsigned, b); }
__device__ __forceinline__ float bf_lo(unsigned u) { return __uint_as_float(u << 16); }
__device__ __forceinline__ float bf_hi(unsigned u) { return __uint_as_float(u & 0xffff0000u); }
__device__ __forceinline__ float dot8(u32x4 a, u32x4 b, float s) {
    s = fmaf(bf_lo(a.x), bf_lo(b.x), s); s = fmaf(bf_hi(a.x), bf_hi(b.x), s);
    s = fmaf(bf_lo(a.y), bf_lo(b.y), s); s = fmaf(bf_hi(a.y), bf_hi(b.y), s);
    s = fmaf(bf_lo(a.z), bf_lo(b.z), s); s = fmaf(bf_hi(a.z), bf_hi(b.z), s);
    s = fmaf(bf_lo(a.w), bf_lo(b.w), s); s = fmaf(bf_hi(a.w), bf_hi(b.w), s);
    return s;
}
__device__ __forceinline__ int lane_id() { int l; asm volatile("v_mbcnt_lo_u32_b32 %0, -1, 0\n\tv_mbcnt_hi_u32_b32 %0, -1, %0" : "=v"(l)); return l; }
template <int X> __device__ __forceinline__ float swz_xor(float v) { return __int_as_float(__builtin_amdgcn_ds_swizzle(__float_as_int(v), (X << 10) | 0x1f)); }
__device__ __forceinline__ float xsum32(float v) { auto rr = __builtin_amdgcn_permlane32_swap(__float_as_uint(v), __float_as_uint(v), false, false); return __uint_as_float(rr[0]) + __uint_as_float(rr[1]); }
__device__ __forceinline__ float wave_sum(float v) { v += swz_xor<1>(v); v += swz_xor<2>(v); v += swz_xor<4>(v); v += swz_xor<8>(v); v += swz_xor<16>(v); return xsum32(v); }
__device__ __forceinline__ float sum4(const f32x4& a) { return (a[0] + a[1]) + (a[2] + a[3]); }
__device__ __forceinline__ float ssq16(const float* p, size_t st) { float a[16];
#pragma unroll
    for (int i = 0; i < 16; ++i) a[i] = p[(size_t)i * st];
    return ((((a[0] + a[1]) + (a[2] + a[3])) + ((a[4] + a[5]) + (a[6] + a[7]))) + (((a[8] + a[9]) + (a[10] + a[11])) + ((a[12] + a[13]) + (a[14] + a[15])))); }

namespace pg8 {
constexpr int BM = 256, BK = 64, HALF = 128, HTB = HALF * BK * 2, STAGE_BYTES = 8 * HTB, NXCD = 8, WGM = 8;
__host__ __device__ __forceinline__ int lds_byte(int r, int c) { const int st = (r >> 4) * 2 + (c >> 5), rr = r & 15, cc = c & 31, ob = rr * 64 + cc * 2; return st * 1024 + (ob ^ (((ob >> 9) & 1) << 5)); }
__host__ __device__ __forceinline__ void stage_rc(int b, int& R, int& C) { const int st = b / 1024, sb = b % 1024, swz = sb ^ (((sb >> 9) & 1) << 5); R = (st >> 1) * 16 + swz / 64; C = (st & 1) * 32 + (swz % 64) / 2; }
__host__ __device__ __forceinline__ int perm32(int rho) { const int n = rho >> 4, i = rho & 15; return 8 * (i >> 2) + 4 * n + (i & 3); }

struct Unit { int pm, pn; };
struct Gemm { const bf16* A; const bf16* Bt; int M, N, K, lda; };

struct StaticOrder {
    int nM, nN, nwg, G, c;
    __host__ __device__ __forceinline__ void init(int M_, int N_, int G_, int c_) { nM = M_ / BM; nN = N_ / BM; nwg = nM * nN; G = G_; c = c_; }
    __host__ __device__ __forceinline__ bool next(int i, Unit& u) const {
        const long L = (long)i * G + c; if (L >= nwg) return false;
        int wgid = (int)L; { const int q = nwg / NXCD, r = nwg % NXCD, xcd = wgid % NXCD, off = wgid / NXCD; wgid = (xcd < r ? xcd * (q + 1) : r * (q + 1) + (xcd - r) * q) + off; }
        const int nig = WGM * nN, gid = wgid / nig, fm = gid * WGM, gsz = (nM - fm) < WGM ? (nM - fm) : WGM;
        u.pm = fm + ((wgid % nig) % gsz); u.pn = (wgid % nig) / gsz; return true;
    }
    __host__ __device__ __forceinline__ void krange(const Unit&, int& kt0, int& ntu, int ntfull) const { kt0 = 0; ntu = ntfull; }
};
struct MlaOrder {
    int c;
    __host__ __device__ __forceinline__ bool next(int i, Unit& u) const { if (i >= 3 || c >= 256) return false; u.pm = c >> 1; const int odd = c & 1; u.pn = odd ? (i == 0 ? 2 : 3 + i) : (i == 2 ? 3 : i); return true; }
    __host__ __device__ __forceinline__ void krange(const Unit& u, int& kt0, int& ntu, int) const { if (u.pn < 3) { kt0 = 0; ntu = 6; } else { kt0 = 6; ntu = 2; } }
};

template <class Epi, bool F8 = false, class Sched = StaticOrder, bool RSC = false>
__device__ __forceinline__ void gemm_phase(LAS unsigned char* lds, const Gemm g, const Sched& S, const Epi& E, const int wid  ) {
    const int lane = lane_id(), tid = wid * 64 + lane;
    const int wr = wid >> 2, wc = wid & 3, fr = lane & 15, fq = lane >> 4;
    constexpr int ESZ = F8 ? 1 : 2;
    const int K = g.K, ntfull = K * ESZ / (BK * 2), lda = g.lda;
    unsigned voffA[2], voffB[2];
#pragma unroll
    for (int i = 0; i < 2; ++i) { int R, C; stage_rc(tid * 16 + i * 8192, R, C); const int Rb = Epi::PERM ? ((R & ~31) + perm32(R & 31)) : R;
        voffA[i] = (unsigned)(R * lda * ESZ + C * 2); voffB[i] = (unsigned)(Rb * K * ESZ + C * 2); }
    const size_t kstep = (size_t)(BK * 2);
    const size_t hstepA = (size_t)HALF * lda * ESZ, hstepB = (size_t)HALF * K * ESZ;
    const size_t tstepA = 2 * hstepA, tstepB = 2 * hstepB;
    const unsigned ldsw = (unsigned)wid * 1024u;
    const int aoff = lds_byte(wr * 64 + fr, fq * 8), boff = lds_byte(wc * 32 + fr, fq * 8);
#define PG8_SA(b, h) (((b) * 2 + (h)) * HTB)
#define PG8_SB(b, h) ((4 + (b) * 2 + (h)) * HTB)
#define PG8_STAGE(bufoff, gbase, voff) do { _Pragma("unroll") for (int _i = 0; _i < 2; ++_i) { unsigned vo_ = (voff)[_i]; asm volatile("" : "+v"(vo_));   \
        __builtin_amdgcn_global_load_lds((const unsigned*)((const char*)(gbase) + vo_), (LAS unsigned*)(lds + (bufoff) + ldsw + _i * 8192), 16, 0, 0); } } while (0)
#define PG8_RD2(p) __builtin_shufflevector(*(const LAS i32x4*)(p), *(const LAS i32x4*)((p) + 1024), 0, 1, 2, 3, 4, 5, 6, 7)
#define PG8_LDA(dst, b, h) do { _Pragma("unroll") for (int m = 0; m < 4; ++m) dst[m] = PG8_RD2(lds + PG8_SA(b, h) + aoff + m * 2048); } while (0)
#define PG8_LDB(dst, b, h) do { _Pragma("unroll") for (int n = 0; n < 2; ++n) dst[n] = PG8_RD2(lds + PG8_SB(b, h) + boff + n * 2048); } while (0)
#define PG8_LO(x) __builtin_bit_cast(bf16x8, __builtin_shufflevector(x, x, 0, 1, 2, 3))
#define PG8_HI(x) __builtin_bit_cast(bf16x8, __builtin_shufflevector(x, x, 4, 5, 6, 7))
#define PG8_MMA(ai, bj, At, Bt) do { __builtin_amdgcn_s_setprio(1); _Pragma("unroll") for (int m = 0; m < 4; ++m) _Pragma("unroll") for (int n = 0; n < 2; ++n) { \
        if constexpr (F8) acc[ai][bj][m][n] = __builtin_amdgcn_mfma_scale_f32_16x16x128_f8f6f4(Bt[n], At[m], acc[ai][bj][m][n], 0, 0, 0, 0x7f7f7f7f, 0, 0x7f7f7f7f); \
        else { acc[ai][bj][m][n] = __builtin_amdgcn_mfma_f32_16x16x32_bf16(PG8_LO(Bt[n]), PG8_LO(At[m]), acc[ai][bj][m][n], 0, 0, 0); \
               acc[ai][bj][m][n] = __builtin_amdgcn_mfma_f32_16x16x32_bf16(PG8_HI(Bt[n]), PG8_HI(At[m]), acc[ai][bj][m][n], 0, 0, 0); } } \
        __builtin_amdgcn_s_setprio(0); } while (0)
#define PG8_WAIT_V(n) asm volatile("s_waitcnt vmcnt(" #n ")" ::: "memory")
#define PG8_WAIT_L(n) asm volatile("s_waitcnt lgkmcnt(" #n ")" ::: "memory")
#define PG8_BAR __builtin_amdgcn_s_barrier()
#define PG8_SCHED __builtin_amdgcn_sched_barrier(0)
    Unit cur, nxt; int ui = 0;
    if (!S.next(0, cur)) return;
    f32x4 acc[2][2][4][2];
#pragma unroll
    for (int a = 0; a < 2; ++a)
#pragma unroll
        for (int b = 0; b < 2; ++b)
#pragma unroll
            for (int m = 0; m < 4; ++m)
#pragma unroll
                for (int n = 0; n < 2; ++n) acc[a][b][m][n] = (f32x4){0.f, 0.f, 0.f, 0.f};
    i32x8 At[4], B0[2], B1[2];
    int kt0, nt; S.krange(cur, kt0, nt, ntfull);
    const char* cA = (const char*)g.A + (size_t)cur.pm * tstepA + (size_t)kt0 * kstep; const char* cB = (const char*)g.Bt + (size_t)cur.pn * tstepB + (size_t)kt0 * kstep;
    PG8_STAGE(PG8_SB(0, 0), cB, voffB); PG8_STAGE(PG8_SB(0, 1), cB + hstepB, voffB); PG8_STAGE(PG8_SA(0, 0), cA, voffA); PG8_STAGE(PG8_SA(0, 1), cA + hstepA, voffA);
    if (wr == 1) PG8_BAR;
    PG8_WAIT_V(2); PG8_BAR;
    PG8_STAGE(PG8_SB(1, 0), cB + kstep, voffB); PG8_STAGE(PG8_SA(1, 0), cA + kstep, voffA); PG8_STAGE(PG8_SB(1, 1), cB + hstepB + kstep, voffB);
    PG8_WAIT_V(6); PG8_BAR;
    for (;;) {
        const bool has_next = S.next(ui + 1, nxt);
        int nkt0 = kt0, nnt = nt; if (has_next) S.krange(nxt, nkt0, nnt, ntfull);
        const char* nA = has_next ? (const char*)g.A + (size_t)nxt.pm * tstepA + (size_t)nkt0 * kstep : cA; const char* nB = has_next ? (const char*)g.Bt + (size_t)nxt.pn * tstepB + (size_t)nkt0 * kstep : cB;
        for (int t = 0; t < nt; t += 2) {
            if constexpr (RSC) { if (t == 6 || t == 12) { const LAS float* rr_ = (const LAS float*)(lds + RS_OFF) + (ui * 256 + wr * 64 + fr) * 4 + (t == 6 ? 0 : 1);
#pragma unroll
                for (int ai = 0; ai < 2; ++ai)
#pragma unroll
                    for (int m = 0; m < 4; ++m) { const float f_ = rr_[(ai * HALF + m * 16) * 4];
#pragma unroll
                        for (int bj = 0; bj < 2; ++bj)
#pragma unroll
                            for (int n = 0; n < 2; ++n) acc[ai][bj][m][n] *= f_; } } }
            const bool last = (t == nt - 2);
            const char* a1 = cA + (size_t)(t + 1) * kstep;
            const char* a2 = last ? nA : cA + (size_t)(t + 2) * kstep; const char* b2 = last ? nB : cB + (size_t)(t + 2) * kstep;
            const char* a3 = a2 + kstep; const char* b3 = b2 + kstep;
            PG8_LDB(B0, 0, 0); PG8_LDB(B1, 0, 1); PG8_SCHED; PG8_LDA(At, 0, 0); PG8_STAGE(PG8_SA(1, 1), a1 + hstepA, voffA);
            PG8_WAIT_V(8); PG8_WAIT_L(0); PG8_BAR; PG8_MMA(0, 0, At, B0); PG8_MMA(0, 1, At, B1); PG8_BAR; PG8_SCHED;
            PG8_LDA(At, 0, 1); PG8_STAGE(PG8_SB(0, 0), b2, voffB); PG8_STAGE(PG8_SB(0, 1), b2 + hstepB, voffB); PG8_STAGE(PG8_SA(0, 0), a2, voffA);
            PG8_WAIT_V(8); PG8_WAIT_L(0); PG8_BAR; PG8_MMA(1, 0, At, B0); PG8_MMA(1, 1, At, B1); PG8_BAR; PG8_SCHED;
            PG8_LDB(B0, 1, 0); PG8_LDB(B1, 1, 1); PG8_SCHED; PG8_LDA(At, 1, 0); PG8_STAGE(PG8_SA(0, 1), a2 + hstepA, voffA);
            PG8_WAIT_V(8); PG8_WAIT_L(0); PG8_BAR; PG8_MMA(0, 0, At, B0); PG8_MMA(0, 1, At, B1); PG8_BAR; PG8_SCHED;
            PG8_LDA(At, 1, 1); PG8_STAGE(PG8_SB(1, 0), b3, voffB); PG8_STAGE(PG8_SB(1, 1), b3 + hstepB, voffB); PG8_STAGE(PG8_SA(1, 0), a3, voffA);
            PG8_WAIT_V(8); PG8_WAIT_L(0); PG8_BAR; PG8_MMA(1, 0, At, B0); PG8_MMA(1, 1, At, B1); PG8_BAR; PG8_SCHED;
        }
        if (wr == 0) PG8_BAR;
        { const int le = lane_id(); E(acc, cur, ui, (const LAS float*)(lds + RS_OFF - 0), wr, wc, le & 15, le >> 4); }
        if (!has_next) break;
#pragma unroll
        for (int a = 0; a < 2; ++a)
#pragma unroll
            for (int b = 0; b < 2; ++b)
#pragma unroll
                for (int m = 0; m < 4; ++m)
#pragma unroll
                    for (int n = 0; n < 2; ++n) acc[a][b][m][n] = (f32x4){0.f, 0.f, 0.f, 0.f};
        cur = nxt; cA = nA; cB = nB; nt = nnt; kt0 = nkt0; ++ui;
        if (wr == 1) PG8_BAR;
    }
    PG8_WAIT_V(0);
    PG8_BAR;
#undef PG8_SA
#undef PG8_SB
#undef PG8_STAGE
#undef PG8_LDA
#undef PG8_LDB
#undef PG8_MMA
#undef PG8_LO
#undef PG8_HI
#undef PG8_RD2
#undef PG8_WAIT_V
#undef PG8_WAIT_L
#undef PG8_BAR
#undef PG8_SCHED
}

template <int MODE, class Sched> __device__ __forceinline__ void stage_rs(LAS float* rst, const float* ssq, const Sched& S, int wave) {
    const int t = wave * 64 + lane_id(), half = t >> 8, row = t & 255;
    f32x4 q[4][4]; int pn_[4]; bool ok[4];
#pragma unroll
    for (int k = 0; k < 4; ++k) { Unit u; ok[k] = S.next(2 * k + half, u); pn_[k] = ok[k] ? u.pn : 0; const int pm = ok[k] ? u.pm : 0;
        const float* p = ssq + (size_t)(pm * BM + row);
#pragma unroll
        for (int j = 0; j < 4; ++j) q[k][j] = (f32x4){p[(size_t)(4 * j) * M], p[(size_t)(4 * j + 1) * M], p[(size_t)(4 * j + 2) * M], p[(size_t)(4 * j + 3) * M]}; }
#pragma unroll
    for (int k = 0; k < 4; ++k) if (ok[k]) { float r;
        if (MODE == 0) r = rsqrtf(((sum4(q[k][0]) + sum4(q[k][1])) + (sum4(q[k][2]) + sum4(q[k][3]))) * (1.0f / DM) + EPS);
        else r = pn_[k] < 3 ? rsqrtf(((sum4(q[k][0]) + sum4(q[k][1])) + sum4(q[k][2])) * (1.0f / 384.0f) + EPS) : rsqrtf(sum4(q[k][3]) * (1.0f / 128.0f) + EPS);
        rst[(2 * k + half) * 256 + row] = r; }
    asm volatile("s_nop 15\n\ts_waitcnt vmcnt(0) lgkmcnt(0)\n\ts_barrier" ::: "memory");
}

__device__ __forceinline__ void rope_consts(float (&crev)[4], int i0) {
#pragma unroll
    for (int p = 0; p < 4; ++p) crev[p] = __builtin_amdgcn_exp2f(-(float)(i0 + p) * (13.287712379549449f / 16.0f)) * 0.15915494309189535f;
}
__device__ __forceinline__ void rope8(f32x4& v0, f32x4& v1, int pos, const float (&crev)[4]) {
    float c[4], sn[4];
#pragma unroll
    for (int p = 0; p < 4; ++p) { float rev = (float)pos * crev[p]; rev = __builtin_amdgcn_fractf(rev); c[p] = __builtin_amdgcn_cosf(rev); sn[p] = __builtin_amdgcn_sinf(rev); }
    f32x4 a, b;
    a[0] = v0[0] * c[0] - v0[1] * sn[0]; a[1] = v0[1] * c[0] + v0[0] * sn[0];
    a[2] = v0[2] * c[1] - v0[3] * sn[1]; a[3] = v0[3] * c[1] + v0[2] * sn[1];
    b[0] = v1[0] * c[2] - v1[1] * sn[2]; b[1] = v1[1] * c[2] + v1[0] * sn[2];
    b[2] = v1[2] * c[3] - v1[3] * sn[3]; b[3] = v1[3] * c[3] + v1[2] * sn[3];
    v0 = a; v1 = b;
}
__device__ __forceinline__ float sumsq8(const f32x4& a, const f32x4& b) { return (a[0] * a[0] + a[1] * a[1]) + (a[2] * a[2] + a[3] * a[3]) + (b[0] * b[0] + b[1] * b[1]) + (b[2] * b[2] + b[3] * b[3]); }
__device__ __forceinline__ u32x4 pack8(const f32x4& a, const f32x4& b) { u32x4 w; w.x = cvt_pk_bf16(a[0], a[1]); w.y = cvt_pk_bf16(a[2], a[3]); w.z = cvt_pk_bf16(b[0], b[1]); w.w = cvt_pk_bf16(b[2], b[3]); return w; }

struct EpiProj {
    static constexpr bool PERM = true;
    bf16* O; const float* ssq_x; float* ssq_c; const f32x2* cs;
    __device__ __forceinline__ void operator()(const f32x4 (&acc)[2][2][4][2], const Unit& u, int ui, const LAS float* rst, int wr, int wc, int fr, int fq) const {
        const int row0 = u.pm * BM + wr * 64 + fr, colb = u.pn * BM + wc * 32 + 8 * fq;
        const bool sp = (u.pn >= 4 && u.pn <= 6);
        float crev[4]; rope_consts(crev, 4 * fq);
#pragma unroll
        for (int ai = 0; ai < 2; ++ai)
#pragma unroll
            for (int m = 0; m < 4; ++m) { const int row = row0 + ai * HALF + m * 16; const float rs = rst[ui * 256 + row - u.pm * BM];
                bf16* rowp = O + (size_t)row * PP + colb;
#pragma unroll
                for (int bj = 0; bj < 2; ++bj) { f32x4 v0 = acc[ai][bj][m][0] * rs, v1 = acc[ai][bj][m][1] * rs;
                    if (sp) {
                        if (u.pn == 6 && bj == 1 && wc == 0) rope8(v0, v1, row & (SEQ - 1), crev);
                        const bool is_cq = (u.pn == 4 && bj == 1) || (u.pn == 5), is_ckv = (u.pn == 6 && bj == 0);
                        if (is_cq || is_ckv) { float s = sumsq8(v0, v1); s += swz_xor<16>(s); s = xsum32(s);
                            const int slot = (is_ckv ? 12 : (u.pn == 4 ? 0 : 4 + 4 * bj)) + wc;
                            if (fq == 0) ssq_c[(size_t)slot * M + row] = s; }
                    }
                    *(u32x4*)(rowp + bj * HALF) = pack8(v0, v1); } }
    }
};
struct EpiMla {
    static constexpr bool PERM = true;
    bf16* O; const float* ssq_c; const f32x2* cs;
    __device__ __forceinline__ void operator()(const f32x4 (&acc)[2][2][4][2], const Unit& u, int ui, const LAS float* rst, int wr, int wc, int fr, int fq) const {
        const int row0 = u.pm * BM + wr * 64 + fr, colb = u.pn * BM + wc * 32 + 8 * fq;
        const bool isq = u.pn < 3;
        float crev[4]; rope_consts(crev, 4 * fq);
#pragma unroll
        for (int ai = 0; ai < 2; ++ai)
#pragma unroll
            for (int m = 0; m < 4; ++m) { const int row = row0 + ai * HALF + m * 16;
                const float rs = rst[ui * 256 + row - u.pm * BM];
                bf16* rowp = O + (size_t)row * QP + colb;
#pragma unroll
                for (int bj = 0; bj < 2; ++bj) { f32x4 v0 = acc[ai][bj][m][0] * rs, v1 = acc[ai][bj][m][1] * rs;
                    if ((u.pn == 1 && bj == 1) || (u.pn == 2 && bj == 0)) rope8(v0, v1, row & (SEQ - 1), crev);
                    *(u32x4*)(rowp + bj * HALF) = pack8(v0, v1); } }
    }
};
template <bool RS> struct EpiRes {
    static constexpr bool PERM = true;
    bf16* xb; float* ssq; float ascale;
    __device__ __forceinline__ void operator()(const f32x4 (&acc)[2][2][4][2], const Unit& u, int ui, const LAS float* rst, int wr, int wc, int fr, int fq) const {
        const int row0 = u.pm * BM + wr * 64 + fr, colb = u.pn * BM + wc * 32 + 8 * fq;
        u32x4 old[2][4][2];
#pragma unroll
        for (int ai = 0; ai < 2; ++ai)
#pragma unroll
            for (int m = 0; m < 4; ++m)
#pragma unroll
                for (int bj = 0; bj < 2; ++bj) old[ai][m][bj] = *(const u32x4*)(xb + (size_t)(row0 + ai * HALF + m * 16) * DM + colb + bj * HALF);
#pragma unroll
        for (int ai = 0; ai < 2; ++ai)
#pragma unroll
            for (int m = 0; m < 4; ++m) { const int row = row0 + ai * HALF + m * 16; bf16* rowp = xb + (size_t)row * DM + colb; float s = 0.f;
                const float asc = RS ? ascale * rst[(ui * 256 + row - u.pm * BM) * 4 + 2] : ascale;
#pragma unroll
                for (int bj = 0; bj < 2; ++bj) { const u32x4 o4 = old[ai][m][bj];
                    const f32x4 v0 = acc[ai][bj][m][0] * asc + (f32x4){bf_lo(o4.x), bf_hi(o4.x), bf_lo(o4.y), bf_hi(o4.y)}, v1 = acc[ai][bj][m][1] * asc + (f32x4){bf_lo(o4.z), bf_hi(o4.z), bf_lo(o4.w), bf_hi(o4.w)};
                    s += sumsq8(v0, v1); *(u32x4*)(rowp + bj * HALF) = pack8(v0, v1); }
                s += swz_xor<16>(s); s = xsum32(s);
                if (fq == 0) ssq[(size_t)(u.pn * 4 + wc) * M + row] = s; }
    }
};
struct EpiUp {
    static constexpr bool PERM = true;
    bf16* O; const float* ssq;
    __device__ __forceinline__ void operator()(const f32x4 (&acc)[2][2][4][2], const Unit& u, int ui, const LAS float* rst, int wr, int wc, int fr, int fq) const {
        const int row0 = u.pm * BM + wr * 64 + fr, colb = u.pn * BM + wc * 32 + 8 * fq;
#pragma unroll
        for (int ai = 0; ai < 2; ++ai)
#pragma unroll
            for (int m = 0; m < 4; ++m) { const int row = row0 + ai * HALF + m * 16; const float rs = rst[ui * 256 + row - u.pm * BM];
                bf16* rowp = O + (size_t)row * DFF + colb;
#pragma unroll
                for (int bj = 0; bj < 2; ++bj) { f32x4 v0 = acc[ai][bj][m][0] * rs, v1 = acc[ai][bj][m][1] * rs;
#pragma unroll
                    for (int e = 0; e < 4; ++e) { const float a = fmaxf(v0[e], 0.f), b = fmaxf(v1[e], 0.f); v0[e] = a * a; v1[e] = b * b; }
                    *(u32x4*)(rowp + bj * HALF) = pack8(v0, v1); } }
    }
};
__device__ __forceinline__ unsigned pk4_fp8(const f32x4& v) { unsigned w = 0u; w = __builtin_amdgcn_cvt_pk_fp8_f32(v[0], v[1], w, false); w = __builtin_amdgcn_cvt_pk_fp8_f32(v[2], v[3], w, true); return w; }
struct EpiUp8 {
    static constexpr bool PERM = true;
    unsigned char* O; const float* ssq;
    __device__ __forceinline__ void operator()(const f32x4 (&acc)[2][2][4][2], const Unit& u, int ui, const LAS float* rst, int wr, int wc, int fr, int fq) const {
        const int row0 = u.pm * BM + wr * 64 + fr, colb = u.pn * BM + wc * 32 + 8 * fq;
#pragma unroll
        for (int ai = 0; ai < 2; ++ai)
#pragma unroll
            for (int m = 0; m < 4; ++m) { const int row = row0 + ai * HALF + m * 16; const float rs = rst[ui * 256 + row - u.pm * BM];
                unsigned char* rowp = O + (size_t)row * DFF + colb;
                u32x2 w[2];
#pragma unroll
                for (int bj = 0; bj < 2; ++bj) { f32x4 v0 = acc[ai][bj][m][0] * rs, v1 = acc[ai][bj][m][1] * rs;
#pragma unroll
                    for (int e = 0; e < 4; ++e) { const float a = fmaxf(v0[e], 0.f), b = fmaxf(v1[e], 0.f); v0[e] = fminf(a * a * 8.0f, 448.0f); v1[e] = fminf(b * b * 8.0f, 448.0f); }
                    w[bj].x = pk4_fp8(v0); w[bj].y = pk4_fp8(v1); }
                { auto sx = __builtin_amdgcn_permlane16_swap(w[0].x, w[1].x, false, false); auto sy = __builtin_amdgcn_permlane16_swap(w[0].y, w[1].y, false, false);
                  const u32x4 o = {sx[0], sy[0], sx[1], sy[1]};
                  *(u32x4*)(rowp + ((fq & 1) ? HALF - 8 : 0)) = o; } }
    }
};
}

#define XB_TMO      128
#define XB_XCNT(j)  (256  + 64 * (j))
#define XB_XSUB(j)  (1280 + 64 * (j))
#define XB_XGEN(j)  (2304 + 64 * (j))
#define XB_TOP      3328
#define XB_TOPGEN   3392
#define XCD_BAR_WORDS 3456
#define XB_SPIN_CAP (1u << 18)
__device__ __forceinline__ unsigned xb_ld(unsigned* p)              { return __hip_atomic_load(p, __ATOMIC_RELAXED, __HIP_MEMORY_SCOPE_AGENT); }
__device__ __forceinline__ unsigned xb_add(unsigned* p, unsigned v) { return __hip_atomic_fetch_add(p, v, __ATOMIC_RELAXED, __HIP_MEMORY_SCOPE_AGENT); }
__device__ __forceinline__ unsigned xb_xcc_id() { return (unsigned)__builtin_amdgcn_s_getreg((3 << 11) | 20) & 0xFu; }
#define XB_SPIN(cond, bar) do { unsigned _sp = 0; while (cond) { __builtin_amdgcn_s_sleep(1); \
    if ((++_sp & 255u) == 0u) { if (xb_ld(&(bar)[XB_TMO])) break; if (_sp > XB_SPIN_CAP) { atomicAdd(&(bar)[XB_TMO], 1u); break; } } } } while (0)
struct XcdBarrier { unsigned* bar; unsigned x; volatile LAS unsigned* st; };
__device__ __forceinline__ XcdBarrier xcd_barrier_post(unsigned* bar, volatile LAS unsigned* st, bool t0  ) {
    XcdBarrier b; b.bar = bar; b.x = xb_xcc_id(); b.st = st;
    if (t0) (void)xb_add(&bar[XB_XCNT(b.x)], 1u);
    return b;
}
__device__ __forceinline__ void xcd_barrier_complete(unsigned* bar, unsigned x, unsigned& nloc, unsigned& nx) {
    const unsigned G = gridDim.x * gridDim.y * gridDim.z;
    unsigned sum, cnt, mine, sp = 0u;
    for (;;) {
        sum = 0u; cnt = 0u; mine = 0u;
#pragma unroll
        for (unsigned j = 0; j < 16; ++j) { const unsigned c = xb_ld(&bar[XB_XCNT(j)]); sum += c; cnt += (c > 0u) ? 1u : 0u; mine = (j == x) ? c : mine; }
        if (sum == G) break;
        __builtin_amdgcn_s_sleep(1);
        if ((++sp & 255u) == 0u) { if (xb_ld(&bar[XB_TMO])) break; if (sp > XB_SPIN_CAP) { atomicAdd(&bar[XB_TMO], 1u); break; } }
    }
    nloc = mine > 0u ? mine : 1u; nx = cnt > 0u ? cnt : 1u;
}
__device__ __forceinline__ void xcd_barrier(const XcdBarrier& b, bool t0  ) {
    asm volatile("s_waitcnt vmcnt(0)" ::: "memory");
    __syncthreads();
    if (t0) {
        GAS unsigned* barg_ = (GAS unsigned*)b.bar; unsigned bx = b.x;
        asm volatile("" : "+s"(barg_), "+s"(bx)); unsigned* bar = (unsigned*)barg_;
        __builtin_amdgcn_s_waitcnt(0);
        unsigned nloc = b.st[0], nx = b.st[1];
        if (nloc == 0u) { xcd_barrier_complete(bar, bx, nloc, nx); b.st[0] = nloc; b.st[1] = nx; }
        const unsigned old = xb_add(&bar[XB_XSUB(bx)], 1u);
        const unsigned gen = old / nloc;
        if (old + 1u == (gen + 1u) * nloc) {
            __builtin_amdgcn_fence(__ATOMIC_RELEASE, "agent");
            asm volatile("s_waitcnt vmcnt(0)" ::: "memory");
            const unsigned og = xb_add(&bar[XB_TOP], 1u);
            const unsigned tg = og / nx;
            if (og + 1u == (tg + 1u) * nx) xb_add(&bar[XB_TOPGEN], 1u);
            else XB_SPIN(xb_ld(&bar[XB_TOPGEN]) == tg, bar);
            __builtin_amdgcn_fence(__ATOMIC_ACQUIRE, "agent");
            xb_add(&bar[XB_XGEN(bx)], 1u);
            asm volatile("s_waitcnt vmcnt(0)" ::: "memory");
        } else {
            XB_SPIN(xb_ld(&bar[XB_XGEN(bx)]) == gen, bar);
            __builtin_amdgcn_fence(__ATOMIC_ACQUIRE, "agent");
            asm volatile("s_waitcnt vmcnt(0)" ::: "memory");
        }
    }
    __syncthreads();
}

namespace att {
typedef float f32x16 __attribute__((ext_vector_type(16)));
typedef short s16x4 __attribute__((ext_vector_type(4)));
typedef LAS const char* lds_cptr;
constexpr int THRL = 8;
constexpr int NEXP1 = 8;
__device__ __forceinline__ int crow(int r, int hi) { return (r & 3) + 8 * (r >> 2) + 4 * hi; }
__device__ __forceinline__ void glds16s(const void* sbase  , unsigned voff  , unsigned lds_dst) { unsigned keep;
    asm volatile("s_mov_b32 %0, m0\n\ts_mov_b32 m0, %3\n\ts_nop 0\n\tglobal_load_lds_dwordx4 %1, %2\n\ts_mov_b32 m0, %0" : "=&s"(keep) : "v"(voff), "s"(sbase), "s"(lds_dst) : "memory"); }
__device__ __forceinline__ void glds16(const void* gsrc, unsigned lds_dst) { unsigned keep;
    asm volatile("s_mov_b32 %0, m0\n\ts_mov_b32 m0, %2\n\ts_nop 0\n\tglobal_load_lds_dwordx4 %1, off\n\ts_mov_b32 m0, %0" : "=&s"(keep) : "v"(gsrc), "s"(lds_dst) : "memory"); }
__device__ __forceinline__ float max3f(float a, float b, float c) { return __builtin_fmaxf(__builtin_fmaxf(a, b), c); }
#define ATT_WAIT_BAR(N) asm volatile("s_nop 15\n\ts_waitcnt vmcnt(" #N ") lgkmcnt(0)\n\ts_barrier" ::: "memory")
#define ATT_SBAR() __builtin_amdgcn_sched_barrier(0)
__device__ __forceinline__ float swap_add(float v) { auto rr = __builtin_amdgcn_permlane32_swap(__float_as_uint(v), __float_as_uint(v), false, false); return __uint_as_float(rr[0]) + __uint_as_float(rr[1]); }
__device__ __forceinline__ float swap_max(float v) { auto rr = __builtin_amdgcn_permlane32_swap(__float_as_uint(v), __float_as_uint(v), false, false); return fmaxf(__uint_as_float(rr[0]), __uint_as_float(rr[1])); }

#define MFMA_FENCE1(a) asm volatile("s_nop 15\n\ts_nop 1" : "+v"(a))
#define MFMA_FENCE2(a, b) asm volatile("s_nop 15\n\ts_nop 1" : "+v"(a), "+v"(b))
template <int ND0> __device__ __forceinline__ void qkt_lds(f32x16& p0, f32x16& p1, lds_cptr kslot, const bf16x8* qr, const f32x16& c0, int r32, int hi) {
    lds_cptr kb = kslot + hi * 1024 + r32 * 16;
    bf16x8 kf[2 * ND0];
#pragma unroll
    for (int d0 = 0; d0 < ND0; ++d0) { kf[2 * d0] = *(const LAS bf16x8*)(kb + d0 * 2048); kf[2 * d0 + 1] = *(const LAS bf16x8*)(kb + d0 * 2048 + 512); }
    ATT_SBAR();
#pragma unroll
    for (int d0 = 0; d0 < ND0; ++d0) {
        if (d0 == 0) { p0 = __builtin_amdgcn_mfma_f32_32x32x16_bf16(kf[0], qr[0], c0, 0, 0, 0); p1 = __builtin_amdgcn_mfma_f32_32x32x16_bf16(kf[1], qr[0], c0, 0, 0, 0); }
        else { p0 = __builtin_amdgcn_mfma_f32_32x32x16_bf16(kf[2 * d0], qr[d0], p0, 0, 0, 0); p1 = __builtin_amdgcn_mfma_f32_32x32x16_bf16(kf[2 * d0 + 1], qr[d0], p1, 0, 0, 0); } }
}
struct VFrag { s16x4 lo[8], hi[8]; };
__device__ __forceinline__ void pv64_read(VFrag& v, int vb) {
#pragma unroll
    for (int d0 = 0; d0 < 2; ++d0)
#pragma unroll
        for (int ks = 0; ks < 4; ++ks) {
            asm volatile("ds_read_b64_tr_b16 %0,%1 offset:%c2" : "=&v"(v.lo[d0 * 4 + ks]) : "v"(vb), "i"(d0 * 4096 + ks * 1024) : "memory");
            asm volatile("ds_read_b64_tr_b16 %0,%1 offset:%c2" : "=&v"(v.hi[d0 * 4 + ks]) : "v"(vb), "i"(d0 * 4096 + ks * 1024 + 512) : "memory"); }
}
#define ATT_PK(k) (bf16x8){lo[k][0], lo[k][1], lo[k][2], lo[k][3], hi[k][0], hi[k][1], hi[k][2], hi[k][3]}
__device__ __forceinline__ void pv64_mma(f32x16* o, VFrag& v, bf16x8 pa0, bf16x8 pa1, bf16x8 pa2, bf16x8 pa3) {
    asm volatile("s_waitcnt lgkmcnt(0)" : "+v"(v.lo[0]), "+v"(v.lo[1]), "+v"(v.lo[2]), "+v"(v.lo[3]), "+v"(v.lo[4]), "+v"(v.lo[5]), "+v"(v.lo[6]), "+v"(v.lo[7]),
                 "+v"(v.hi[0]), "+v"(v.hi[1]), "+v"(v.hi[2]), "+v"(v.hi[3]), "+v"(v.hi[4]), "+v"(v.hi[5]), "+v"(v.hi[6]), "+v"(v.hi[7]) :: "memory");
#pragma unroll
    for (int d0 = 0; d0 < 2; ++d0) { const s16x4* lo = v.lo + 4 * d0; const s16x4* hi = v.hi + 4 * d0;
        o[d0] = __builtin_amdgcn_mfma_f32_32x32x16_bf16(pa0, ATT_PK(0), o[d0], 0, 0, 0);
        o[d0] = __builtin_amdgcn_mfma_f32_32x32x16_bf16(pa1, ATT_PK(1), o[d0], 0, 0, 0);
        o[d0] = __builtin_amdgcn_mfma_f32_32x32x16_bf16(pa2, ATT_PK(2), o[d0], 0, 0, 0);
        o[d0] = __builtin_amdgcn_mfma_f32_32x32x16_bf16(pa3, ATT_PK(3), o[d0], 0, 0, 0); }
}
struct V32 { s16x4 lo[4], hi[4]; };
__device__ __forceinline__ void pv32_read(V32& v, int vb) {
#pragma unroll
    for (int d0 = 0; d0 < 2; ++d0)
#pragma unroll
        for (int ks = 0; ks < 2; ++ks) {
            asm volatile("ds_read_b64_tr_b16 %0,%1 offset:%c2" : "=&v"(v.lo[d0 * 2 + ks]) : "v"(vb), "i"(d0 * 4096 + ks * 1024) : "memory");
            asm volatile("ds_read_b64_tr_b16 %0,%1 offset:%c2" : "=&v"(v.hi[d0 * 2 + ks]) : "v"(vb), "i"(d0 * 4096 + ks * 1024 + 512) : "memory"); }
}
__device__ __forceinline__ void pv32_mma(f32x16* o, V32& v, bf16x8 pa0, bf16x8 pa1) {
    asm volatile("s_waitcnt lgkmcnt(0)" : "+v"(v.lo[0]), "+v"(v.lo[1]), "+v"(v.lo[2]), "+v"(v.lo[3]), "+v"(v.hi[0]), "+v"(v.hi[1]), "+v"(v.hi[2]), "+v"(v.hi[3]) :: "memory");
#pragma unroll
    for (int d0 = 0; d0 < 2; ++d0) {
        o[d0] = __builtin_amdgcn_mfma_f32_32x32x16_bf16(pa0, ((bf16x8){v.lo[2 * d0][0], v.lo[2 * d0][1], v.lo[2 * d0][2], v.lo[2 * d0][3], v.hi[2 * d0][0], v.hi[2 * d0][1], v.hi[2 * d0][2], v.hi[2 * d0][3]}), o[d0], 0, 0, 0);
        o[d0] = __builtin_amdgcn_mfma_f32_32x32x16_bf16(pa1, ((bf16x8){v.lo[2 * d0 + 1][0], v.lo[2 * d0 + 1][1], v.lo[2 * d0 + 1][2], v.lo[2 * d0 + 1][3], v.hi[2 * d0 + 1][0], v.hi[2 * d0 + 1][1], v.hi[2 * d0 + 1][2], v.hi[2 * d0 + 1][3]}), o[d0], 0, 0, 0); }
}
__device__ __forceinline__ void pv32(f32x16* o, int vb, bf16x8 pa0, bf16x8 pa1) {
#pragma unroll
    for (int d0 = 0; d0 < 2; ++d0) { s16x4 lo[2], hi[2];
#pragma unroll
        for (int ks = 0; ks < 2; ++ks) {
            asm volatile("ds_read_b64_tr_b16 %0,%1 offset:%c2" : "=&v"(lo[ks]) : "v"(vb), "i"(d0 * 4096 + ks * 1024) : "memory");
            asm volatile("ds_read_b64_tr_b16 %0,%1 offset:%c2" : "=&v"(hi[ks]) : "v"(vb), "i"(d0 * 4096 + ks * 1024 + 512) : "memory"); }
        asm volatile("s_waitcnt lgkmcnt(0)" ::: "memory"); ATT_SBAR();
        o[d0] = __builtin_amdgcn_mfma_f32_32x32x16_bf16(pa0, ATT_PK(0), o[d0], 0, 0, 0);
        o[d0] = __builtin_amdgcn_mfma_f32_32x32x16_bf16(pa1, ATT_PK(1), o[d0], 0, 0, 0);
#undef ATT_PK
    }
}
__device__ __forceinline__ void cmask(f32x16& p0, f32x16& p1, int jb, int qrel, int hi) {
    const int kb = 64 * jb + 4 * hi;
#pragma unroll
    for (int r = 0; r < 16; ++r) { const int kv = kb + (r & 3) + 8 * (r >> 2); if (kv > qrel) p0[r] = -INFINITY; if (kv + 32 > qrel) p1[r] = -INFINITY; }
}
struct SmState { float mhat, l; f32x16 negm; f32x16 o[2]; };
__device__ __forceinline__ void sm_init(SmState& s) { s.mhat = 0.f; s.l = 0.f; s.negm = f32x16{}; s.o[0] = f32x16{}; s.o[1] = f32x16{}; }
__device__ __forceinline__ bool sm_decide64(SmState& s, f32x16& p0, f32x16& p1, LAS float* wsf, int r32, int hi) {
    float a = max3f(p0[0], p0[1], p1[0]), b = max3f(p0[2], p0[3], p1[1]); a = max3f(a, p1[2], p1[3]);
#pragma unroll
    for (int r = 4; r < 16; r += 4) { a = max3f(a, p0[r], p0[r + 1]); b = max3f(b, p0[r + 2], p0[r + 3]); a = max3f(a, p1[r], p1[r + 1]); b = max3f(b, p1[r + 2], p1[r + 3]); }
    const float rm = swap_max(fmaxf(a, b)); bool resc_ = false;
    if (__any(rm > (float)THRL)) { const float dl = fmaxf(rm, 0.f); s.mhat += dl;
#pragma unroll
        for (int r = 0; r < 16; ++r) { p0[r] -= dl; p1[r] -= dl; s.negm[r] = -s.mhat; }
        const float f = __builtin_amdgcn_exp2f(-dl); s.l *= f; if (hi == 0) wsf[r32] = f;
        resc_ = true; }
#pragma unroll
    for (int r = 0; r < NEXP1; ++r) p0[r] = __builtin_amdgcn_exp2f(p0[r]);
    asm volatile("" : "+v"(p0));
    return resc_;
}
__device__ __forceinline__ void sm_exp64(SmState& s, bool resc, f32x16& p0, f32x16& p1, LAS float* wsf, int hi, u32x4& pw0, u32x4& pw1, u32x4& pw2, u32x4& pw3) {
    if (resc) { asm volatile("s_waitcnt lgkmcnt(0)" ::: "memory"); MFMA_FENCE2(s.o[0], s.o[1]);
#pragma unroll
        for (int d = 0; d < 2; ++d)
#pragma unroll
            for (int r = 0; r < 16; ++r) s.o[d][r] *= wsf[crow(r, hi)];
        asm volatile("s_waitcnt lgkmcnt(0)" ::: "memory"); }
    float sa0 = 0.f, sa1 = 0.f, sb0 = 0.f, sb1 = 0.f;
#pragma unroll
    for (int r = 0; r < 16; r += 2) { if (r >= NEXP1) { p0[r] = __builtin_amdgcn_exp2f(p0[r]); p0[r + 1] = __builtin_amdgcn_exp2f(p0[r + 1]); }
        p1[r] = __builtin_amdgcn_exp2f(p1[r]); p1[r + 1] = __builtin_amdgcn_exp2f(p1[r + 1]);
        sa0 += p0[r]; sa1 += p0[r + 1]; sb0 += p1[r]; sb1 += p1[r + 1]; }
    asm volatile("" : "+v"(sa0), "+v"(sa1), "+v"(sb0), "+v"(sb1));
    s.l += (sa0 + sa1) + (sb0 + sb1);
    pw0 = (u32x4){cvt_pk_bf16(p0[0], p0[1]), cvt_pk_bf16(p0[2], p0[3]), cvt_pk_bf16(p0[4], p0[5]), cvt_pk_bf16(p0[6], p0[7])};
    pw1 = (u32x4){cvt_pk_bf16(p0[8], p0[9]), cvt_pk_bf16(p0[10], p0[11]), cvt_pk_bf16(p0[12], p0[13]), cvt_pk_bf16(p0[14], p0[15])};
    pw2 = (u32x4){cvt_pk_bf16(p1[0], p1[1]), cvt_pk_bf16(p1[2], p1[3]), cvt_pk_bf16(p1[4], p1[5]), cvt_pk_bf16(p1[6], p1[7])};
    pw3 = (u32x4){cvt_pk_bf16(p1[8], p1[9]), cvt_pk_bf16(p1[10], p1[11]), cvt_pk_bf16(p1[12], p1[13]), cvt_pk_bf16(p1[14], p1[15])};
}
__device__ __forceinline__ void sm_step32(SmState& s, f32x16& p0, LAS float* wsf, int r32, int hi, u32x4& pw0, u32x4& pw1) {
    float a = max3f(p0[0], p0[1], p0[2]), b = max3f(p0[3], p0[4], p0[5]);
    a = max3f(a, p0[6], p0[7]); b = max3f(b, p0[8], p0[9]); a = max3f(a, p0[10], p0[11]); b = max3f(b, p0[12], p0[13]); a = max3f(a, p0[14], p0[15]);
    const float rm = swap_max(fmaxf(a, b));
    if (__any(rm > (float)THRL)) { const float dl = fmaxf(rm, 0.f); s.mhat += dl;
#pragma unroll
        for (int r = 0; r < 16; ++r) { p0[r] -= dl; s.negm[r] = -s.mhat; }
        const float f = __builtin_amdgcn_exp2f(-dl); s.l *= f; if (hi == 0) wsf[r32] = f;
        asm volatile("s_waitcnt lgkmcnt(0)" ::: "memory"); MFMA_FENCE2(s.o[0], s.o[1]);
#pragma unroll
        for (int d = 0; d < 2; ++d)
#pragma unroll
            for (int r = 0; r < 16; ++r) s.o[d][r] *= wsf[crow(r, hi)];
        asm volatile("s_waitcnt lgkmcnt(0)" ::: "memory"); }
    float sum = 0.f;
#pragma unroll
    for (int r = 0; r < 16; ++r) { p0[r] = __builtin_amdgcn_exp2f(p0[r]); sum += p0[r]; }
    s.l += sum;
    pw0 = (u32x4){cvt_pk_bf16(p0[0], p0[1]), cvt_pk_bf16(p0[2], p0[3]), cvt_pk_bf16(p0[4], p0[5]), cvt_pk_bf16(p0[6], p0[7])};
    pw1 = (u32x4){cvt_pk_bf16(p0[8], p0[9]), cvt_pk_bf16(p0[10], p0[11]), cvt_pk_bf16(p0[12], p0[13]), cvt_pk_bf16(p0[14], p0[15])};
}
__device__ __forceinline__ float sm_finish(SmState& s, LAS float* wsf, LAS bf16* stg, bf16* orow0, long rstride, int lane, int r32, int hi, float* ssq_row0 = nullptr) {
    MFMA_FENCE2(s.o[0], s.o[1]);
    const float lt = swap_add(s.l);
    if (hi == 0) wsf[32 + r32] = lt;
    asm volatile("s_waitcnt lgkmcnt(0)" ::: "memory");
    float rl[16];
#pragma unroll
    for (int r = 0; r < 16; ++r) rl[r] = wsf[32 + crow(r, hi)];
    asm volatile("s_waitcnt lgkmcnt(0)" : "+v"(rl[0]), "+v"(rl[1]), "+v"(rl[2]), "+v"(rl[3]), "+v"(rl[4]), "+v"(rl[5]), "+v"(rl[6]), "+v"(rl[7]), "+v"(rl[8]), "+v"(rl[9]), "+v"(rl[10]), "+v"(rl[11]), "+v"(rl[12]), "+v"(rl[13]), "+v"(rl[14]), "+v"(rl[15]) :: "memory");
#pragma unroll
    for (int r = 0; r < 16; ++r) { const int orow = crow(r, hi); const float ri = __builtin_amdgcn_rcpf(rl[r]);
#pragma unroll
        for (int d0 = 0; d0 < 2; ++d0) stg[orow * 64 + d0 * 32 + r32] = (bf16)(cvt_pk_bf16(s.o[d0][r] * ri, 0.f) & 0xffffu); }
    asm volatile("s_waitcnt lgkmcnt(0)" ::: "memory");
#pragma unroll
    for (int i = 0; i < 4; ++i) { const int row = i * 8 + (lane >> 3), ch = lane & 7; const u32x4 v = *(const LAS u32x4*)(stg + row * 64 + ch * 8); *(u32x4*)(orow0 + (long)row * rstride + ch * 8) = v;
        if (ssq_row0) { float q = bf_lo(v.x) * bf_lo(v.x) + bf_hi(v.x) * bf_hi(v.x) + bf_lo(v.y) * bf_lo(v.y) + bf_hi(v.y) * bf_hi(v.y) + bf_lo(v.z) * bf_lo(v.z) + bf_hi(v.z) * bf_hi(v.z) + bf_lo(v.w) * bf_lo(v.w) + bf_hi(v.w) * bf_hi(v.w);
            q += swz_xor<1>(q); q += swz_xor<2>(q); q += swz_xor<4>(q); if (ch == 0) ssq_row0[row] = q; } }
    asm volatile("s_waitcnt lgkmcnt(0)" ::: "memory");
    return s.mhat + __builtin_amdgcn_logf(lt);
}

constexpr int L_K = 0, KSLOT = 12288, L_V = 3 * KSLOT, VSLOT = 8192, L_WS = L_V + 3 * VSLOT, L_OST = L_WS + 8 * 256, L_TB = L_OST + 8 * 4096, L_Q = L_TB + (256 + 4096) * 4, L_KM = L_Q + 16, L_END = L_KM + 16 * 64 * 4;
static_assert(L_END <= RING_BYTES, "attention LDS map");

__device__ __forceinline__ int wg_next(unsigned* ctr, LAS unsigned char* shm, int slot_off, int wave) {
    volatile LAS unsigned* slot = (volatile LAS unsigned*)(shm + slot_off);
    asm volatile("s_nop 15\n\ts_waitcnt vmcnt(0) lgkmcnt(0)\n\ts_barrier" ::: "memory");
    if (wave == 0 && lane_id() == 0) slot[0] = __hip_atomic_fetch_add(ctr, 1u, __ATOMIC_RELAXED, __HIP_MEMORY_SCOPE_AGENT);
    asm volatile("s_nop 15\n\ts_waitcnt vmcnt(0) lgkmcnt(0)\n\ts_barrier" ::: "memory");
    const unsigned v = slot[0];
    return (int)__builtin_amdgcn_readfirstlane(v);
}

__device__ __forceinline__ void mla_unit(int b, int h, int qb, const bf16* QM, const bf16* PROJ, bf16* OB, float* ssq_mix, LAS unsigned char* shm, const int wid) {
    const int lane = lane_id(), tid = wid * 64 + lane, r32 = lane & 31, hi = lane >> 5; (void)tid;
    const long rowbase = (long)b * SEQ; const int q0 = qb * 256;
    const unsigned lds0 = (unsigned)(uintptr_t)shm;
    LAS float* wsf = (LAS float*)(shm + L_WS) + wid * 64;
    const bf16* Qw = QM + (rowbase + q0 + wid * 32 + r32) * QP;
    bf16x8 qr[6];
#pragma unroll
    for (int d0 = 0; d0 < 4; ++d0) qr[d0] = *(const bf16x8*)(Qw + Q_NOPE + h * 64 + d0 * 16 + hi * 8);
#pragma unroll
    for (int d0 = 0; d0 < 2; ++d0) qr[4 + d0] = *(const bf16x8*)(Qw + Q_ROPE + h * 32 + d0 * 16 + hi * 8);
    asm volatile("" : "+v"(qr[0]), "+v"(qr[1]), "+v"(qr[2]), "+v"(qr[3]), "+v"(qr[4]), "+v"(qr[5]));
    const bf16* ksrc = QM + (rowbase + lane) * QP + Q_KV + h * 128 + wid * 8;
    const bf16* rsrc = PROJ + (rowbase + lane) * PP + C_KR + (wid & 3) * 8;
    const bf16* vsrc = QM + (rowbase + 16 * (wid & 3) + (lane >> 2)) * QP + Q_KV + h * 128 + 64 + (wid >> 2) * 32 + (lane & 3) * 8;
    const unsigned kdst = lds0 + L_K + wid * 1024, rdst = lds0 + L_K + (8 + (wid & 3)) * 1024, vdst = lds0 + L_V + wid * 1024;
    const int vb0 = (int)(lds0 + L_V) + ((lane >> 4) & 1) * 32 + (lane & 3) * 8 + (4 * hi + ((lane & 15) >> 2)) * 64;
    const lds_cptr kbase = (lds_cptr)(shm + L_K);
    const int NT = 4 * qb + 4, qrel = wid * 32 + r32;
    SmState st; sm_init(st);
    const bool halfB = wid >= 4;
#define MLA_K(t, s) do { glds16(ksrc + (long)(t) * 64 * QP, (unsigned)__builtin_amdgcn_readfirstlane(kdst + (s) * KSLOT)); \
        if (wid < 4) glds16(rsrc + (long)(t) * 64 * PP, (unsigned)__builtin_amdgcn_readfirstlane(rdst + (s) * KSLOT)); } while (0)
#define MLA_V(t, s) glds16(vsrc + (long)(t) * 64 * QP, (unsigned)__builtin_amdgcn_readfirstlane(vdst + (s) * VSLOT))
#define MLA_WODD(t) ATT_WAIT_BAR(0)
#define MLA_WEVEN(t) ATT_WAIT_BAR(0)
    f32x16 p0, p1; bool resc = false; u32x4 pw0, pw1, pw2, pw3;
#define ATT_SKIP(t) ((t) >= NT - 4 && 64 * ((t) - (NT - 4)) > 32 * wid + 31)
#define MLA_PART1(t, sl) do { if (ATT_SKIP(t)) resc = false; else { qkt_lds<6>(p0, p1, kbase + (sl) * KSLOT, qr, st.negm, r32, hi); if ((t) >= NT - 4) cmask(p0, p1, (t) - (NT - 4), qrel, hi); resc = sm_decide64(st, p0, p1, wsf, r32, hi); } } while (0)
#define MLA_PART2(t, sl) do { if (!ATT_SKIP(t)) { VFrag vf_; pv64_read(vf_, vb0 + (sl) * VSLOT); sm_exp64(st, resc, p0, p1, wsf, hi, pw0, pw1, pw2, pw3); \
        pv64_mma(st.o, vf_, __builtin_bit_cast(bf16x8, pw0), __builtin_bit_cast(bf16x8, pw1), __builtin_bit_cast(bf16x8, pw2), __builtin_bit_cast(bf16x8, pw3)); } } while (0)
    MLA_K(0, 0); MLA_V(0, 0);
    ATT_WAIT_BAR(0);
    if (!halfB) { int sc = 0;
        for (int t = 0; t < NT; ++t) { const int sn = sc == 2 ? 0 : sc + 1;
            if (t + 1 < NT) { MLA_K(t + 1, sn); MLA_V(t + 1, sn); }
            MLA_PART1(t, sc); MLA_PART2(t, sc); ATT_WAIT_BAR(0);
            sc = sn; }
        ATT_WAIT_BAR(0);
    } else { int sp = 0, sc = 1;
        if (1 < NT) { MLA_K(1, 1); MLA_V(1, 1); }
        MLA_PART1(0, 0); ATT_WAIT_BAR(0);
        for (int t = 1; t < NT; ++t) { const int sn = sc == 2 ? 0 : sc + 1;
            if (t + 1 < NT) { MLA_K(t + 1, sn); MLA_V(t + 1, sn); }
            MLA_PART2(t - 1, sp); MLA_PART1(t, sc); ATT_WAIT_BAR(0);
            sp = sc; sc = sn; }
        MLA_PART2(NT - 1, sp); ATT_WAIT_BAR(0);
    }
#undef MLA_K
#undef MLA_V
#undef MLA_WODD
#undef MLA_WEVEN
#undef MLA_PART1
#undef MLA_PART2
    (void)sm_finish(st, wsf, (LAS bf16*)(shm + L_OST) + wid * 2048, OB + (rowbase + q0 + wid * 32) * DM + O_B + h * 64, DM, lane, r32, hi, ssq_mix + (size_t)h * M + (rowbase + q0 + wid * 32));
}


typedef short v4i16_t __attribute__((ext_vector_type(4)));
__device__ __forceinline__ s16x4 vtr16(lds_cptr p) { return __builtin_bit_cast(s16x4, __builtin_amdgcn_ds_read_tr16_b64_v4i16((LAS v4i16_t*)p)); }
__device__ __forceinline__ float rowmax64(const f32x16& p0, const f32x16& p1) {
    float a = max3f(p0[0], p0[1], p1[0]), b = max3f(p0[2], p0[3], p1[1]); a = max3f(a, p1[2], p1[3]);
#pragma unroll
    for (int r = 4; r < 16; r += 4) { a = max3f(a, p0[r], p0[r + 1]); b = max3f(b, p0[r + 2], p0[r + 3]); a = max3f(a, p1[r], p1[r + 1]); b = max3f(b, p1[r + 2], p1[r + 3]); }
    return swap_max(fmaxf(a, b));
}
#define PINV(x) asm volatile("" : "+v"(x))
#define MF32(a, b, c) __builtin_amdgcn_mfma_f32_32x32x16_bf16(a, b, c, 0, 0, 0)
__device__ __forceinline__ void mla_unit2(int b, int h, int qb, const bf16* QM, const bf16* PROJ, bf16* OB, float* ssq_mix, LAS unsigned char* shm, const int wid) {
    const int lane = lane_id(), r32 = lane & 31, hi = lane >> 5;
    const long rowbase = (long)b * SEQ; const int q0 = qb * 256;
    const unsigned lds0 = (unsigned)(uintptr_t)shm;
    LAS float* wsf = (LAS float*)(shm + L_WS) + wid * 64;
    const bf16* Qw = QM + (rowbase + q0 + wid * 32 + r32) * QP;
    bf16x8 qr[6];
#pragma unroll
    for (int d0 = 0; d0 < 4; ++d0) qr[d0] = *(const bf16x8*)(Qw + Q_NOPE + h * 64 + d0 * 16 + hi * 8);
#pragma unroll
    for (int d0 = 0; d0 < 2; ++d0) qr[4 + d0] = *(const bf16x8*)(Qw + Q_ROPE + h * 32 + d0 * 16 + hi * 8);
    asm volatile("" : "+v"(qr[0]), "+v"(qr[1]), "+v"(qr[2]), "+v"(qr[3]), "+v"(qr[4]), "+v"(qr[5]));
    const bf16* kbase_g = QM + rowbase * QP + Q_KV + h * 128 + wid * 8; const unsigned koff = (unsigned)(lane * QP * 2);
    const bf16* rbase_g = PROJ + rowbase * PP + C_KR + (wid & 3) * 8; const unsigned roff = (unsigned)(lane * PP * 2);
    const bf16* vbase_g = QM + (rowbase + 16 * (wid & 3)) * QP + Q_KV + h * 128 + 64 + (wid >> 2) * 32; const unsigned voff_ = (unsigned)(((lane >> 2) * QP + (lane & 3) * 8) * 2);
    const unsigned kdst = lds0 + L_K + wid * 1024, rdst = lds0 + L_K + (8 + (wid & 3)) * 1024, vdst = lds0 + L_V + wid * 1024;
#define U2_K(t, s) do { glds16s(kbase_g + (long)(t) * 64 * QP, koff, (unsigned)__builtin_amdgcn_readfirstlane(kdst + (s) * KSLOT)); \
        if (wid < 4) glds16s(rbase_g + (long)(t) * 64 * PP, roff, (unsigned)__builtin_amdgcn_readfirstlane(rdst + (s) * KSLOT)); } while (0)
#define U2_V(t, s) glds16s(vbase_g + (long)(t) * 64 * QP, voff_, (unsigned)__builtin_amdgcn_readfirstlane(vdst + (s) * VSLOT))
    const lds_cptr vp0 = (lds_cptr)(shm + L_V) + ((lane >> 4) & 1) * 32 + (lane & 3) * 8 + (4 * hi + ((lane & 15) >> 2)) * 64;
    const lds_cptr kp0 = (lds_cptr)(shm + L_K) + hi * 1024 + r32 * 16;
    const int NT = 4 * qb + 4, qrel = wid * 32 + r32;
    SmState st; sm_init(st); PINV(st.negm);
    bool resc = false;
    f32x16 pA0, pA1, pB0, pB1; bf16x8 kf[8]; s16x4 vlo[8], vhi[8]; u32x4 pw0, pw1, pw2, pw3;
    int sl_prev = 0, sl_cur = 0, sl_next = 1;
#define U2_ROT() do { sl_prev = sl_cur; sl_cur = sl_next; sl_next = (sl_next == 2) ? 0 : sl_next + 1; } while (0)
#define U2_KLOAD2(kp, d0) do { kf[2 * (d0)] = *(const LAS bf16x8*)((kp) + (d0) * 2048); kf[2 * (d0) + 1] = *(const LAS bf16x8*)((kp) + (d0) * 2048 + 512); } while (0)
#define U2_RESC() do { if (resc) { _Pragma("unroll") for (int d_ = 0; d_ < 2; ++d_) _Pragma("unroll") for (int r = 0; r < 16; ++r) st.o[d_][r] *= wsf[crow(r, hi)]; } } while (0)
    U2_K(0, 0); U2_V(0, 0); U2_K(1, 1); U2_K(2, 2); U2_V(1, 1);
    ATT_WAIT_BAR(0);
    { bf16x8 k0[12];
#pragma unroll
      for (int d0 = 0; d0 < 6; ++d0) { k0[2 * d0] = *(const LAS bf16x8*)(kp0 + d0 * 2048); k0[2 * d0 + 1] = *(const LAS bf16x8*)(kp0 + d0 * 2048 + 512); }
      ATT_SBAR();
      pA0 = MF32(k0[0], qr[0], st.negm); pA1 = MF32(k0[1], qr[0], st.negm);
#pragma unroll
      for (int d0 = 1; d0 < 6; ++d0) { pA0 = MF32(k0[2 * d0], qr[d0], pA0); pA1 = MF32(k0[2 * d0 + 1], qr[d0], pA1); } }
    if (NT == 4) cmask(pA0, pA1, 0, qrel, hi);
    { const float rm = rowmax64(pA0, pA1); st.mhat = rm;
#pragma unroll
      for (int r = 0; r < 16; ++r) { pA0[r] = __builtin_amdgcn_exp2f(pA0[r] - rm); pA1[r] = __builtin_amdgcn_exp2f(pA1[r] - rm); st.negm[r] = -rm; } }
    PINV(pA0); PINV(pA1); PINV(st.negm); ATT_SBAR();
    ATT_WAIT_BAR(0);
    U2_ROT();
#pragma unroll
    for (int d0 = 0; d0 < 4; ++d0) U2_KLOAD2(kp0 + sl_cur * KSLOT, d0);
#define U2_PKW(P, i) cvt_pk_bf16(P[i], P[(i) + 1])
#define U2_PAF(k) __builtin_bit_cast(bf16x8, pw##k)
#define U2_VFR(i) (bf16x8){vlo[i][0], vlo[i][1], vlo[i][2], vlo[i][3], vhi[i][0], vhi[i][1], vhi[i][2], vhi[i][3]}
#define U2_VRD(i) do { vlo[i] = vtr16(vp_ + (((i) >> 2) * 4096 + ((i) & 3) * 1024)); vhi[i] = vtr16(vp_ + (((i) >> 2) * 4096 + ((i) & 3) * 1024 + 512)); } while (0)
#define U2_KRD(G, d0) do { if (G) { U2_KLOAD2(kp0 + sl_next * KSLOT, d0); ATT_SBAR(); } } while (0)
#define U2_GAPA(MF, a0, a1, a2, a3, W0, W1, PW) do { MF; sacc += a0; sacc += a1; sacc += a2; sacc += a3; W0; W1; PINV(PW); PINV(sacc); ATT_SBAR(); } while (0)
#define U2_GAPB(MF, X, i) do { MF; X[i] = __builtin_amdgcn_exp2f(X[i]); X[(i) + 1] = __builtin_amdgcn_exp2f(X[(i) + 1]); X[(i) + 2] = __builtin_amdgcn_exp2f(X[(i) + 2]); X[(i) + 3] = __builtin_amdgcn_exp2f(X[(i) + 3]); PINV(X); ATT_SBAR(); } while (0)
#define U2_STEP(C0, C1, P0, P1, t, MASK, GK, GV, GL) do { ATT_SBAR(); \
    if (GK) U2_K((t) + 2, sl_prev); if (GV) U2_V((t) + 1, sl_next); \
    const lds_cptr vp_ = vp0 + sl_prev * VSLOT; \
    float sacc = P0[0] + P0[1]; \
    U2_GAPA(C0 = MF32(kf[0], qr[0], st.negm), P0[2], P0[3], P0[4], P0[5],     pw0[0] = U2_PKW(P0, 0),  pw0[1] = U2_PKW(P0, 2),  pw0); \
    U2_GAPA(C1 = MF32(kf[1], qr[0], st.negm), P0[6], P0[7], P0[8], P0[9],     pw0[2] = U2_PKW(P0, 4),  pw0[3] = U2_PKW(P0, 6),  pw0); \
    U2_GAPA(C0 = MF32(kf[2], qr[1], C0),      P0[10], P0[11], P0[12], P0[13], pw1[0] = U2_PKW(P0, 8),  pw1[1] = U2_PKW(P0, 10), pw1); \
    U2_GAPA(C1 = MF32(kf[3], qr[1], C1),      P0[14], P0[15], P1[0], P1[1],   pw1[2] = U2_PKW(P0, 12), pw1[3] = U2_PKW(P0, 14), pw1); \
    bf16x8 kr_[4]; { const lds_cptr kq_ = kp0 + sl_cur * KSLOT; kr_[0] = *(const LAS bf16x8*)(kq_ + 4 * 2048); kr_[1] = *(const LAS bf16x8*)(kq_ + 4 * 2048 + 512); kr_[2] = *(const LAS bf16x8*)(kq_ + 5 * 2048); kr_[3] = *(const LAS bf16x8*)(kq_ + 5 * 2048 + 512); } ATT_SBAR();     \
    U2_GAPA(C0 = MF32(kf[4], qr[2], C0),      P1[2], P1[3], P1[4], P1[5],     pw2[0] = U2_PKW(P1, 0),  pw2[1] = U2_PKW(P1, 2),  pw2); \
    U2_GAPA(C1 = MF32(kf[5], qr[2], C1),      P1[6], P1[7], P1[8], P1[9],     pw2[2] = U2_PKW(P1, 4),  pw2[3] = U2_PKW(P1, 6),  pw2); \
    U2_GAPA(C0 = MF32(kf[6], qr[3], C0),      P1[10], P1[11], P1[12], P1[13], pw3[0] = U2_PKW(P1, 8),  pw3[1] = U2_PKW(P1, 10), pw3); \
    U2_GAPA(C1 = MF32(kf[7], qr[3], C1),      P1[14], P1[15], 0.f, 0.f,       pw3[2] = U2_PKW(P1, 12), pw3[3] = U2_PKW(P1, 14), pw3); \
    C0 = MF32(kr_[0], qr[4], C0); C1 = MF32(kr_[1], qr[4], C1); C0 = MF32(kr_[2], qr[5], C0); C1 = MF32(kr_[3], qr[5], C1); \
    U2_VRD(0); U2_VRD(4); U2_VRD(1); U2_VRD(5); U2_VRD(2); U2_VRD(6); U2_VRD(3); U2_VRD(7); ATT_SBAR();     \
    st.l += sacc; \
    if (MASK) cmask(C0, C1, (t) - (NT - 4), qrel, hi); \
    { const float rm = rowmax64(C0, C1); resc = false; \
      if (__builtin_expect(__any(rm > (float)THRL), 0)) { const float dl = fmaxf(rm, 0.f); st.mhat += dl; \
          _Pragma("unroll") for (int r = 0; r < 16; ++r) { C0[r] -= dl; C1[r] -= dl; st.negm[r] = -st.mhat; } \
          const float f = __builtin_amdgcn_exp2f(-dl); st.l *= f; if (hi == 0) wsf[r32] = f; resc = true; } } \
    ATT_SBAR(); \
    U2_GAPB(st.o[0] = MF32(U2_PAF(0), U2_VFR(0), st.o[0]), C0, 0); \
    U2_GAPB(st.o[1] = MF32(U2_PAF(0), U2_VFR(4), st.o[1]), C0, 4);  U2_KRD(GL, 0); \
    U2_GAPB(st.o[0] = MF32(U2_PAF(1), U2_VFR(1), st.o[0]), C0, 8); \
    U2_GAPB(st.o[1] = MF32(U2_PAF(1), U2_VFR(5), st.o[1]), C0, 12); U2_KRD(GL, 1); \
    U2_GAPB(st.o[0] = MF32(U2_PAF(2), U2_VFR(2), st.o[0]), C1, 0);  U2_KRD(GL, 2); \
    U2_GAPB(st.o[1] = MF32(U2_PAF(2), U2_VFR(6), st.o[1]), C1, 4);  U2_KRD(GL, 3); \
    U2_GAPB(st.o[0] = MF32(U2_PAF(3), U2_VFR(3), st.o[0]), C1, 8); \
    U2_GAPB(st.o[1] = MF32(U2_PAF(3), U2_VFR(7), st.o[1]), C1, 12); \
    } while (0)
    ATT_WAIT_BAR(0);
    int t = 1;
    for (; t + 1 < NT - 4; t += 2) {
        U2_STEP(pB0, pB1, pA0, pA1, t, false, true, true, true);     ATT_WAIT_BAR(0); U2_RESC(); U2_ROT();
        U2_STEP(pA0, pA1, pB0, pB1, t + 1, false, true, true, true); ATT_WAIT_BAR(0); U2_RESC(); U2_ROT();
    }
    for (; t + 1 < NT; t += 2) {
        U2_STEP(pB0, pB1, pA0, pA1, t, true, (t + 2 < NT), (t + 1 < NT), (t + 1 < NT));         ATT_WAIT_BAR(0); U2_RESC(); U2_ROT();
        U2_STEP(pA0, pA1, pB0, pB1, t + 1, true, (t + 3 < NT), (t + 2 < NT), (t + 2 < NT));     ATT_WAIT_BAR(0); U2_RESC(); U2_ROT();
    }
    U2_STEP(pB0, pB1, pA0, pA1, NT - 1, true, false, false, false); U2_RESC();
    { float sacc = pB0[0] + pB0[1];
#pragma unroll
      for (int r = 2; r < 16; ++r) sacc += pB0[r];
#pragma unroll
      for (int r = 0; r < 16; ++r) sacc += pB1[r];
      st.l += sacc;
      pw0 = (u32x4){U2_PKW(pB0, 0), U2_PKW(pB0, 2), U2_PKW(pB0, 4), U2_PKW(pB0, 6)}; pw1 = (u32x4){U2_PKW(pB0, 8), U2_PKW(pB0, 10), U2_PKW(pB0, 12), U2_PKW(pB0, 14)};
      pw2 = (u32x4){U2_PKW(pB1, 0), U2_PKW(pB1, 2), U2_PKW(pB1, 4), U2_PKW(pB1, 6)}; pw3 = (u32x4){U2_PKW(pB1, 8), U2_PKW(pB1, 10), U2_PKW(pB1, 12), U2_PKW(pB1, 14)};
      const lds_cptr vp_ = vp0 + sl_cur * VSLOT;
#pragma unroll
      for (int i = 0; i < 8; ++i) U2_VRD(i);
      st.o[0] = MF32(U2_PAF(0), U2_VFR(0), st.o[0]); st.o[1] = MF32(U2_PAF(0), U2_VFR(4), st.o[1]); st.o[0] = MF32(U2_PAF(1), U2_VFR(1), st.o[0]); st.o[1] = MF32(U2_PAF(1), U2_VFR(5), st.o[1]);
      st.o[0] = MF32(U2_PAF(2), U2_VFR(2), st.o[0]); st.o[1] = MF32(U2_PAF(2), U2_VFR(6), st.o[1]); st.o[0] = MF32(U2_PAF(3), U2_VFR(3), st.o[0]); st.o[1] = MF32(U2_PAF(3), U2_VFR(7), st.o[1]); }
    ATT_WAIT_BAR(0);
#undef U2_K
#undef U2_V
#undef U2_ROT
#undef U2_KLOAD2
#undef U2_RESC
#undef U2_PKW
#undef U2_PAF
#undef U2_VFR
#undef U2_VRD
#undef U2_KRD
#undef U2_GAPA
#undef U2_GAPB
#undef U2_STEP
    (void)sm_finish(st, wsf, (LAS bf16*)(shm + L_OST) + wid * 2048, OB + (rowbase + q0 + wid * 32) * DM + O_B + h * 64, DM, lane, r32, hi, ssq_mix + (size_t)h * M + (rowbase + q0 + wid * 32));
}

__device__ __forceinline__ void moba_unit(int b, int h, int j, const bf16* PROJ, const float* kmean, const float* tmoba, bf16* OB, float* ssq_mix, LAS unsigned char* shm, const int wid) {
    const int lane = lane_id(), tid = wid * 64 + lane, r32 = lane & 31, hi = lane >> 5;
    const long rowbase = (long)b * SEQ; const int q0 = j * 256;
    const unsigned lds0 = (unsigned)(uintptr_t)shm;
    LAS float* wsf = (LAS float*)(shm + L_WS) + wid * 64;
    LAS float* tb = (LAS float*)(shm + L_TB);
    { float tv[9];
#pragma unroll
      for (int k = 0; k < 9; ++k) { const int i = tid + k * (NWAVES * 64); tv[k] = (i >= 256 && i < 256 + 4096) ? tmoba[h * 4096 + i - 256] : 0.f; }
#pragma unroll
      for (int k = 0; k < 9; ++k) { const int i = tid + k * (NWAVES * 64); if (i < 256 + 4096) tb[i] = tv[k]; } }
    LAS float* kml = (LAS float*)(shm + L_KM);
    for (int i = tid; i < j * 64; i += NWAVES * 64) kml[i] = kmean[((size_t)(b * 16 + (i >> 6)) * 4 + h) * 64 + (i & 63)];
    asm volatile("s_nop 15\n\ts_waitcnt vmcnt(0) lgkmcnt(0)\n\ts_barrier" ::: "memory");
    const float c31 = tb[256 + 4095];
    const bf16* Qw = PROJ + (rowbase + q0 + wid * 32 + r32) * PP + C_QC + h * 64;
    bf16x8 qr[4];
#pragma unroll
    for (int d0 = 0; d0 < 4; ++d0) qr[d0] = *(const bf16x8*)(Qw + d0 * 16 + hi * 8);
    float g1 = -INFINITY, g2 = -INFINITY, g3 = -INFINITY; float gate[16];
#pragma unroll
    for (int blk = 0; blk < 16; ++blk) { float s = -INFINITY;
        if (blk < j) { const LAS float* km = kml + blk * 64 + hi * 8; float a = 0.f;
#pragma unroll
            for (int d0 = 0; d0 < 4; ++d0) { const f32x4 k0 = *(const LAS f32x4*)(km + d0 * 16), k1 = *(const LAS f32x4*)(km + d0 * 16 + 4); const u32x4 q = __builtin_bit_cast(u32x4, qr[d0]);
                a = fmaf(bf_lo(q.x), k0[0], a); a = fmaf(bf_hi(q.x), k0[1], a); a = fmaf(bf_lo(q.y), k0[2], a); a = fmaf(bf_hi(q.y), k0[3], a);
                a = fmaf(bf_lo(q.z), k1[0], a); a = fmaf(bf_hi(q.z), k1[1], a); a = fmaf(bf_lo(q.w), k1[2], a); a = fmaf(bf_hi(q.w), k1[3], a); }
            s = swap_add(a); }
        gate[blk] = s;
        if (s > g1) { g3 = g2; g2 = g1; g1 = s; } else if (s > g2) { g3 = g2; g2 = s; } else if (s > g3) { g3 = s; } }
    unsigned sel = 0u;
#pragma unroll
    for (int blk = 0; blk < 16; ++blk) if (blk < j && gate[blk] >= g3) sel |= 1u << blk;
    const bf16* ksrc = PROJ + (rowbase + lane) * PP + C_KC + h * 64 + wid * 8;
    const bf16* vsrc = PROJ + (rowbase + 16 * (wid & 3) + (lane >> 2)) * PP + C_VC + h * 64 + (wid >> 2) * 32 + (lane & 3) * 8;
    const unsigned kdst = lds0 + L_K + wid * 1024, vdst = lds0 + L_V + wid * 1024;
    const int vb0 = (int)(lds0 + L_V) + ((lane >> 4) & 1) * 32 + (lane & 3) * 8 + (4 * hi + ((lane & 15) >> 2)) * 64;
    const lds_cptr kbase = (lds_cptr)(shm + L_K);
    const int NT = 4 * j + 4, qrel = wid * 32 + r32;
    SmState st; sm_init(st);
    const bool halfB = wid >= 4;
#define MOBA_K(t, s) glds16(ksrc + (long)(t) * 64 * PP, (unsigned)__builtin_amdgcn_readfirstlane(kdst + (s) * KSLOT))
#define MOBA_V(t, s) glds16(vsrc + (long)(t) * 64 * PP, (unsigned)__builtin_amdgcn_readfirstlane(vdst + (s) * VSLOT))
#define MOBA_W(t) ATT_WAIT_BAR(0)
    f32x16 p0, p1; bool resc = false; u32x4 pw0, pw1, pw2, pw3;
#define MOBA_PART1(t, sl) do { if (ATT_SKIP(t)) resc = false; else { const int blk_ = (t) >> 2; const bool on_ = (blk_ == j) || ((sel >> blk_) & 1u); f32x16 c0_; \
        const bool far_ = (q0 - 64 * (t) - 63) >= 1536;     \
        const float cv_ = on_ ? st.negm[0] + (far_ ? c31 : 0.f) : -INFINITY;     \
        _Pragma("unroll") for (int r = 0; r < 16; ++r) c0_[r] = cv_; \
        if (far_) qkt_lds<4>(p0, p1, kbase + (sl) * KSLOT, qr, c0_, r32, hi); \
        else { float tbv_[32];     \
          const LAS float* lb_ = tb + (256 + q0 + qrel - 64 * (t) - 4 * hi - 27 - 32); \
          _Pragma("unroll") for (int r = 0; r < 16; ++r) { const int c_ = (r & 3) + 8 * (r >> 2); tbv_[r] = lb_[32 + 27 - c_]; tbv_[16 + r] = lb_[27 - c_]; } \
          qkt_lds<4>(p0, p1, kbase + (sl) * KSLOT, qr, c0_, r32, hi); \
          if (blk_ == j) cmask(p0, p1, (t) & 3, qrel, hi); \
          _Pragma("unroll") for (int r = 0; r < 16; ++r) { p0[r] += tbv_[r]; p1[r] += tbv_[16 + r]; } } \
        resc = sm_decide64(st, p0, p1, wsf, r32, hi); } } while (0)
#define MOBA_PART2(t, sl) do { if (!ATT_SKIP(t)) { VFrag vf_; pv64_read(vf_, vb0 + (sl) * VSLOT); sm_exp64(st, resc, p0, p1, wsf, hi, pw0, pw1, pw2, pw3); \
        pv64_mma(st.o, vf_, __builtin_bit_cast(bf16x8, pw0), __builtin_bit_cast(bf16x8, pw1), __builtin_bit_cast(bf16x8, pw2), __builtin_bit_cast(bf16x8, pw3)); } } while (0)
    MOBA_K(0, 0); MOBA_V(0, 0);
    ATT_WAIT_BAR(0);
    if (!halfB) { int sc = 0;
        for (int t = 0; t < NT; ++t) { const int sn = sc == 2 ? 0 : sc + 1;
            if (t + 1 < NT) { MOBA_K(t + 1, sn); MOBA_V(t + 1, sn); }
            MOBA_PART1(t, sc); MOBA_PART2(t, sc); ATT_WAIT_BAR(0);
            sc = sn; }
        ATT_WAIT_BAR(0);
    } else { int sp = 0, sc = 1;
        if (1 < NT) { MOBA_K(1, 1); MOBA_V(1, 1); }
        MOBA_PART1(0, 0); ATT_WAIT_BAR(0);
        for (int t = 1; t < NT; ++t) { const int sn = sc == 2 ? 0 : sc + 1;
            if (t + 1 < NT) { MOBA_K(t + 1, sn); MOBA_V(t + 1, sn); }
            MOBA_PART2(t - 1, sp); MOBA_PART1(t, sc); ATT_WAIT_BAR(0);
            sp = sc; sc = sn; }
        MOBA_PART2(NT - 1, sp); ATT_WAIT_BAR(0);
    }
#undef MOBA_K
#undef MOBA_V
#undef MOBA_W
#undef MOBA_PART1
#undef MOBA_PART2
    (void)sm_finish(st, wsf, (LAS bf16*)(shm + L_OST) + wid * 2048, OB + (rowbase + q0 + wid * 32) * DM + O_C + h * 64, DM, lane, r32, hi, ssq_mix + (size_t)(6 + h) * M + (rowbase + q0 + wid * 32));
}

constexpr int D_V = 0, D_WS = 65536, D_OST = D_WS + 8 * 256, D_TB = D_OST + 8 * 4096, D_Q = D_TB + 3 * 6 * 192 * 4, D_END = D_Q + 16;
static_assert(D_END <= RING_BYTES, "dilated LDS map");
__device__ __forceinline__ void dil_task(int p, int b, int h, int r, int m0, const bf16* PROJ, bf16* OPART, float* LSE, LAS unsigned char* shm, int wid, int lane) {
    const int r32 = lane & 31, hi = lane >> 5, sh = 2 * p;
    const long rowbase = (long)b * SEQ;
    const unsigned lds0 = (unsigned)(uintptr_t)shm;
    LAS float* wsf = (LAS float*)(shm + D_WS) + wid * 64;
    const LAS float* tbl = (const LAS float*)(shm + D_TB) + (p * 6 + h) * 192 + 32;
    const unsigned vslot0 = lds0 + D_V + wid * 8192;
    const int tq = r + ((m0 + r32) << sh);
    const bf16* Qw = PROJ + (rowbase + tq) * PP + C_QA + h * 64;
    bf16x8 qr[4];
#pragma unroll
    for (int d0 = 0; d0 < 4; ++d0) qr[d0] = *(const bf16x8*)(Qw + d0 * 16 + hi * 8);
    const int g0 = (4 - (m0 >> 5)) > 0 ? (4 - (m0 >> 5)) : 0;
    bf16x8 kc[4], kn[4];
#define DIL_LOADK(dst, g) do { const int ks_ = m0 - 128 + 32 * (g) + r32; const bf16* kp_ = PROJ + (rowbase + r + ((long)ks_ << sh)) * PP + C_KA + h * 64 + hi * 8; \
        _Pragma("unroll") for (int d0 = 0; d0 < 4; ++d0) dst[d0] = *(const bf16x8*)(kp_ + d0 * 16); } while (0)
#define DIL_LOADV(VD, g) do { _Pragma("unroll") for (int pc = 0; pc < 4; ++pc) { const int dh_ = pc >> 1, rg_ = pc & 1; const int ks_ = m0 - 128 + 32 * (g) + 16 * rg_ + (lane >> 2); \
            VD[pc] = *(const u32x4*)(PROJ + (rowbase + r + ((long)ks_ << sh)) * PP + C_VA + h * 64 + dh_ * 32 + (lane & 3) * 8); } } while (0)
#define DIL_STV(VS, g) do { _Pragma("unroll") for (int pc = 0; pc < 4; ++pc) *(LAS u32x4*)(shm + D_V + wid * 8192 + ((g) & 1) * 2048 + (pc >> 1) * 4096 + (pc & 1) * 1024 + lane * 16) = VS[pc]; } while (0)
    u32x4 vc[4], vn[4], vf[4]; bf16x8 kf[4];
    const int vb0 = (int)vslot0 + ((lane >> 4) & 1) * 32 + (lane & 3) * 8 + (4 * hi + ((lane & 15) >> 2)) * 64;
    SmState st; sm_init(st);
    DIL_LOADV(vc, g0); DIL_LOADK(kc, g0);
    if (g0 + 1 < 5) { DIL_LOADV(vn, g0 + 1); DIL_LOADK(kn, g0 + 1); } else { _Pragma("unroll") for (int d0 = 0; d0 < 4; ++d0) { kn[d0] = kc[d0]; vn[d0] = vc[d0]; } }
    for (int g = g0; g < 5; ++g) {
        if (g + 2 < 5) { DIL_LOADV(vf, g + 2); DIL_LOADK(kf, g + 2); } else { _Pragma("unroll") for (int d0 = 0; d0 < 4; ++d0) { kf[d0] = kn[d0]; vf[d0] = vn[d0]; } }
        DIL_STV(vc, g);
        float tb_[16];
        { const LAS float* lb = tbl + (128 - 32 * g) + r32 - 4 * hi - 27;
#pragma unroll
          for (int rr = 0; rr < 16; ++rr) tb_[rr] = lb[27 - ((rr & 3) + 8 * (rr >> 2))]; }
        ATT_SBAR();
        f32x16 p0;
#pragma unroll
        for (int d0 = 0; d0 < 4; ++d0) p0 = __builtin_amdgcn_mfma_f32_32x32x16_bf16(kc[d0], qr[d0], d0 == 0 ? st.negm : p0, 0, 0, 0);
        MFMA_FENCE1(p0);
        if (g == 0) {
#pragma unroll
            for (int rr = 0; rr < 16; ++rr) if (crow(rr, hi) < r32) p0[rr] = -INFINITY; }
        if (g == 4) {
#pragma unroll
            for (int rr = 0; rr < 16; ++rr) if (crow(rr, hi) > r32) p0[rr] = -INFINITY; }
#pragma unroll
        for (int rr = 0; rr < 16; ++rr) p0[rr] += tb_[rr];
        u32x4 pw0, pw1; sm_step32(st, p0, wsf, r32, hi, pw0, pw1);
        pv32(st.o, vb0 + (g & 1) * 2048, __builtin_bit_cast(bf16x8, pw0), __builtin_bit_cast(bf16x8, pw1));
#pragma unroll
        for (int d0 = 0; d0 < 4; ++d0) { kc[d0] = kn[d0]; kn[d0] = kf[d0]; vc[d0] = vn[d0]; vn[d0] = vf[d0]; }
    }
#undef DIL_LOADV
#undef DIL_LOADK
#undef DIL_STV
    bf16* orow0 = OPART + ((size_t)p * M + rowbase + r + ((long)m0 << sh)) * 384 + h * 64;
    const float lse = sm_finish(st, wsf, (LAS bf16*)(shm + D_OST) + wid * 2048, orow0, (long)384 << sh, lane, r32, hi);
    if (hi == 0) LSE[((size_t)(p * NB + b) * 6 + h) * SEQ + (size_t)r * (SEQ >> sh) + m0 + r32] = lse;
}

constexpr int DU_K = 0, DU_V = 49152, DU_WS = 98304, DU_OST = 0;
static_assert(DU_WS + 8 * 256 == D_TB && DU_V + 6 * 8192 == DU_WS, "dilated unit LDS map");
__device__ __forceinline__ int du_swz(int c) { return (c & 7) ^ ((c & 1) << 3); }
struct DuId { int p, b, h, r, m0u; };
__device__ __forceinline__ DuId du_decode(int id) { DuId d; d.h = id % H_DIL; const int rest = id / H_DIL; d.p = rest >> 7; d.b = (rest >> 4) & 7; const int uu = rest & 15, per = 16 >> (2 * d.p); d.r = uu / per; d.m0u = 256 * (uu % per); return d; }
constexpr int DU_N = 3 * NB * 16 * H_DIL;
struct DuRegs { u32x4 kv[6], vv[6]; bf16x8 qr[4]; };
__device__ __forceinline__ void du_load(DuRegs& R, const DuId& u, const bf16* PROJ, int wid, int lane) {
    const int r32 = lane & 31, hi = lane >> 5, sh = 2 * u.p; const long rowbase = (long)u.b * SEQ;
    const bf16* Qw = PROJ + (rowbase + u.r + ((long)(u.m0u + 32 * wid + r32) << sh)) * PP + C_QA + u.h * 64;
#pragma unroll
    for (int d0 = 0; d0 < 4; ++d0) R.qr[d0] = *(const bf16x8*)(Qw + d0 * 16 + hi * 8);
    const int t = wid * 64 + lane, row8 = t >> 3, c8 = t & 7;
#pragma unroll
    for (int n = 0; n < 6; ++n) { const int ks = u.m0u - 128 + n * 64 + row8;
        const bf16* src = PROJ + (rowbase + u.r + ((long)(ks < 0 ? 0 : ks) << sh)) * PP + u.h * 64 + c8 * 8;
        R.kv[n] = *(const u32x4*)(src + C_KA); R.vv[n] = *(const u32x4*)(src + C_VA); }
}
__device__ __forceinline__ void dil_units(unsigned* qctr, const bf16* PROJ, bf16* OPART, float* LSE, LAS unsigned char* shm, const int wid) {
    const int lane = lane_id(), r32 = lane & 31, hi = lane >> 5;
    const unsigned lds0 = (unsigned)(uintptr_t)shm;
    LAS float* wsf = (LAS float*)(shm + DU_WS) + wid * 64;
    volatile LAS unsigned* slot = (volatile LAS unsigned*)(shm + D_Q);
    int cur = wg_next(qctr, shm, D_Q, wid); if (cur >= DU_N) return;
    int nxt = wg_next(qctr, shm, D_Q, wid);
    DuRegs R; du_load(R, du_decode(cur), PROJ, wid, lane);
    const bool t0 = wid == 0 && lane == 0;
    for (;;) {
        const DuId u = du_decode(cur); const int sh = 2 * u.p; const long rowbase = (long)u.b * SEQ;
        unsigned ahead = 0u; if (t0) ahead = __hip_atomic_fetch_add(qctr, 1u, __ATOMIC_RELAXED, __HIP_MEMORY_SCOPE_AGENT);
        { const int t = wid * 64 + lane, row8 = t >> 3, c8 = t & 7;
#pragma unroll
          for (int n = 0; n < 6; ++n) { const int i = n * 64 + row8, G = i >> 5, kk = i & 31;
              *(LAS u32x4*)(shm + DU_K + G * 4096 + c8 * 512 + ((kk ^ du_swz(c8)) * 16)) = R.kv[n];
              *(LAS u32x4*)(shm + DU_V + (G >> 1) * 8192 + (G & 1) * 2048 + (c8 >> 2) * 4096 + (kk >> 4) * 1024 + (kk & 15) * 64 + (c8 & 3) * 16) = R.vv[n]; } }
        bf16x8 qr[4];
#pragma unroll
        for (int d0 = 0; d0 < 4; ++d0) qr[d0] = R.qr[d0];
        asm volatile("s_nop 15\n\ts_waitcnt lgkmcnt(0)\n\ts_barrier" ::: "memory");
        if (nxt < DU_N) du_load(R, du_decode(nxt), PROJ, wid, lane);
        const LAS float* tbl = (const LAS float*)(shm + D_TB) + (u.p * 6 + u.h) * 192 + 32;
        const int m0 = u.m0u + 32 * wid;
        const int g0 = (4 - (m0 >> 5)) > 0 ? (4 - (m0 >> 5)) : 0;
        const int vbl = (int)(lds0 + DU_V) + ((lane >> 4) & 1) * 32 + (lane & 3) * 8 + (4 * hi + ((lane & 15) >> 2)) * 64;
        SmState st; sm_init(st);
        for (int g = g0; g < 5; ++g) { const int G = wid + g;
            float tb_[16]; bf16x8 kf[4];
            { const LAS float* lb = tbl + (128 - 32 * g) + r32 - 4 * hi - 27;
#pragma unroll
              for (int rr = 0; rr < 16; ++rr) tb_[rr] = lb[27 - ((rr & 3) + 8 * (rr >> 2))]; }
#pragma unroll
            for (int d0 = 0; d0 < 4; ++d0) kf[d0] = *(const LAS bf16x8*)(shm + DU_K + G * 4096 + (2 * d0 + hi) * 512 + ((r32 ^ du_swz(2 * d0 + hi)) * 16));
            ATT_SBAR();
            f32x16 p0;
#pragma unroll
            for (int d0 = 0; d0 < 4; ++d0) p0 = __builtin_amdgcn_mfma_f32_32x32x16_bf16(kf[d0], qr[d0], d0 == 0 ? st.negm : p0, 0, 0, 0);
            V32 vf_; pv32_read(vf_, vbl + (G >> 1) * 8192 + (G & 1) * 2048);
            MFMA_FENCE1(p0);
            if (g == 0) {
#pragma unroll
                for (int rr = 0; rr < 16; ++rr) if (crow(rr, hi) < r32) p0[rr] = -INFINITY; }
            if (g == 4) {
#pragma unroll
                for (int rr = 0; rr < 16; ++rr) if (crow(rr, hi) > r32) p0[rr] = -INFINITY; }
#pragma unroll
            for (int rr = 0; rr < 16; ++rr) p0[rr] += tb_[rr];
            u32x4 pw0, pw1; sm_step32(st, p0, wsf, r32, hi, pw0, pw1);
            pv32_mma(st.o, vf_, __builtin_bit_cast(bf16x8, pw0), __builtin_bit_cast(bf16x8, pw1));
        }
        if (t0) slot[0] = ahead;
        asm volatile("s_nop 15\n\ts_waitcnt lgkmcnt(0)\n\ts_barrier" ::: "memory");
        const int nn = (int)__builtin_amdgcn_readfirstlane(slot[0]);
        bf16* orow0 = OPART + ((size_t)u.p * M + rowbase + u.r + ((long)m0 << sh)) * 384 + u.h * 64;
        const float lse = sm_finish(st, wsf, (LAS bf16*)(shm + DU_OST) + wid * 2048, orow0, (long)384 << sh, lane, r32, hi);
        if (hi == 0) LSE[((size_t)(u.p * NB + u.b) * 6 + u.h) * SEQ + (size_t)u.r * (SEQ >> sh) + m0 + r32] = lse;
        asm volatile("s_nop 15\n\ts_waitcnt lgkmcnt(0)\n\ts_barrier" ::: "memory");
        if (nxt >= DU_N) break;
        cur = nxt; nxt = nn;
    }
}
}

__device__ __forceinline__ int ilv32(int n) { return n < 16 ? 2 * n : 2 * (n - 16) + 1; }
__device__ __forceinline__ void tr_item(const float* W, int N, const float* gain, float cscale, bf16* WT, int ldt, int dcol, int drow, bool il, LAS float* scr, int k0, int n0, int lane) {
    { f32x4 v[8]; float gsc[8];
#pragma unroll
      for (int i = 0; i < 8; ++i) { const int kk = 8 * i + (lane >> 3); v[i] = *(const f32x4*)(W + (size_t)(k0 + kk) * N + n0 + 4 * (lane & 7)); gsc[i] = (gain ? gain[k0 + kk] : 1.0f) * cscale; }
#pragma unroll
      for (int i = 0; i < 8; ++i) { const int kk = 8 * i + (lane >> 3); LAS float* d = scr + kk * 33 + 4 * (lane & 7); d[0] = v[i][0] * gsc[i]; d[1] = v[i][1] * gsc[i]; d[2] = v[i][2] * gsc[i]; d[3] = v[i][3] * gsc[i]; } }
    LDS_WAIT(); asm volatile("" ::: "memory");
    const int c = lane & 7;
#pragma unroll
    for (int j = 0; j < 4; ++j) { const int n = (lane >> 3) + 8 * j; const LAS float* s = scr + (8 * c) * 33 + n;
        u32x4 o; o.x = cvt_pk_bf16(s[0 * 33], s[1 * 33]); o.y = cvt_pk_bf16(s[2 * 33], s[3 * 33]); o.z = cvt_pk_bf16(s[4 * 33], s[5 * 33]); o.w = cvt_pk_bf16(s[6 * 33], s[7 * 33]);
        const int dr = drow + (il ? ilv32(n) : n);
        *(u32x4*)(WT + (size_t)dr * ldt + dcol + k0 + 8 * c) = o; }
    LDS_WAIT(); asm volatile("" ::: "memory");
}
__device__ __forceinline__ void tr_item8(const float* W, int N, float cscale, unsigned char* WT, int ldt, int drow, LAS float* scr, int k0, int n0, int lane) {
    { f32x4 v[8];
#pragma unroll
      for (int i = 0; i < 8; ++i) { const int kk = 8 * i + (lane >> 3); v[i] = *(const f32x4*)(W + (size_t)(k0 + kk) * N + n0 + 4 * (lane & 7)); }
#pragma unroll
      for (int i = 0; i < 8; ++i) { const int kk = 8 * i + (lane >> 3); LAS float* d = scr + kk * 33 + 4 * (lane & 7); d[0] = v[i][0] * cscale; d[1] = v[i][1] * cscale; d[2] = v[i][2] * cscale; d[3] = v[i][3] * cscale; } }
    LDS_WAIT(); asm volatile("" ::: "memory");
    const int c = lane & 7;
#pragma unroll
    for (int j = 0; j < 4; ++j) { const int n = (lane >> 3) + 8 * j; const LAS float* sp = scr + (8 * c) * 33 + n;
        u32x2 o; o.x = pg8::pk4_fp8((f32x4){sp[0 * 33], sp[1 * 33], sp[2 * 33], sp[3 * 33]}); o.y = pg8::pk4_fp8((f32x4){sp[4 * 33], sp[5 * 33], sp[6 * 33], sp[7 * 33]});
        *(u32x2*)(WT + (size_t)(drow + n) * ldt + k0 + 8 * c) = o; }
    LDS_WAIT(); asm volatile("" ::: "memory");
}
__device__ __forceinline__ int t5_bucket(int n) {
    if (n < 16) return n;
    int large = 16 + (int)(log2f((float)n * (1.0f / 16.0f)) * (16.0f / 7.0f));
    return large < 31 ? large : 31;
}

struct Args { const float* in[14]; float* out; unsigned char* ws; int ph_lo, ph_hi, li, pad; };

__global__ void __launch_bounds__(NWAVES * 64, 2) mk_fwd(Args args) {
    extern __shared__ __attribute__((aligned(16))) unsigned char lds_raw[];
    LAS unsigned char* lds0 = (LAS unsigned char*)lds_raw;
    volatile LAS unsigned* MISC = (volatile LAS unsigned*)(lds0 + MISC_OFF);
    const int wave0 = __builtin_amdgcn_readfirstlane((int)threadIdx.x >> 6);
#define PHASE_LOCALS \
    int z_; asm volatile("s_mov_b32 %0, 0" : "=s"(z_)); const int wave = wave0 + z_; \
    GAS unsigned char* wsg_ = (GAS unsigned char*)args.ws; GAS float* outg_ = (GAS float*)args.out; asm volatile("" : "+s"(wsg_), "+s"(outg_));     \
    unsigned char* ws = (unsigned char*)wsg_; const int G = (int)gridDim.x + z_; float* out = (float*)outg_; LAS unsigned char* lds = lds0 + z_; (void)lds; \
    const int bid = (int)blockIdx.x + z_; const int gw = bid * NWAVES + wave, NGW = G * NWAVES, NGT = NGW * 64; (void)bid; \
    unsigned* ctl = (unsigned*)(ws + WS_CTL); float* ssq_all = (float*)(ws + WS_SSQ); const f32x2* rope_cs = (const f32x2*)(ws + WS_ROPE); \
    float* tmoba = (float*)(ws + WS_TMOBA); float* tdil = (float*)(ws + WS_TDIL); float* kmean = (float*)(ws + WS_KMEAN); \
    bf16* XB = (bf16*)(ws + WS_XB); bf16* PROJ = (bf16*)(ws + WS_PROJ); bf16* QM = (bf16*)(ws + WS_QM); bf16* OB = (bf16*)(ws + WS_O); bf16* UB = (bf16*)(ws + WS_U); \
    (void)out; (void)gw; (void)NGW; (void)NGT; (void)ctl; (void)ssq_all; (void)rope_cs; (void)tmoba; (void)tdil; (void)kmean; (void)XB; (void)PROJ; (void)QM; (void)OB; (void)UB
#define LAYER_LOCALS PHASE_LOCALS; const int lz_ = l + z_; unsigned char* wl = ws + WS_W + (size_t)lz_ * W_STRIDE; float* ssq_x = ssq_all; float* ssq_c = ssq_all + (size_t)M * 16; float* ssq_mlp = ssq_all + (size_t)M * 32; \
    (void)wl; (void)ssq_x; (void)ssq_c; (void)ssq_mlp
    unsigned* ctl0 = (unsigned*)(args.ws + WS_CTL);
    for (int u = wave0 * 64 + lane_id(); u < (LDS_BYTES - LDSCTL_OFF) / 4; u += NWAVES * 64) ((LAS unsigned*)(lds0 + LDSCTL_OFF))[u] = 0u;
    __syncthreads();
    XcdBarrier bar; bar.bar = ctl0 + CW_BAR + args.li * XCD_BAR_WORDS; bar.x = 0; bar.st = nullptr;
    if (!MK_PER_PHASE) bar = xcd_barrier_post(ctl0 + CW_BAR + args.li * XCD_BAR_WORDS, MISC + 8, wave0 == 0 && lane_id() == 0);
    const int lo = MK_PER_PHASE ? args.ph_lo : 0, hi = MK_PER_PHASE ? args.ph_hi : N_PHASES;
#define IN(k) (lo <= (k) && (k) < hi)
#define SEAM(k) do { if (IN(k) && IN((k) + 1)) xcd_barrier(bar, wave0 == 0 && lane_id() == 0); } while (0)

    if (IN(0)) {
        PHASE_LOCALS; const float* x_in = args.in[0];
        const int lane = lane_id(), gt = bid * (NWAVES * 64) + wave * 64 + lane;
        LAS float* scr = (LAS float*)(lds + wave * 16384);
        constexpr int I_IN = 16 * 77, I_UQ = 6 * 18, I_UKV = 2 * 24, I_O = 16 * 32, I_UP = 16 * 128, I_DN = 64 * 32, I_L = I_IN + I_UQ + I_UKV + I_O + I_UP + I_DN;
        for (int it = gw; it < DEPTH * I_L; it += NGW) {
            const int l = it / I_L; int r = it % I_L;
            unsigned char* wl = ws + WS_W + (size_t)l * W_STRIDE;
            if (r < I_IN) { const int kb = r / 77, nb = r % 77, n0 = 32 * nb;
                int drow = n0; bool il = false; float sc = 1.0f;
                if (n0 < 384) sc = QS_64;
                else if (n0 == 1664) il = true;
                else if (n0 >= 1696) { drow = n0 + 32; if (n0 < 1952) sc = QS_64; }
                tr_item(args.in[2] + (size_t)l * DM * DIN, DIN, args.in[1] + l * DM, sc, (bf16*)(wl + W_IN), DM, 0, drow, il, scr, 64 * kb, n0, lane); continue; }
            r -= I_IN;
            if (r < I_UQ) { const int kb = r / 18, nb = r % 18, n0 = 32 * nb, h = n0 / 96, rr = n0 % 96;
                const int drow = (rr < 64) ? (Q_NOPE + 64 * h + rr) : (Q_ROPE + 32 * h);
                tr_item(args.in[5] + (size_t)l * 384 * 576, 576, args.in[3] + l * 384, QS_96, (bf16*)(wl + W_MLA), 512, 0, drow, rr == 64, scr, 64 * kb, n0, lane); continue; }
            r -= I_UQ;
            if (r < I_UKV) { const int kb = r / 24, nb = r % 24, n0 = 32 * nb;
                tr_item(args.in[6] + (size_t)l * 128 * 768, 768, args.in[4] + l * 128, 1.0f, (bf16*)(wl + W_MLA), 512, 384, Q_KV + n0, false, scr, 64 * kb, n0, lane); continue; }
            r -= I_UKV;
            if (r < I_O) { const int kb = r / 32, nb = r % 32;
                tr_item(args.in[9] + (size_t)l * DM * DM, DM, args.in[8] + l * DM, 1.0f, (bf16*)(wl + W_O), DM, 0, 32 * nb, false, scr, 64 * kb, 32 * nb, lane); continue; }
            r -= I_O;
            if (r < I_UP) { const int kb = r / 128, nb = r % 128;
                tr_item(args.in[11] + (size_t)l * DM * DFF, DFF, args.in[10] + l * DM, 1.0f, (bf16*)(wl + W_UP), DM, 0, 32 * nb, false, scr, 64 * kb, 32 * nb, lane); continue; }
            r -= I_UP;
            { const int kb = r % 64, nb = r / 64;
#if FP8_DOWN
                tr_item8(args.in[12] + (size_t)l * DFF * DM, DM, 64.0f, (unsigned char*)(wl + W_DOWN), DFF, 32 * nb, scr, 64 * kb, 32 * nb, lane); }
#else
                tr_item(args.in[12] + (size_t)l * DFF * DM, DM, nullptr, 1.0f, (bf16*)(wl + W_DOWN), DFF, 0, 32 * nb, false, scr, 64 * kb, 32 * nb, lane); }
#endif
        }
        for (int it = gt; it < DEPTH * (96 * 128 + 1536 * 64); it += NGT) {
            const int l = it / (96 * 128 + 1536 * 64); int r = it % (96 * 128 + 1536 * 64);
            unsigned char* wl = ws + WS_W + (size_t)l * W_STRIDE;
            if (r < 96 * 128) { const int rr = r / 128, ch = r % 128; const int row = rr < 32 ? 1696 + rr : 2496 + (rr - 32);
                *(u32x4*)((bf16*)(wl + W_IN) + (size_t)row * DM + ch * 8) = (u32x4){0u, 0u, 0u, 0u}; }
            else { r -= 96 * 128; const int row = r / 64, ch = r % 64; const int col = ch * 8;
                const bool data = (row < 576 && col < 384) || (row >= 768 && col >= 384);
                if (!data) *(u32x4*)((bf16*)(wl + W_MLA) + (size_t)row * 512 + col) = (u32x4){0u, 0u, 0u, 0u}; }
        }
        for (int it = gt; it < SEQ * 16; it += NGT) { const int t = it >> 4, i = it & 15;
            const float inv_freq = exp2f(-(float)i * (13.287712379549449f / 16.0f));
            const float ang = (float)t * inv_freq;
            double rev = (double)ang * 0.15915494309189535; rev -= floor(rev); const float rv = (float)rev;
            ((f32x2*)(ws + WS_ROPE))[it] = (f32x2){__builtin_amdgcn_cosf(rv), __builtin_amdgcn_sinf(rv)}; }
        const float* rel_bias = args.in[7];
        for (int it = gt; it < 4 * 4096; it += NGT) { const int h = it >> 12, d = it & 4095; tmoba[it] = rel_bias[t5_bucket(d) * 10 + 6 + h] * LOG2E; }
        for (int it = gt; it < 3 * 6 * 192; it += NGT) { const int p = it / (6 * 192), h = (it / 192) % 6, d = it % 192 - 32; const int dil = p == 0 ? 1 : (p == 1 ? 4 : 16);
            tdil[it] = (d >= 0 && d <= 128) ? rel_bias[t5_bucket(d * dil) * 10 + h] * LOG2E : 0.f; }
        for (int g32 = bid; g32 < M / 32; g32 += G) { const int m0 = g32 * 32 + 4 * wave;
            f32x4 v[4][4]; float s[4];
#pragma unroll
            for (int q = 0; q < 4; ++q) { const f32x4* xr = (const f32x4*)(x_in + (size_t)(m0 + q) * DM) + 2 * lane;
#pragma unroll
                for (int j = 0; j < 2; ++j) { v[q][2 * j] = xr[128 * j]; v[q][2 * j + 1] = xr[128 * j + 1]; } }
#pragma unroll
            for (int q = 0; q < 4; ++q) { const int m = m0 + q;
                s[q] = 0.f;
#pragma unroll
                for (int j = 0; j < 4; ++j) s[q] += (v[q][j][0] * v[q][j][0] + v[q][j][1] * v[q][j][1]) + (v[q][j][2] * v[q][j][2] + v[q][j][3] * v[q][j][3]);
                s[q] = wave_sum(s[q]);
                u32x4* o16 = (u32x4*)(XB + (size_t)m * DM) + lane;
#pragma unroll
                for (int j = 0; j < 2; ++j) { u32x4 w; w.x = cvt_pk_bf16(v[q][2 * j][0], v[q][2 * j][1]); w.y = cvt_pk_bf16(v[q][2 * j][2], v[q][2 * j][3]);
                    w.z = cvt_pk_bf16(v[q][2 * j + 1][0], v[q][2 * j + 1][1]); w.w = cvt_pk_bf16(v[q][2 * j + 1][2], v[q][2 * j + 1][3]); o16[64 * j] = w; } }
            { const int q_ = lane & 3, sl = lane >> 2; const float sv = q_ == 0 ? s[0] : (q_ == 1 ? s[1] : (q_ == 2 ? s[2] : s[3]));
              ssq_all[(size_t)sl * M + m0 + q_] = sl == 0 ? sv : 0.f; }
        }
    }
    SEAM(0);

    for (int l = 0; l < DEPTH; ++l) {
        const int pb = 1 + 7 * l;
        if (pb + 7 <= lo || pb >= hi) continue;

        if (IN(pb + 0)) {
            LAYER_LOCALS;
            pg8::Gemm g{XB, (const bf16*)(wl + W_IN), M, PP, DM, DM}; pg8::StaticOrder S; S.init(M, PP, G, bid);
            pg8::stage_rs<0>((LAS float*)(lds + RS_OFF), ssq_x, S, wave);
            pg8::EpiProj E{PROJ, ssq_x, ssq_c, rope_cs};
            pg8::gemm_phase<pg8::EpiProj>(lds, g, S, E, wave);
        }
        SEAM(pb + 0);
        if (IN(pb + 1)) {
            LAYER_LOCALS;
            pg8::Gemm g{PROJ + C_CQ, (const bf16*)(wl + W_MLA), M, QP, 512, PP}; pg8::MlaOrder S{G == 256 ? bid : (bid == 0 ? 0 : 256)};
            pg8::stage_rs<1>((LAS float*)(lds + RS_OFF), ssq_c, S, wave);
            pg8::EpiMla E{QM, ssq_c, rope_cs};
            pg8::gemm_phase<pg8::EpiMla, false, pg8::MlaOrder>(lds, g, S, E, wave);
            { const int ln = lane_id();
              for (int it = gw; it < NB * 16 * H_MOBA; it += NGW) { const int blk = it >> 2, h = it & 3;
                  const bf16* p = PROJ + ((size_t)blk * 256 + (ln >> 3)) * PP + C_KC + h * 64 + (ln & 7) * 8; float a[8];
#pragma unroll
                  for (int e = 0; e < 8; ++e) a[e] = 0.f;
#pragma unroll 8
                  for (int i = 0; i < 32; ++i) { const u32x4 v = *(const u32x4*)(p + (size_t)i * 8 * PP);
                      a[0] += bf_lo(v.x); a[1] += bf_hi(v.x); a[2] += bf_lo(v.y); a[3] += bf_hi(v.y); a[4] += bf_lo(v.z); a[5] += bf_hi(v.z); a[6] += bf_lo(v.w); a[7] += bf_hi(v.w); }
#pragma unroll
                  for (int e = 0; e < 8; ++e) { a[e] += swz_xor<8>(a[e]); a[e] += swz_xor<16>(a[e]); a[e] = xsum32(a[e]); }
                  if (ln < 8) { float* o = kmean + (size_t)it * 64 + ln * 8;
                      *(f32x4*)o = (f32x4){a[0], a[1], a[2], a[3]} * (1.0f / 256.0f); *(f32x4*)(o + 4) = (f32x4){a[4], a[5], a[6], a[7]} * (1.0f / 256.0f); } } }
        }
        SEAM(pb + 1);
        if (IN(pb + 2)) {
            LAYER_LOCALS;
            { unsigned* qctr = ctl + CW_Q + 64 * (3 * l + 0);
              for (;;) { const int i = att::wg_next(qctr, lds, att::L_Q, wave); if (i >= NB * H_MLA * 16) break;
                  const int qb = 15 - i / (NB * H_MLA), bh = i % (NB * H_MLA); att::mla_unit2(bh / H_MLA, bh % H_MLA, qb, QM, PROJ, OB, ssq_c, lds, wave); } }
            { unsigned* qctr = ctl + CW_Q + 64 * (3 * l + 1);
              for (;;) { const int i = att::wg_next(qctr, lds, att::L_Q, wave); if (i >= NB * H_MOBA * 16) break;
                  const int j = 15 - i / (NB * H_MOBA), bh = i % (NB * H_MOBA); att::moba_unit(bh / H_MOBA, bh % H_MOBA, j, PROJ, kmean, tmoba, OB, ssq_c, lds, wave); } }
            { unsigned* qctr = ctl + CW_Q + 64 * (3 * l + 2);
              asm volatile("s_nop 15\n\ts_waitcnt vmcnt(0) lgkmcnt(0)\n\ts_barrier" ::: "memory");
              { const int t2 = wave * 64 + lane_id(); for (int i = t2; i < 3 * 6 * 192; i += NWAVES * 64) ((LAS float*)(lds + att::D_TB))[i] = tdil[i]; }
              asm volatile("s_nop 15\n\ts_waitcnt vmcnt(0) lgkmcnt(0)\n\ts_barrier" ::: "memory");
              const int ln = lane_id();
              (void)ln; att::dil_units(qctr, PROJ, (bf16*)out, (float*)((unsigned char*)out + 72 * MiB), lds, wave); }
        }
        SEAM(pb + 2);
        if (IN(pb + 3)) {
            LAYER_LOCALS;
            const int lane = lane_id();
            float* rowsc = (float*)(ws + WS_ROWSC);
            for (int m = gw; m < M; m += NGW) {
                float f0[8]; float s0 = 0.f;
                if (lane < 48) {
                    const bf16* op = (const bf16*)out + (size_t)m * 384 + 8 * lane; const float* lp = (const float*)((const unsigned char*)out + 72 * MiB); const int hh_ = lane >> 3, bb_ = m >> 12, tt_ = m & (SEQ - 1);
                    const u32x4 a0 = *(const u32x4*)op, a1 = *(const u32x4*)(op + (size_t)M * 384), a2 = *(const u32x4*)(op + (size_t)2 * M * 384);
                    const float l0 = lp[((size_t)(0 * NB + bb_) * 6 + hh_) * SEQ + tt_],
                                l1 = lp[((size_t)(1 * NB + bb_) * 6 + hh_) * SEQ + (size_t)(tt_ & 3) * (SEQ >> 2) + (tt_ >> 2)],
                                l2 = lp[((size_t)(2 * NB + bb_) * 6 + hh_) * SEQ + (size_t)(tt_ & 15) * (SEQ >> 4) + (tt_ >> 4)]; const float mx = fmaxf(l0, fmaxf(l1, l2));
                    float w0 = exp2f(l0 - mx), w1 = exp2f(l1 - mx), w2 = exp2f(l2 - mx); const float iw = 1.0f / (w0 + w1 + w2); w0 *= iw; w1 *= iw; w2 *= iw;
                    f0[0] = w0 * bf_lo(a0.x) + w1 * bf_lo(a1.x) + w2 * bf_lo(a2.x); f0[1] = w0 * bf_hi(a0.x) + w1 * bf_hi(a1.x) + w2 * bf_hi(a2.x);
                    f0[2] = w0 * bf_lo(a0.y) + w1 * bf_lo(a1.y) + w2 * bf_lo(a2.y); f0[3] = w0 * bf_hi(a0.y) + w1 * bf_hi(a1.y) + w2 * bf_hi(a2.y);
                    f0[4] = w0 * bf_lo(a0.z) + w1 * bf_lo(a1.z) + w2 * bf_lo(a2.z); f0[5] = w0 * bf_hi(a0.z) + w1 * bf_hi(a1.z) + w2 * bf_hi(a2.z);
                    f0[6] = w0 * bf_lo(a0.w) + w1 * bf_lo(a1.w) + w2 * bf_lo(a2.w); f0[7] = w0 * bf_hi(a0.w) + w1 * bf_hi(a1.w) + w2 * bf_hi(a2.w);
                    u32x4 w; w.x = cvt_pk_bf16(f0[0], f0[1]); w.y = cvt_pk_bf16(f0[2], f0[3]); w.z = cvt_pk_bf16(f0[4], f0[5]); w.w = cvt_pk_bf16(f0[6], f0[7]);
                    *((u32x4*)(OB + (size_t)m * DM) + lane) = w;
                    s0 = bf_lo(w.x) * bf_lo(w.x) + bf_hi(w.x) * bf_hi(w.x) + bf_lo(w.y) * bf_lo(w.y) + bf_hi(w.y) * bf_hi(w.y) + bf_lo(w.z) * bf_lo(w.z) + bf_hi(w.z) * bf_hi(w.z) + bf_lo(w.w) * bf_lo(w.w) + bf_hi(w.w) * bf_hi(w.w);
                }
                const float sa = wave_sum(s0);
                if (lane == 0) { float qs[10];
#pragma unroll
                    for (int i = 0; i < 10; ++i) qs[i] = ssq_c[(size_t)i * M + m];
                    const float sb = ((qs[0] + qs[1]) + (qs[2] + qs[3])) + (qs[4] + qs[5]), sc = (qs[6] + qs[7]) + (qs[8] + qs[9]);
                    const float ra = rsqrtf(sa * (1.0f / 384.0f) + EPS), rb_ = rsqrtf(sb * (1.0f / 384.0f) + EPS), rc = rsqrtf(sc * (1.0f / 256.0f) + EPS);
                    *(f32x4*)(rowsc + (size_t)m * 4) = (f32x4){ra / rb_, rb_ / rc, rc, 0.f}; }
            }
        }
        SEAM(pb + 3);
        if (IN(pb + 4)) {
            LAYER_LOCALS;
            pg8::Gemm g{OB, (const bf16*)(wl + W_O), M, DM, DM, DM}; pg8::StaticOrder S; S.init(M, DM, G, bid);
            { const float* rowsc = (const float*)(ws + WS_ROWSC); LAS float* rst = (LAS float*)(lds + RS_OFF); const int t = wave * 64 + lane_id(); pg8::Unit uu;
              for (int i = 0; i < 2 && S.next(i, uu); ++i) if (t < 256) *(LAS f32x4*)(rst + (i * 256 + t) * 4) = *(const f32x4*)(rowsc + (size_t)(uu.pm * 256 + t) * 4);
              asm volatile("s_nop 15\n\ts_waitcnt vmcnt(0) lgkmcnt(0)\n\ts_barrier" ::: "memory"); }
            pg8::EpiRes<true> E{XB, ssq_mlp, 1.0f};
            pg8::gemm_phase<pg8::EpiRes<true>, false, pg8::StaticOrder, true>(lds, g, S, E, wave);
        }
        SEAM(pb + 4);
        if (IN(pb + 5)) {
            LAYER_LOCALS;
            pg8::Gemm g{XB, (const bf16*)(wl + W_UP), M, DFF, DM, DM}; pg8::StaticOrder S; S.init(M, DFF, G, bid);
            pg8::stage_rs<0>((LAS float*)(lds + RS_OFF), ssq_mlp, S, wave);
#if FP8_DOWN
            pg8::EpiUp8 E{(unsigned char*)UB, ssq_mlp};
            pg8::gemm_phase<pg8::EpiUp8>(lds, g, S, E, wave);
#else
            pg8::EpiUp E{UB, ssq_mlp};
            pg8::gemm_phase<pg8::EpiUp>(lds, g, S, E, wave);
#endif
        }
        SEAM(pb + 5);
        if (IN(pb + 6)) {
            LAYER_LOCALS;
            pg8::Gemm g{UB, (const bf16*)(wl + W_DOWN), M, DM, DFF, DFF}; pg8::StaticOrder S; S.init(M, DM, G, bid);
#if FP8_DOWN
            pg8::EpiRes<false> E{XB, ssq_x, 1.0f / 512.0f};
            pg8::gemm_phase<pg8::EpiRes<false>, true>(lds, g, S, E, wave);
#else
            pg8::EpiRes<false> E{XB, ssq_x, 1.0f};
            pg8::gemm_phase<pg8::EpiRes<false>>(lds, g, S, E, wave);
#endif
        }
        SEAM(pb + 6);
    }
    if (IN(29)) {
        PHASE_LOCALS;
        const float* ssq_f = ssq_all; const float* gf = args.in[13];
        const int lane = lane_id();
        for (int m = gw; m < M; m += NGW) {
            const float rs = rsqrtf(ssq16(ssq_f + m, (size_t)M) * (1.0f / DM) + EPS);
#pragma unroll
            for (int j = 0; j < 2; ++j) { const int c = 8 * (lane + 64 * j); const u32x4 v = *(const u32x4*)(XB + (size_t)m * DM + c);
                const f32x4 ga = *(const f32x4*)(gf + c), gb = *(const f32x4*)(gf + c + 4);
                f32x4 oa = (f32x4){bf_lo(v.x), bf_hi(v.x), bf_lo(v.y), bf_hi(v.y)} * rs * ga, ob = (f32x4){bf_lo(v.z), bf_hi(v.z), bf_lo(v.w), bf_hi(v.w)} * rs * gb;
                *(f32x4*)(out + (size_t)m * DM + c) = oa; *(f32x4*)(out + (size_t)m * DM + c + 4) = ob; }
        }
    }
#undef IN
#undef SEAM
}

extern "C" void kernel_launch(void* const* d_in, const int* in_sizes, int n_in, void* d_out, int out_size, void* d_ws, size_t ws_size, hipStream_t stream) {
    static int grid = 0;
    if (grid == 0) {
        if (n_in != 14 || in_sizes[0] != M * DM || out_size != M * DM || ws_size < WS_END) { fprintf(stderr, "kernel_launch: unexpected shapes (n_in %d, in0 %d, out %d, ws %zu); nothing launched\n", n_in, n_in > 0 ? in_sizes[0] : -1, out_size, ws_size); grid = -1; return; }
        int dev = 0, cus = 0, per_cu = 0;
        if (hipGetDevice(&dev) != hipSuccess || hipDeviceGetAttribute(&cus, hipDeviceAttributeMultiprocessorCount, dev) != hipSuccess) { grid = -1; return; }
        if (hipFuncSetAttribute((const void*)mk_fwd, hipFuncAttributeMaxDynamicSharedMemorySize, LDS_BYTES) != hipSuccess) { fprintf(stderr, "kernel_launch: hipFuncSetAttribute failed\n"); grid = -1; return; }
        if (hipOccupancyMaxActiveBlocksPerMultiprocessor(&per_cu, (const void*)mk_fwd, NWAVES * 64, LDS_BYTES) != hipSuccess || per_cu < 1)
            fprintf(stderr, "kernel_launch: note: occupancy query reports %d workgroups per CU\n", per_cu);
        (void)hipGetLastError();
        grid = cus;
    }
    if (grid < 0) return;
    if (hipMemsetAsync((char*)d_ws + WS_CTL, 0, CTL_ZERO_BYTES, stream) != hipSuccess) { fprintf(stderr, "kernel_launch: memset failed\n"); return; }
    Args a{};
    for (int i = 0; i < 14; ++i) a.in[i] = (const float*)d_in[i];
    a.out = (float*)d_out; a.ws = (unsigned char*)d_ws; a.pad = 0;
#if MK_PER_PHASE
    for (int p = 0; p < N_PHASES; ++p) { a.ph_lo = p; a.ph_hi = p + 1; a.li = 0;
        hipLaunchKernelGGL(mk_fwd, dim3(grid), dim3(NWAVES * 64), LDS_BYTES, stream, a); }
#else
    a.ph_lo = 0; a.ph_hi = N_PHASES; a.li = 0;
    hipLaunchKernelGGL(mk_fwd, dim3(grid), dim3(NWAVES * 64), LDS_BYTES, stream, a);
#endif
    const hipError_t le = hipPeekAtLastError();
    if (le != hipSuccess) fprintf(stderr, "kernel_launch: launch failed: %s\n", hipGetErrorName(le));
}
```

```cpp
#include <hip/hip_runtime.h>
#include <cstdio>
#include <cstdint>

#define LAS __attribute__((address_space(3)))
#define GAS __attribute__((address_space(1)))
typedef unsigned short bf16;
typedef short bf16x8 __attribute__((ext_vector_type(8)));
typedef float f32x4 __attribute__((ext_vector_type(4)));
typedef float f32x2 __attribute__((ext_vector_type(2)));
typedef unsigned u32x4 __attribute__((ext_vector_type(4)));
typedef unsigned u32x2 __attribute__((ext_vector_type(2)));
typedef int i32x4 __attribute__((ext_vector_type(4)));
typedef int i32x8 __attribute__((ext_vector_type(8)));

#ifndef FP8_DOWN
#define FP8_DOWN 1
#endif
#ifndef MK_PER_PHASE
#define MK_PER_PHASE 0
#endif

constexpr int NB = 8, SEQ = 4096, DM = 1024, DEPTH = 4, M = NB * SEQ, DFF = 4096;
constexpr int DIN = 2464, PP = 2560  , QP = 1536  ;
constexpr int H_DIL = 6, H_MLA = 6, H_MOBA = 4;
constexpr int C_QA = 0, C_KA = 384, C_VA = 768, C_CQ = 1152, C_CKV = 1536, C_KR = 1664, C_QC = 1728, C_KC = 1984, C_VC = 2240;
constexpr int Q_NOPE = 0, Q_ROPE = 384, Q_KV = 768;
constexpr int O_A = 0, O_B = 384, O_C = 768;
constexpr float EPS = 1e-6f;
constexpr float LOG2E = 1.4426950408889634f;
constexpr float QS_64 = 0.125f * LOG2E;
constexpr float QS_96 = 0.10206207261596575f * LOG2E;

constexpr size_t MiB = 1u << 20;
constexpr size_t WS_CTL = 0, CTL_ZERO_BYTES = 1 * MiB;
constexpr size_t WS_SSQ = 1 * MiB;
constexpr size_t WS_ROPE = 7 * MiB;
constexpr size_t WS_TMOBA = 7 * MiB + 512 * 1024;
constexpr size_t WS_TDIL = WS_TMOBA + 64 * 1024;
constexpr size_t WS_KMEAN = 7 * MiB + 768 * 1024;
constexpr size_t WS_W = 8 * MiB, W_STRIDE = 25 * MiB;
constexpr size_t W_IN = 0, W_MLA = 5 * MiB, W_O = 6 * MiB + 512 * 1024, W_UP = 8 * MiB + 512 * 1024, W_DOWN = 16 * MiB + 512 * 1024;
constexpr size_t WS_ROWSC = 108 * MiB;
constexpr size_t WS_XB = 112 * MiB;
constexpr size_t WS_PROJ = 176 * MiB;
constexpr size_t WS_QM = 336 * MiB;
constexpr size_t WS_O = 432 * MiB;
constexpr size_t WS_U = WS_PROJ;
constexpr size_t WS_END = 496 * MiB;
static_assert(WS_PROJ + (size_t)M * PP * 2 == WS_QM && WS_QM + (size_t)M * QP * 2 == WS_O && WS_U + (size_t)M * DFF * 2 <= WS_O && WS_O + (size_t)M * DM * 2 == WS_END, "ws map");
static_assert(WS_W + DEPTH * W_STRIDE <= WS_XB && WS_XB + (size_t)M * DM * 2 == WS_PROJ, "ws map 2");
constexpr int CW_Q = 1024;
constexpr int CW_BAR = 16384;
constexpr int N_PHASES = 30;

constexpr int RING_BYTES = 131072;
constexpr int LDSCTL_OFF = RING_BYTES, MISC_OFF = LDSCTL_OFF + 320;
constexpr int RS_OFF = 132096;
constexpr int LDS_BYTES = 147456;
constexpr int NWAVES = 8;

#define LDS_WAIT() asm volatile("s_waitcnt lgkmcnt(0)" ::: "memory")
#define VM_WAIT() asm volatile("s_waitcnt vmcnt(0)" ::: "memory")
typedef __bf16 bf16x2_t __attribute__((ext_vector_type(2)));
__device__ __forceinline__ unsigned cvt_pk_bf16(float lo, float hi) { const f32x2 v = {lo, hi}; const bf16x2_t b = __builtin_convertvector(v, bf16x2_t); return __builtin_bit_cast(unsigned, b); }
__device__ __forceinline__ float bf_lo(unsigned u) { return __uint_as_float(u << 16); }
__device__ __forceinline__ float bf_hi(unsigned u) { return __uint_as_float(u & 0xffff0000u); }
__device__ __forceinline__ float dot8(u32x4 a, u32x4 b, float s) {
    s = fmaf(bf_lo(a.x), bf_lo(b.x), s); s = fmaf(bf_hi(a.x), bf_hi(b.x), s);
    s = fmaf(bf_lo(a.y), bf_lo(b.y), s); s = fmaf(bf_hi(a.y), bf_hi(b.y), s);
    s = fmaf(bf_lo(a.z), bf_lo(b.z), s); s = fmaf(bf_hi(a.z), bf_hi(b.z), s);
    s = fmaf(bf_lo(a.w), bf_lo(b.w), s); s = fmaf(bf_hi(a.w), bf_hi(b.w), s);
    return s;
}
__device__ __forceinline__ int lane_id() { int l; asm volatile("v_mbcnt_lo_u32_b32 %0, -1, 0\n\tv_mbcnt_hi_u32_b32 %0, -1, %0" : "=v"(l)); return l; }
template <int X> __device__ __forceinline__ float swz_xor(float v) { return __int_as_float(__builtin_amdgcn_ds_swizzle(__float_as_int(v), (X << 10) | 0x1f)); }
__device__ __forceinline__ float xsum32(float v) { auto rr = __builtin_amdgcn_permlane32_swap(__float_as_uint(v), __float_as_uint(v), false, false); return __uint_as_float(rr[0]) + __uint_as_float(rr[1]); }
__device__ __forceinline__ float wave_sum(float v) { v += swz_xor<1>(v); v += swz_xor<2>(v); v += swz_xor<4>(v); v += swz_xor<8>(v); v += swz_xor<16>(v); return xsum32(v); }
__device__ __forceinline__ float sum4(const f32x4& a) { return (a[0] + a[1]) + (a[2] + a[3]); }
__device__ __forceinline__ float ssq16(const float* p, size_t st) { float a[16];
#pragma unroll
    for (int i = 0; i < 16; ++i) a[i] = p[(size_t)i * st];
    return ((((a[0] + a[1]) + (a[2] + a[3])) + ((a[4] + a[5]) + (a[6] + a[7]))) + (((a[8] + a[9]) + (a[10] + a[11])) + ((a[12] + a[13]) + (a[14] + a[15])))); }

namespace pg8 {
constexpr int BM = 256, BK = 64, HALF = 128, HTB = HALF * BK * 2, STAGE_BYTES = 8 * HTB, NXCD = 8, WGM = 8;
__host__ __device__ __forceinline__ int lds_byte(int r, int c) { const int st = (r >> 4) * 2 + (c >> 5), rr = r & 15, cc = c & 31, ob = rr * 64 + cc * 2; return st * 1024 + (ob ^ (((ob >> 9) & 1) << 5)); }
__host__ __device__ __forceinline__ void stage_rc(int b, int& R, int& C) { const int st = b / 1024, sb = b % 1024, swz = sb ^ (((sb >> 9) & 1) << 5); R = (st >> 1) * 16 + swz / 64; C = (st & 1) * 32 + (swz % 64) / 2; }
__host__ __device__ __forceinline__ int perm32(int rho) { const int n = rho >> 4, i = rho & 15; return 8 * (i >> 2) + 4 * n + (i & 3); }

struct Unit { int pm, pn; };
struct Gemm { const bf16* A; const bf16* Bt; int M, N, K, lda; };

struct StaticOrder {
    int nM, nN, nwg, G, c;
    __host__ __device__ __forceinline__ void init(int M_, int N_, int G_, int c_) { nM = M_ / BM; nN = N_ / BM; nwg = nM * nN; G = G_; c = c_; }
    __host__ __device__ __forceinline__ bool next(int i, Unit& u) const {
        const long L = (long)i * G + c; if (L >= nwg) return false;
        int wgid = (int)L; { const int q = nwg / NXCD, r = nwg % NXCD, xcd = wgid % NXCD, off = wgid / NXCD; wgid = (xcd < r ? xcd * (q + 1) : r * (q + 1) + (xcd - r) * q) + off; }
        const int nig = WGM * nN, gid = wgid / nig, fm = gid * WGM, gsz = (nM - fm) < WGM ? (nM - fm) : WGM;
        u.pm = fm + ((wgid % nig) % gsz); u.pn = (wgid % nig) / gsz; return true;
    }
    __host__ __device__ __forceinline__ void krange(const Unit&, int& kt0, int& ntu, int ntfull) const { kt0 = 0; ntu = ntfull; }
};
struct MlaOrder {
    int c;
    __host__ __device__ __forceinline__ bool next(int i, Unit& u) const { if (i >= 3 || c >= 256) return false; u.pm = c >> 1; const int odd = c & 1; u.pn = odd ? (i == 0 ? 2 : 3 + i) : (i == 2 ? 3 : i); return true; }
    __host__ __device__ __forceinline__ void krange(const Unit& u, int& kt0, int& ntu, int) const { if (u.pn < 3) { kt0 = 0; ntu = 6; } else { kt0 = 6; ntu = 2; } }
};

template <class Epi, bool F8 = false, class Sched = StaticOrder, bool RSC = false>
__device__ __forceinline__ void gemm_phase(LAS unsigned char* lds, const Gemm g, const Sched& S, const Epi& E, const int wid  ) {
    const int lane = lane_id(), tid = wid * 64 + lane;
    const int wr = wid >> 2, wc = wid & 3, fr = lane & 15, fq = lane >> 4;
    constexpr int ESZ = F8 ? 1 : 2;
    const int K = g.K, ntfull = K * ESZ / (BK * 2), lda = g.lda;
    unsigned voffA[2], voffB[2];
#pragma unroll
    for (int i = 0; i < 2; ++i) { int R, C; stage_rc(tid * 16 + i * 8192, R, C); const int Rb = Epi::PERM ? ((R & ~31) + perm32(R & 31)) : R;
        voffA[i] = (unsigned)(R * lda * ESZ + C * 2); voffB[i] = (unsigned)(Rb * K * ESZ + C * 2); }
    const size_t kstep = (size_t)(BK * 2);
    const size_t hstepA = (size_t)HALF * lda * ESZ, hstepB = (size_t)HALF * K * ESZ;
    const size_t tstepA = 2 * hstepA, tstepB = 2 * hstepB;
    const unsigned ldsw = (unsigned)wid * 1024u;
    const int aoff = lds_byte(wr * 64 + fr, fq * 8), boff = lds_byte(wc * 32 + fr, fq * 8);
#define PG8_SA(b, h) (((b) * 2 + (h)) * HTB)
#define PG8_SB(b, h) ((4 + (b) * 2 + (h)) * HTB)
#define PG8_STAGE(bufoff, gbase, voff) do { _Pragma("unroll") for (int _i = 0; _i < 2; ++_i) { unsigned vo_ = (voff)[_i]; asm volatile("" : "+v"(vo_));   \
        __builtin_amdgcn_global_load_lds((const unsigned*)((const char*)(gbase) + vo_), (LAS unsigned*)(lds + (bufoff) + ldsw + _i * 8192), 16, 0, 0); } } while (0)
#define PG8_RD2(p) __builtin_shufflevector(*(const LAS i32x4*)(p), *(const LAS i32x4*)((p) + 1024), 0, 1, 2, 3, 4, 5, 6, 7)
#define PG8_LDA(dst, b, h) do { _Pragma("unroll") for (int m = 0; m < 4; ++m) dst[m] = PG8_RD2(lds + PG8_SA(b, h) + aoff + m * 2048); } while (0)
#define PG8_LDB(dst, b, h) do { _Pragma("unroll") for (int n = 0; n < 2; ++n) dst[n] = PG8_RD2(lds + PG8_SB(b, h) + boff + n * 2048); } while (0)
#define PG8_LO(x) __builtin_bit_cast(bf16x8, __builtin_shufflevector(x, x, 0, 1, 2, 3))
#define PG8_HI(x) __builtin_bit_cast(bf16x8, __builtin_shufflevector(x, x, 4, 5, 6, 7))
#define PG8_MMA(ai, bj, At, Bt) do { __builtin_amdgcn_s_setprio(1); _Pragma("unroll") for (int m = 0; m < 4; ++m) _Pragma("unroll") for (int n = 0; n < 2; ++n) { \
        if constexpr (F8) acc[ai][bj][m][n] = __builtin_amdgcn_mfma_scale_f32_16x16x128_f8f6f4(Bt[n], At[m], acc[ai][bj][m][n], 0, 0, 0, 0x7f7f7f7f, 0, 0x7f7f7f7f); \
        else { acc[ai][bj][m][n] = __builtin_amdgcn_mfma_f32_16x16x32_bf16(PG8_LO(Bt[n]), PG8_LO(At[m]), acc[ai][bj][m][n], 0, 0, 0); \
               acc[ai][bj][m][n] = __builtin_amdgcn_mfma_f32_16x16x32_bf16(PG8_HI(Bt[n]), PG8_HI(At[m]), acc[ai][bj][m][n], 0, 0, 0); } } \
        __builtin_amdgcn_s_setprio(0); } while (0)
#define PG8_WAIT_V(n) asm volatile("s_waitcnt vmcnt(" #n ")" ::: "memory")
#define PG8_WAIT_L(n) asm volatile("s_waitcnt lgkmcnt(" #n ")" ::: "memory")
#define PG8_BAR __builtin_amdgcn_s_barrier()
#define PG8_SCHED __builtin_amdgcn_sched_barrier(0)
    Unit cur, nxt; int ui = 0;
    if (!S.next(0, cur)) return;
    f32x4 acc[2][2][4][2];
#pragma unroll
    for (int a = 0; a < 2; ++a)
#pragma unroll
        for (int b = 0; b < 2; ++b)
#pragma unroll
            for (int m = 0; m < 4; ++m)
#pragma unroll
                for (int n = 0; n < 2; ++n) acc[a][b][m][n] = (f32x4){0.f, 0.f, 0.f, 0.f};
    i32x8 At[4], B0[2], B1[2];
    int kt0, nt; S.krange(cur, kt0, nt, ntfull);
    const char* cA = (const char*)g.A + (size_t)cur.pm * tstepA + (size_t)kt0 * kstep; const char* cB = (const char*)g.Bt + (size_t)cur.pn * tstepB + (size_t)kt0 * kstep;
    PG8_STAGE(PG8_SB(0, 0), cB, voffB); PG8_STAGE(PG8_SB(0, 1), cB + hstepB, voffB); PG8_STAGE(PG8_SA(0, 0), cA, voffA); PG8_STAGE(PG8_SA(0, 1), cA + hstepA, voffA);
    if (wr == 1) PG8_BAR;
    PG8_WAIT_V(2); PG8_BAR;
    PG8_STAGE(PG8_SB(1, 0), cB + kstep, voffB); PG8_STAGE(PG8_SA(1, 0), cA + kstep, voffA); PG8_STAGE(PG8_SB(1, 1), cB + hstepB + kstep, voffB);
    PG8_WAIT_V(6); PG8_BAR;
    for (;;) {
        const bool has_next = S.next(ui + 1, nxt);
        int nkt0 = kt0, nnt = nt; if (has_next) S.krange(nxt, nkt0, nnt, ntfull);
        const char* nA = has_next ? (const char*)g.A + (size_t)nxt.pm * tstepA + (size_t)nkt0 * kstep : cA; const char* nB = has_next ? (const char*)g.Bt + (size_t)nxt.pn * tstepB + (size_t)nkt0 * kstep : cB;
        for (int t = 0; t < nt; t += 2) {
            if constexpr (RSC) { if (t == 6 || t == 12) { const LAS float* rr_ = (const LAS float*)(lds + RS_OFF) + (ui * 256 + wr * 64 + fr) * 4 + (t == 6 ? 0 : 1);
#pragma unroll
                for (int ai = 0; ai < 2; ++ai)
#pragma unroll
                    for (int m = 0; m < 4; ++m) { const float f_ = rr_[(ai * HALF + m * 16) * 4];
#pragma unroll
                        for (int bj = 0; bj < 2; ++bj)
#pragma unroll
                            for (int n = 0; n < 2; ++n) acc[ai][bj][m][n] *= f_; } } }
            const bool last = (t == nt - 2);
            const char* a1 = cA + (size_t)(t + 1) * kstep;
            const char* a2 = last ? nA : cA + (size_t)(t + 2) * kstep; const char* b2 = last ? nB : cB + (size_t)(t + 2) * kstep;
            const char* a3 = a2 + kstep; const char* b3 = b2 + kstep;
            PG8_LDB(B0, 0, 0); PG8_LDB(B1, 0, 1); PG8_SCHED; PG8_LDA(At, 0, 0); PG8_STAGE(PG8_SA(1, 1), a1 + hstepA, voffA);
            PG8_WAIT_V(8); PG8_WAIT_L(0); PG8_BAR; PG8_MMA(0, 0, At, B0); PG8_MMA(0, 1, At, B1); PG8_BAR; PG8_SCHED;
            PG8_LDA(At, 0, 1); PG8_STAGE(PG8_SB(0, 0), b2, voffB); PG8_STAGE(PG8_SB(0, 1), b2 + hstepB, voffB); PG8_STAGE(PG8_SA(0, 0), a2, voffA);
            PG8_WAIT_V(8); PG8_WAIT_L(0); PG8_BAR; PG8_MMA(1, 0, At, B0); PG8_MMA(1, 1, At, B1); PG8_BAR; PG8_SCHED;
            PG8_LDB(B0, 1, 0); PG8_LDB(B1, 1, 1); PG8_SCHED; PG8_LDA(At, 1, 0); PG8_STAGE(PG8_SA(0, 1), a2 + hstepA, voffA);
            PG8_WAIT_V(8); PG8_WAIT_L(0); PG8_BAR; PG8_MMA(0, 0, At, B0); PG8_MMA(0, 1, At, B1); PG8_BAR; PG8_SCHED;
            PG8_LDA(At, 1, 1); PG8_STAGE(PG8_SB(1, 0), b3, voffB); PG8_STAGE(PG8_SB(1, 1), b3 + hstepB, voffB); PG8_STAGE(PG8_SA(1, 0), a3, voffA);
            PG8_WAIT_V(8); PG8_WAIT_L(0); PG8_BAR; PG8_MMA(1, 0, At, B0); PG8_MMA(1, 1, At, B1); PG8_BAR; PG8_SCHED;
        }
        if (wr == 0) PG8_BAR;
        { const int le = lane_id(); E(acc, cur, ui, (const LAS float*)(lds + RS_OFF - 0), wr, wc, le & 15, le >> 4); }
        if (!has_next) break;
#pragma unroll
        for (int a = 0; a < 2; ++a)
#pragma unroll
            for (int b = 0; b < 2; ++b)
#pragma unroll
                for (int m = 0; m < 4; ++m)
#pragma unroll
                    for (int n = 0; n < 2; ++n) acc[a][b][m][n] = (f32x4){0.f, 0.f, 0.f, 0.f};
        cur = nxt; cA = nA; cB = nB; nt = nnt; kt0 = nkt0; ++ui;
        if (wr == 1) PG8_BAR;
    }
    PG8_WAIT_V(0);
    PG8_BAR;
#undef PG8_SA
#undef PG8_SB
#undef PG8_STAGE
#undef PG8_LDA
#undef PG8_LDB
#undef PG8_MMA
#undef PG8_LO
#undef PG8_HI
#undef PG8_RD2
#undef PG8_WAIT_V
#undef PG8_WAIT_L
#undef PG8_BAR
#undef PG8_SCHED
}

template <int MODE, class Sched> __device__ __forceinline__ void stage_rs(LAS float* rst, const float* ssq, const Sched& S, int wave) {
    const int t = wave * 64 + lane_id(), half = t >> 8, row = t & 255;
    f32x4 q[4][4]; int pn_[4]; bool ok[4];
#pragma unroll
    for (int k = 0; k < 4; ++k) { Unit u; ok[k] = S.next(2 * k + half, u); pn_[k] = ok[k] ? u.pn : 0; const int pm = ok[k] ? u.pm : 0;
        const float* p = ssq + (size_t)(pm * BM + row);
#pragma unroll
        for (int j = 0; j < 4; ++j) q[k][j] = (f32x4){p[(size_t)(4 * j) * M], p[(size_t)(4 * j + 1) * M], p[(size_t)(4 * j + 2) * M], p[(size_t)(4 * j + 3) * M]}; }
#pragma unroll
    for (int k = 0; k < 4; ++k) if (ok[k]) { float r;
        if (MODE == 0) r = rsqrtf(((sum4(q[k][0]) + sum4(q[k][1])) + (sum4(q[k][2]) + sum4(q[k][3]))) * (1.0f / DM) + EPS);
        else r = pn_[k] < 3 ? rsqrtf(((sum4(q[k][0]) + sum4(q[k][1])) + sum4(q[k][2])) * (1.0f / 384.0f) + EPS) : rsqrtf(sum4(q[k][3]) * (1.0f / 128.0f) + EPS);
        rst[(2 * k + half) * 256 + row] = r; }
    asm volatile("s_nop 15\n\ts_waitcnt vmcnt(0) lgkmcnt(0)\n\ts_barrier" ::: "memory");
}

__device__ __forceinline__ void rope_consts(float (&crev)[4], int i0) {
#pragma unroll
    for (int p = 0; p < 4; ++p) crev[p] = __builtin_amdgcn_exp2f(-(float)(i0 + p) * (13.287712379549449f / 16.0f)) * 0.15915494309189535f;
}
__device__ __forceinline__ void rope8(f32x4& v0, f32x4& v1, int pos, const float (&crev)[4]) {
    float c[4], sn[4];
#pragma unroll
    for (int p = 0; p < 4; ++p) { float rev = (float)pos * crev[p]; rev = __builtin_amdgcn_fractf(rev); c[p] = __builtin_amdgcn_cosf(rev); sn[p] = __builtin_amdgcn_sinf(rev); }
    f32x4 a, b;
    a[0] = v0[0] * c[0] - v0[1] * sn[0]; a[1] = v0[1] * c[0] + v0[0] * sn[0];
    a[2] = v0[2] * c[1] - v0[3] * sn[1]; a[3] = v0[3] * c[1] + v0[2] * sn[1];
    b[0] = v1[0] * c[2] - v1[1] * sn[2]; b[1] = v1[1] * c[2] + v1[0] * sn[2];
    b[2] = v1[2] * c[3] - v1[3] * sn[3]; b[3] = v1[3] * c[3] + v1[2] * sn[3];
    v0 = a; v1 = b;
}
__device__ __forceinline__ float sumsq8(const f32x4& a, const f32x4& b) { return (a[0] * a[0] + a[1] * a[1]) + (a[2] * a[2] + a[3] * a[3]) + (b[0] * b[0] + b[1] * b[1]) + (b[2] * b[2] + b[3] * b[3]); }
__device__ __forceinline__ u32x4 pack8(const f32x4& a, const f32x4& b) { u32x4 w; w.x = cvt_pk_bf16(a[0], a[1]); w.y = cvt_pk_bf16(a[2], a[3]); w.z = cvt_pk_bf16(b[0], b[1]); w.w = cvt_pk_bf16(b[2], b[3]); return w; }

struct EpiProj {
    static constexpr bool PERM = true;
    bf16* O; const float* ssq_x; float* ssq_c; const f32x2* cs;
    __device__ __forceinline__ void operator()(const f32x4 (&acc)[2][2][4][2], const Unit& u, int ui, const LAS float* rst, int wr, int wc, int fr, int fq) const {
        const int row0 = u.pm * BM + wr * 64 + fr, colb = u.pn * BM + wc * 32 + 8 * fq;
        const bool sp = (u.pn >= 4 && u.pn <= 6);
        float crev[4]; rope_consts(crev, 4 * fq);
#pragma unroll
        for (int ai = 0; ai < 2; ++ai)
#pragma unroll
            for (int m = 0; m < 4; ++m) { const int row = row0 + ai * HALF + m * 16; const float rs = rst[ui * 256 + row - u.pm * BM];
                bf16* rowp = O + (size_t)row * PP + colb;
#pragma unroll
                for (int bj = 0; bj < 2; ++bj) { f32x4 v0 = acc[ai][bj][m][0] * rs, v1 = acc[ai][bj][m][1] * rs;
                    if (sp) {
                        if (u.pn == 6 && bj == 1 && wc == 0) rope8(v0, v1, row & (SEQ - 1), crev);
                        const bool is_cq = (u.pn == 4 && bj == 1) || (u.pn == 5), is_ckv = (u.pn == 6 && bj == 0);
                        if (is_cq || is_ckv) { float s = sumsq8(v0, v1); s += swz_xor<16>(s); s = xsum32(s);
                            const int slot = (is_ckv ? 12 : (u.pn == 4 ? 0 : 4 + 4 * bj)) + wc;
                            if (fq == 0) ssq_c[(size_t)slot * M + row] = s; }
                    }
                    *(u32x4*)(rowp + bj * HALF) = pack8(v0, v1); } }
    }
};
struct EpiMla {
    static constexpr bool PERM = true;
    bf16* O; const float* ssq_c; const f32x2* cs;
    __device__ __forceinline__ void operator()(const f32x4 (&acc)[2][2][4][2], const Unit& u, int ui, const LAS float* rst, int wr, int wc, int fr, int fq) const {
        const int row0 = u.pm * BM + wr * 64 + fr, colb = u.pn * BM + wc * 32 + 8 * fq;
        const bool isq = u.pn < 3;
        float crev[4]; rope_consts(crev, 4 * fq);
#pragma unroll
        for (int ai = 0; ai < 2; ++ai)
#pragma unroll
            for (int m = 0; m < 4; ++m) { const int row = row0 + ai * HALF + m * 16;
                const float rs = rst[ui * 256 + row - u.pm * BM];
                bf16* rowp = O + (size_t)row * QP + colb;
#pragma unroll
                for (int bj = 0; bj < 2; ++bj) { f32x4 v0 = acc[ai][bj][m][0] * rs, v1 = acc[ai][bj][m][1] * rs;
                    if ((u.pn == 1 && bj == 1) || (u.pn == 2 && bj == 0)) rope8(v0, v1, row & (SEQ - 1), crev);
                    *(u32x4*)(rowp + bj * HALF) = pack8(v0, v1); } }
    }
};
template <bool RS> struct EpiRes {
    static constexpr bool PERM = true;
    bf16* xb; float* ssq; float ascale;
    __device__ __forceinline__ void operator()(const f32x4 (&acc)[2][2][4][2], const Unit& u, int ui, const LAS float* rst, int wr, int wc, int fr, int fq) const {
        const int row0 = u.pm * BM + wr * 64 + fr, colb = u.pn * BM + wc * 32 + 8 * fq;
        u32x4 old[2][4][2];
#pragma unroll
        for (int ai = 0; ai < 2; ++ai)
#pragma unroll
            for (int m = 0; m < 4; ++m)
#pragma unroll
                for (int bj = 0; bj < 2; ++bj) old[ai][m][bj] = *(const u32x4*)(xb + (size_t)(row0 + ai * HALF + m * 16) * DM + colb + bj * HALF);
#pragma unroll
        for (int ai = 0; ai < 2; ++ai)
#pragma unroll
            for (int m = 0; m < 4; ++m) { const int row = row0 + ai * HALF + m * 16; bf16* rowp = xb + (size_t)row * DM + colb; float s = 0.f;
                const float asc = RS ? ascale * rst[(ui * 256 + row - u.pm * BM) * 4 + 2] : ascale;
#pragma unroll
                for (int bj = 0; bj < 2; ++bj) { const u32x4 o4 = old[ai][m][bj];
                    const f32x4 v0 = acc[ai][bj][m][0] * asc + (f32x4){bf_lo(o4.x), bf_hi(o4.x), bf_lo(o4.y), bf_hi(o4.y)}, v1 = acc[ai][bj][m][1] * asc + (f32x4){bf_lo(o4.z), bf_hi(o4.z), bf_lo(o4.w), bf_hi(o4.w)};
                    s += sumsq8(v0, v1); *(u32x4*)(rowp + bj * HALF) = pack8(v0, v1); }
                s += swz_xor<16>(s); s = xsum32(s);
                if (fq == 0) ssq[(size_t)(u.pn * 4 + wc) * M + row] = s; }
    }
};
struct EpiUp {
    static constexpr bool PERM = true;
    bf16* O; const float* ssq;
    __device__ __forceinline__ void operator()(const f32x4 (&acc)[2][2][4][2], const Unit& u, int ui, const LAS float* rst, int wr, int wc, int fr, int fq) const {
        const int row0 = u.pm * BM + wr * 64 + fr, colb = u.pn * BM + wc * 32 + 8 * fq;
#pragma unroll
        for (int ai = 0; ai < 2; ++ai)
#pragma unroll
            for (int m = 0; m < 4; ++m) { const int row = row0 + ai * HALF + m * 16; const float rs = rst[ui * 256 + row - u.pm * BM];
                bf16* rowp = O + (size_t)row * DFF + colb;
#pragma unroll
                for (int bj = 0; bj < 2; ++bj) { f32x4 v0 = acc[ai][bj][m][0] * rs, v1 = acc[ai][bj][m][1] * rs;
#pragma unroll
                    for (int e = 0; e < 4; ++e) { const float a = fmaxf(v0[e], 0.f), b = fmaxf(v1[e], 0.f); v0[e] = a * a; v1[e] = b * b; }
                    *(u32x4*)(rowp + bj * HALF) = pack8(v0, v1); } }
    }
};
__device__ __forceinline__ unsigned pk4_fp8(const f32x4& v) { unsigned w = 0u; w = __builtin_amdgcn_cvt_pk_fp8_f32(v[0], v[1], w, false); w = __builtin_amdgcn_cvt_pk_fp8_f32(v[2], v[3], w, true); return w; }
struct EpiUp8 {
    static constexpr bool PERM = true;
    unsigned char* O; const float* ssq;
    __device__ __forceinline__ void operator()(const f32x4 (&acc)[2][2][4][2], const Unit& u, int ui, const LAS float* rst, int wr, int wc, int fr, int fq) const {
        const int row0 = u.pm * BM + wr * 64 + fr, colb = u.pn * BM + wc * 32 + 8 * fq;
#pragma unroll
        for (int ai = 0; ai < 2; ++ai)
#pragma unroll
            for (int m = 0; m < 4; ++m) { const int row = row0 + ai * HALF + m * 16; const float rs = rst[ui * 256 + row - u.pm * BM];
                unsigned char* rowp = O + (size_t)row * DFF + colb;
                u32x2 w[2];
#pragma unroll
                for (int bj = 0; bj < 2; ++bj) { f32x4 v0 = acc[ai][bj][m][0] * rs, v1 = acc[ai][bj][m][1] * rs;
#pragma unroll
                    for (int e = 0; e < 4; ++e) { const float a = fmaxf(v0[e], 0.f), b = fmaxf(v1[e], 0.f); v0[e] = fminf(a * a * 8.0f, 448.0f); v1[e] = fminf(b * b * 8.0f, 448.0f); }
                    w[bj].x = pk4_fp8(v0); w[bj].y = pk4_fp8(v1); }
                { auto sx = __builtin_amdgcn_permlane16_swap(w[0].x, w[1].x, false, false); auto sy = __builtin_amdgcn_permlane16_swap(w[0].y, w[1].y, false, false);
                  const u32x4 o = {sx[0], sy[0], sx[1], sy[1]};
                  *(u32x4*)(rowp + ((fq & 1) ? HALF - 8 : 0)) = o; } }
    }
};
}

#define XB_TMO      128
#define XB_XCNT(j)  (256  + 64 * (j))
#define XB_XSUB(j)  (1280 + 64 * (j))
#define XB_XGEN(j)  (2304 + 64 * (j))
#define XB_TOP      3328
#define XB_TOPGEN   3392
#define XCD_BAR_WORDS 3456
#define XB_SPIN_CAP (1u << 18)
__device__ __forceinline__ unsigned xb_ld(unsigned* p)              { return __hip_atomic_load(p, __ATOMIC_RELAXED, __HIP_MEMORY_SCOPE_AGENT); }
__device__ __forceinline__ unsigned xb_add(unsigned* p, unsigned v) { return __hip_atomic_fetch_add(p, v, __ATOMIC_RELAXED, __HIP_MEMORY_SCOPE_AGENT); }
__device__ __forceinline__ unsigned xb_xcc_id() { return (unsigned)__builtin_amdgcn_s_getreg((3 << 11) | 20) & 0xFu; }
#define XB_SPIN(cond, bar) do { unsigned _sp = 0; while (cond) { __builtin_amdgcn_s_sleep(1); \
    if ((++_sp & 255u) == 0u) { if (xb_ld(&(bar)[XB_TMO])) break; if (_sp > XB_SPIN_CAP) { atomicAdd(&(bar)[XB_TMO], 1u); break; } } } } while (0)
struct XcdBarrier { unsigned* bar; unsigned x; volatile LAS unsigned* st; };
__device__ __forceinline__ XcdBarrier xcd_barrier_post(unsigned* bar, volatile LAS unsigned* st, bool t0  ) {
    XcdBarrier b; b.bar = bar; b.x = xb_xcc_id(); b.st = st;
    if (t0) (void)xb_add(&bar[XB_XCNT(b.x)], 1u);
    return b;
}
__device__ __forceinline__ void xcd_barrier_complete(unsigned* bar, unsigned x, unsigned& nloc, unsigned& nx) {
    const unsigned G = gridDim.x * gridDim.y * gridDim.z;
    unsigned sum, cnt, mine, sp = 0u;
    for (;;) {
        sum = 0u; cnt = 0u; mine = 0u;
#pragma unroll
        for (unsigned j = 0; j < 16; ++j) { const unsigned c = xb_ld(&bar[XB_XCNT(j)]); sum += c; cnt += (c > 0u) ? 1u : 0u; mine = (j == x) ? c : mine; }
        if (sum == G) break;
        __builtin_amdgcn_s_sleep(1);
        if ((++sp & 255u) == 0u) { if (xb_ld(&bar[XB_TMO])) break; if (sp > XB_SPIN_CAP) { atomicAdd(&bar[XB_TMO], 1u); break; } }
    }
    nloc = mine > 0u ? mine : 1u; nx = cnt > 0u ? cnt : 1u;
}
__device__ __forceinline__ void xcd_barrier(const XcdBarrier& b, bool t0  ) {
    asm volatile("s_waitcnt vmcnt(0)" ::: "memory");
    __syncthreads();
    if (t0) {
        GAS unsigned* barg_ = (GAS unsigned*)b.bar; unsigned bx = b.x;
        asm volatile("" : "+s"(barg_), "+s"(bx)); unsigned* bar = (unsigned*)barg_;
        __builtin_amdgcn_s_waitcnt(0);
        unsigned nloc = b.st[0], nx = b.st[1];
        if (nloc == 0u) { xcd_barrier_complete(bar, bx, nloc, nx); b.st[0] = nloc; b.st[1] = nx; }
        const unsigned old = xb_add(&bar[XB_XSUB(bx)], 1u);
        const unsigned gen = old / nloc;
        if (old + 1u == (gen + 1u) * nloc) {
            __builtin_amdgcn_fence(__ATOMIC_RELEASE, "agent");
            asm volatile("s_waitcnt vmcnt(0)" ::: "memory");
            const unsigned og = xb_add(&bar[XB_TOP], 1u);
            const unsigned tg = og / nx;
            if (og + 1u == (tg + 1u) * nx) xb_add(&bar[XB_TOPGEN], 1u);
            else XB_SPIN(xb_ld(&bar[XB_TOPGEN]) == tg, bar);
            __builtin_amdgcn_fence(__ATOMIC_ACQUIRE, "agent");
            xb_add(&bar[XB_XGEN(bx)], 1u);
            asm volatile("s_waitcnt vmcnt(0)" ::: "memory");
        } else {
            XB_SPIN(xb_ld(&bar[XB_XGEN(bx)]) == gen, bar);
            __builtin_amdgcn_fence(__ATOMIC_ACQUIRE, "agent");
            asm volatile("s_waitcnt vmcnt(0)" ::: "memory");
        }
    }
    __syncthreads();
}

namespace att {
typedef float f32x16 __attribute__((ext_vector_type(16)));
typedef short s16x4 __attribute__((ext_vector_type(4)));
typedef LAS const char* lds_cptr;
constexpr int THRL = 8;
constexpr int NEXP1 = 8;
__device__ __forceinline__ int crow(int r, int hi) { return (r & 3) + 8 * (r >> 2) + 4 * hi; }
__device__ __forceinline__ void glds16s(const void* sbase  , unsigned voff  , unsigned lds_dst) { unsigned keep;
    asm volatile("s_mov_b32 %0, m0\n\ts_mov_b32 m0, %3\n\ts_nop 0\n\tglobal_load_lds_dwordx4 %1, %2\n\ts_mov_b32 m0, %0" : "=&s"(keep) : "v"(voff), "s"(sbase), "s"(lds_dst) : "memory"); }
__device__ __forceinline__ void glds16(const void* gsrc, unsigned lds_dst) { unsigned keep;
    asm volatile("s_mov_b32 %0, m0\n\ts_mov_b32 m0, %2\n\ts_nop 0\n\tglobal_load_lds_dwordx4 %1, off\n\ts_mov_b32 m0, %0" : "=&s"(keep) : "v"(gsrc), "s"(lds_dst) : "memory"); }
__device__ __forceinline__ float max3f(float a, float b, float c) { return __builtin_fmaxf(__builtin_fmaxf(a, b), c); }
#define ATT_WAIT_BAR(N) asm volatile("s_nop 15\n\ts_waitcnt vmcnt(" #N ") lgkmcnt(0)\n\ts_barrier" ::: "memory")
#define ATT_SBAR() __builtin_amdgcn_sched_barrier(0)
__device__ __forceinline__ float swap_add(float v) { auto rr = __builtin_amdgcn_permlane32_swap(__float_as_uint(v), __float_as_uint(v), false, false); return __uint_as_float(rr[0]) + __uint_as_float(rr[1]); }
__device__ __forceinline__ float swap_max(float v) { auto rr = __builtin_amdgcn_permlane32_swap(__float_as_uint(v), __float_as_uint(v), false, false); return fmaxf(__uint_as_float(rr[0]), __uint_as_float(rr[1])); }

#define MFMA_FENCE1(a) asm volatile("s_nop 15\n\ts_nop 1" : "+v"(a))
#define MFMA_FENCE2(a, b) asm volatile("s_nop 15\n\ts_nop 1" : "+v"(a), "+v"(b))
template <int ND0> __device__ __forceinline__ void qkt_lds(f32x16& p0, f32x16& p1, lds_cptr kslot, const bf16x8* qr, const f32x16& c0, int r32, int hi) {
    lds_cptr kb = kslot + hi * 1024 + r32 * 16;
    bf16x8 kf[2 * ND0];
#pragma unroll
    for (int d0 = 0; d0 < ND0; ++d0) { kf[2 * d0] = *(const LAS bf16x8*)(kb + d0 * 2048); kf[2 * d0 + 1] = *(const LAS bf16x8*)(kb + d0 * 2048 + 512); }
    ATT_SBAR();
#pragma unroll
    for (int d0 = 0; d0 < ND0; ++d0) {
        if (d0 == 0) { p0 = __builtin_amdgcn_mfma_f32_32x32x16_bf16(kf[0], qr[0], c0, 0, 0, 0); p1 = __builtin_amdgcn_mfma_f32_32x32x16_bf16(kf[1], qr[0], c0, 0, 0, 0); }
        else { p0 = __builtin_amdgcn_mfma_f32_32x32x16_bf16(kf[2 * d0], qr[d0], p0, 0, 0, 0); p1 = __builtin_amdgcn_mfma_f32_32x32x16_bf16(kf[2 * d0 + 1], qr[d0], p1, 0, 0, 0); } }
}
struct VFrag { s16x4 lo[8], hi[8]; };
__device__ __forceinline__ void pv64_read(VFrag& v, int vb) {
#pragma unroll
    for (int d0 = 0; d0 < 2; ++d0)
#pragma unroll
        for (int ks = 0; ks < 4; ++ks) {
            asm volatile("ds_read_b64_tr_b16 %0,%1 offset:%c2" : "=&v"(v.lo[d0 * 4 + ks]) : "v"(vb), "i"(d0 * 4096 + ks * 1024) : "memory");
            asm volatile("ds_read_b64_tr_b16 %0,%1 offset:%c2" : "=&v"(v.hi[d0 * 4 + ks]) : "v"(vb), "i"(d0 * 4096 + ks * 1024 + 512) : "memory"); }
}
#define ATT_PK(k) (bf16x8){lo[k][0], lo[k][1], lo[k][2], lo[k][3], hi[k][0], hi[k][1], hi[k][2], hi[k][3]}
__device__ __forceinline__ void pv64_mma(f32x16* o, VFrag& v, bf16x8 pa0, bf16x8 pa1, bf16x8 pa2, bf16x8 pa3) {
    asm volatile("s_waitcnt lgkmcnt(0)" : "+v"(v.lo[0]), "+v"(v.lo[1]), "+v"(v.lo[2]), "+v"(v.lo[3]), "+v"(v.lo[4]), "+v"(v.lo[5]), "+v"(v.lo[6]), "+v"(v.lo[7]),
                 "+v"(v.hi[0]), "+v"(v.hi[1]), "+v"(v.hi[2]), "+v"(v.hi[3]), "+v"(v.hi[4]), "+v"(v.hi[5]), "+v"(v.hi[6]), "+v"(v.hi[7]) :: "memory");
#pragma unroll
    for (int d0 = 0; d0 < 2; ++d0) { const s16x4* lo = v.lo + 4 * d0; const s16x4* hi = v.hi + 4 * d0;
        o[d0] = __builtin_amdgcn_mfma_f32_32x32x16_bf16(pa0, ATT_PK(0), o[d0], 0, 0, 0);
        o[d0] = __builtin_amdgcn_mfma_f32_32x32x16_bf16(pa1, ATT_PK(1), o[d0], 0, 0, 0);
        o[d0] = __builtin_amdgcn_mfma_f32_32x32x16_bf16(pa2, ATT_PK(2), o[d0], 0, 0, 0);
        o[d0] = __builtin_amdgcn_mfma_f32_32x32x16_bf16(pa3, ATT_PK(3), o[d0], 0, 0, 0); }
}
struct V32 { s16x4 lo[4], hi[4]; };
__device__ __forceinline__ void pv32_read(V32& v, int vb) {
#pragma unroll
    for (int d0 = 0; d0 < 2; ++d0)
#pragma unroll
        for (int ks = 0; ks < 2; ++ks) {
            asm volatile("ds_read_b64_tr_b16 %0,%1 offset:%c2" : "=&v"(v.lo[d0 * 2 + ks]) : "v"(vb), "i"(d0 * 4096 + ks * 1024) : "memory");
            asm volatile("ds_read_b64_tr_b16 %0,%1 offset:%c2" : "=&v"(v.hi[d0 * 2 + ks]) : "v"(vb), "i"(d0 * 4096 + ks * 1024 + 512) : "memory"); }
}
__device__ __forceinline__ void pv32_mma(f32x16* o, V32& v, bf16x8 pa0, bf16x8 pa1) {
    asm volatile("s_waitcnt lgkmcnt(0)" : "+v"(v.lo[0]), "+v"(v.lo[1]), "+v"(v.lo[2]), "+v"(v.lo[3]), "+v"(v.hi[0]), "+v"(v.hi[1]), "+v"(v.hi[2]), "+v"(v.hi[3]) :: "memory");
#pragma unroll
    for (int d0 = 0; d0 < 2; ++d0) {
        o[d0] = __builtin_amdgcn_mfma_f32_32x32x16_bf16(pa0, ((bf16x8){v.lo[2 * d0][0], v.lo[2 * d0][1], v.lo[2 * d0][2], v.lo[2 * d0][3], v.hi[2 * d0][0], v.hi[2 * d0][1], v.hi[2 * d0][2], v.hi[2 * d0][3]}), o[d0], 0, 0, 0);
        o[d0] = __builtin_amdgcn_mfma_f32_32x32x16_bf16(pa1, ((bf16x8){v.lo[2 * d0 + 1][0], v.lo[2 * d0 + 1][1], v.lo[2 * d0 + 1][2], v.lo[2 * d0 + 1][3], v.hi[2 * d0 + 1][0], v.hi[2 * d0 + 1][1], v.hi[2 * d0 + 1][2], v.hi[2 * d0 + 1][3]}), o[d0], 0, 0, 0); }
}
__device__ __forceinline__ void pv32(f32x16* o, int vb, bf16x8 pa0, bf16x8 pa1) {
#pragma unroll
    for (int d0 = 0; d0 < 2; ++d0) { s16x4 lo[2], hi[2];
#pragma unroll
        for (int ks = 0; ks < 2; ++ks) {
            asm volatile("ds_read_b64_tr_b16 %0,%1 offset:%c2" : "=&v"(lo[ks]) : "v"(vb), "i"(d0 * 4096 + ks * 1024) : "memory");
            asm volatile("ds_read_b64_tr_b16 %0,%1 offset:%c2" : "=&v"(hi[ks]) : "v"(vb), "i"(d0 * 4096 + ks * 1024 + 512) : "memory"); }
        asm volatile("s_waitcnt lgkmcnt(0)" ::: "memory"); ATT_SBAR();
        o[d0] = __builtin_amdgcn_mfma_f32_32x32x16_bf16(pa0, ATT_PK(0), o[d0], 0, 0, 0);
        o[d0] = __builtin_amdgcn_mfma_f32_32x32x16_bf16(pa1, ATT_PK(1), o[d0], 0, 0, 0);
#undef ATT_PK
    }
}
__device__ __forceinline__ void cmask(f32x16& p0, f32x16& p1, int jb, int qrel, int hi) {
    const int kb = 64 * jb + 4 * hi;
#pragma unroll
    for (int r = 0; r < 16; ++r) { const int kv = kb + (r & 3) + 8 * (r >> 2); if (kv > qrel) p0[r] = -INFINITY; if (kv + 32 > qrel) p1[r] = -INFINITY; }
}
struct SmState { float mhat, l; f32x16 negm; f32x16 o[2]; };
__device__ __forceinline__ void sm_init(SmState& s) { s.mhat = 0.f; s.l = 0.f; s.negm = f32x16{}; s.o[0] = f32x16{}; s.o[1] = f32x16{}; }
__device__ __forceinline__ bool sm_decide64(SmState& s, f32x16& p0, f32x16& p1, LAS float* wsf, int r32, int hi) {
    float a = max3f(p0[0], p0[1], p1[0]), b = max3f(p0[2], p0[3], p1[1]); a = max3f(a, p1[2], p1[3]);
#pragma unroll
    for (int r = 4; r < 16; r += 4) { a = max3f(a, p0[r], p0[r + 1]); b = max3f(b, p0[r + 2], p0[r + 3]); a = max3f(a, p1[r], p1[r + 1]); b = max3f(b, p1[r + 2], p1[r + 3]); }
    const float rm = swap_max(fmaxf(a, b)); bool resc_ = false;
    if (__any(rm > (float)THRL)) { const float dl = fmaxf(rm, 0.f); s.mhat += dl;
#pragma unroll
        for (int r = 0; r < 16; ++r) { p0[r] -= dl; p1[r] -= dl; s.negm[r] = -s.mhat; }
        const float f = __builtin_amdgcn_exp2f(-dl); s.l *= f; if (hi == 0) wsf[r32] = f;
        resc_ = true; }
#pragma unroll
    for (int r = 0; r < NEXP1; ++r) p0[r] = __builtin_amdgcn_exp2f(p0[r]);
    asm volatile("" : "+v"(p0));
    return resc_;
}
__device__ __forceinline__ void sm_exp64(SmState& s, bool resc, f32x16& p0, f32x16& p1, LAS float* wsf, int hi, u32x4& pw0, u32x4& pw1, u32x4& pw2, u32x4& pw3) {
    if (resc) { asm volatile("s_waitcnt lgkmcnt(0)" ::: "memory"); MFMA_FENCE2(s.o[0], s.o[1]);
#pragma unroll
        for (int d = 0; d < 2; ++d)
#pragma unroll
            for (int r = 0; r < 16; ++r) s.o[d][r] *= wsf[crow(r, hi)];
        asm volatile("s_waitcnt lgkmcnt(0)" ::: "memory"); }
    float sa0 = 0.f, sa1 = 0.f, sb0 = 0.f, sb1 = 0.f;
#pragma unroll
    for (int r = 0; r < 16; r += 2) { if (r >= NEXP1) { p0[r] = __builtin_amdgcn_exp2f(p0[r]); p0[r + 1] = __builtin_amdgcn_exp2f(p0[r + 1]); }
        p1[r] = __builtin_amdgcn_exp2f(p1[r]); p1[r + 1] = __builtin_amdgcn_exp2f(p1[r + 1]);
        sa0 += p0[r]; sa1 += p0[r + 1]; sb0 += p1[r]; sb1 += p1[r + 1]; }
    asm volatile("" : "+v"(sa0), "+v"(sa1), "+v"(sb0), "+v"(sb1));
    s.l += (sa0 + sa1) + (sb0 + sb1);
    pw0 = (u32x4){cvt_pk_bf16(p0[0], p0[1]), cvt_pk_bf16(p0[2], p0[3]), cvt_pk_bf16(p0[4], p0[5]), cvt_pk_bf16(p0[6], p0[7])};
    pw1 = (u32x4){cvt_pk_bf16(p0[8], p0[9]), cvt_pk_bf16(p0[10], p0[11]), cvt_pk_bf16(p0[12], p0[13]), cvt_pk_bf16(p0[14], p0[15])};
    pw2 = (u32x4){cvt_pk_bf16(p1[0], p1[1]), cvt_pk_bf16(p1[2], p1[3]), cvt_pk_bf16(p1[4], p1[5]), cvt_pk_bf16(p1[6], p1[7])};
    pw3 = (u32x4){cvt_pk_bf16(p1[8], p1[9]), cvt_pk_bf16(p1[10], p1[11]), cvt_pk_bf16(p1[12], p1[13]), cvt_pk_bf16(p1[14], p1[15])};
}
__device__ __forceinline__ void sm_step32(SmState& s, f32x16& p0, LAS float* wsf, int r32, int hi, u32x4& pw0, u32x4& pw1) {
    float a = max3f(p0[0], p0[1], p0[2]), b = max3f(p0[3], p0[4], p0[5]);
    a = max3f(a, p0[6], p0[7]); b = max3f(b, p0[8], p0[9]); a = max3f(a, p0[10], p0[11]); b = max3f(b, p0[12], p0[13]); a = max3f(a, p0[14], p0[15]);
    const float rm = swap_max(fmaxf(a, b));
    if (__any(rm > (float)THRL)) { const float dl = fmaxf(rm, 0.f); s.mhat += dl;
#pragma unroll
        for (int r = 0; r < 16; ++r) { p0[r] -= dl; s.negm[r] = -s.mhat; }
        const float f = __builtin_amdgcn_exp2f(-dl); s.l *= f; if (hi == 0) wsf[r32] = f;
        asm volatile("s_waitcnt lgkmcnt(0)" ::: "memory"); MFMA_FENCE2(s.o[0], s.o[1]);
#pragma unroll
        for (int d = 0; d < 2; ++d)
#pragma unroll
            for (int r = 0; r < 16; ++r) s.o[d][r] *= wsf[crow(r, hi)];
        asm volatile("s_waitcnt lgkmcnt(0)" ::: "memory"); }
    float sum = 0.f;
#pragma unroll
    for (int r = 0; r < 16; ++r) { p0[r] = __builtin_amdgcn_exp2f(p0[r]); sum += p0[r]; }
    s.l += sum;
    pw0 = (u32x4){cvt_pk_bf16(p0[0], p0[1]), cvt_pk_bf16(p0[2], p0[3]), cvt_pk_bf16(p0[4], p0[5]), cvt_pk_bf16(p0[6], p0[7])};
    pw1 = (u32x4){cvt_pk_bf16(p0[8], p0[9]), cvt_pk_bf16(p0[10], p0[11]), cvt_pk_bf16(p0[12], p0[13]), cvt_pk_bf16(p0[14], p0[15])};
}
__device__ __forceinline__ float sm_finish(SmState& s, LAS float* wsf, LAS bf16* stg, bf16* orow0, long rstride, int lane, int r32, int hi, float* ssq_row0 = nullptr) {
    MFMA_FENCE2(s.o[0], s.o[1]);
    const float lt = swap_add(s.l);
    if (hi == 0) wsf[32 + r32] = lt;
    asm volatile("s_waitcnt lgkmcnt(0)" ::: "memory");
    float rl[16];
#pragma unroll
    for (int r = 0; r < 16; ++r) rl[r] = wsf[32 + crow(r, hi)];
    asm volatile("s_waitcnt lgkmcnt(0)" : "+v"(rl[0]), "+v"(rl[1]), "+v"(rl[2]), "+v"(rl[3]), "+v"(rl[4]), "+v"(rl[5]), "+v"(rl[6]), "+v"(rl[7]), "+v"(rl[8]), "+v"(rl[9]), "+v"(rl[10]), "+v"(rl[11]), "+v"(rl[12]), "+v"(rl[13]), "+v"(rl[14]), "+v"(rl[15]) :: "memory");
#pragma unroll
    for (int r = 0; r < 16; ++r) { const int orow = crow(r, hi); const float ri = __builtin_amdgcn_rcpf(rl[r]);
#pragma unroll
        for (int d0 = 0; d0 < 2; ++d0) stg[orow * 64 + d0 * 32 + r32] = (bf16)(cvt_pk_bf16(s.o[d0][r] * ri, 0.f) & 0xffffu); }
    asm volatile("s_waitcnt lgkmcnt(0)" ::: "memory");
#pragma unroll
    for (int i = 0; i < 4; ++i) { const int row = i * 8 + (lane >> 3), ch = lane & 7; const u32x4 v = *(const LAS u32x4*)(stg + row * 64 + ch * 8); *(u32x4*)(orow0 + (long)row * rstride + ch * 8) = v;
        if (ssq_row0) { float q = bf_lo(v.x) * bf_lo(v.x) + bf_hi(v.x) * bf_hi(v.x) + bf_lo(v.y) * bf_lo(v.y) + bf_hi(v.y) * bf_hi(v.y) + bf_lo(v.z) * bf_lo(v.z) + bf_hi(v.z) * bf_hi(v.z) + bf_lo(v.w) * bf_lo(v.w) + bf_hi(v.w) * bf_hi(v.w);
            q += swz_xor<1>(q); q += swz_xor<2>(q); q += swz_xor<4>(q); if (ch == 0) ssq_row0[row] = q; } }
    asm volatile("s_waitcnt lgkmcnt(0)" ::: "memory");
    return s.mhat + __builtin_amdgcn_logf(lt);
}

constexpr int L_K = 0, KSLOT = 12288, L_V = 3 * KSLOT, VSLOT = 8192, L_WS = L_V + 3 * VSLOT, L_OST = L_WS + 8 * 256, L_TB = L_OST + 8 * 4096, L_Q = L_TB + (256 + 4096) * 4, L_KM = L_Q + 16, L_END = L_KM + 16 * 64 * 4;
static_assert(L_END <= RING_BYTES, "attention LDS map");

__device__ __forceinline__ int wg_next(unsigned* ctr, LAS unsigned char* shm, int slot_off, int wave) {
    volatile LAS unsigned* slot = (volatile LAS unsigned*)(shm + slot_off);
    asm volatile("s_nop 15\n\ts_waitcnt vmcnt(0) lgkmcnt(0)\n\ts_barrier" ::: "memory");
    if (wave == 0 && lane_id() == 0) slot[0] = __hip_atomic_fetch_add(ctr, 1u, __ATOMIC_RELAXED, __HIP_MEMORY_SCOPE_AGENT);
    asm volatile("s_nop 15\n\ts_waitcnt vmcnt(0) lgkmcnt(0)\n\ts_barrier" ::: "memory");
    const unsigned v = slot[0];
    return (int)__builtin_amdgcn_readfirstlane(v);
}

__device__ __forceinline__ void mla_unit(int b, int h, int qb, const bf16* QM, const bf16* PROJ, bf16* OB, float* ssq_mix, LAS unsigned char* shm, const int wid) {
    const int lane = lane_id(), tid = wid * 64 + lane, r32 = lane & 31, hi = lane >> 5; (void)tid;
    const long rowbase = (long)b * SEQ; const int q0 = qb * 256;
    const unsigned lds0 = (unsigned)(uintptr_t)shm;
    LAS float* wsf = (LAS float*)(shm + L_WS) + wid * 64;
    const bf16* Qw = QM + (rowbase + q0 + wid * 32 + r32) * QP;
    bf16x8 qr[6];
#pragma unroll
    for (int d0 = 0; d0 < 4; ++d0) qr[d0] = *(const bf16x8*)(Qw + Q_NOPE + h * 64 + d0 * 16 + hi * 8);
#pragma unroll
    for (int d0 = 0; d0 < 2; ++d0) qr[4 + d0] = *(const bf16x8*)(Qw + Q_ROPE + h * 32 + d0 * 16 + hi * 8);
    asm volatile("" : "+v"(qr[0]), "+v"(qr[1]), "+v"(qr[2]), "+v"(qr[3]), "+v"(qr[4]), "+v"(qr[5]));
    const bf16* ksrc = QM + (rowbase + lane) * QP + Q_KV + h * 128 + wid * 8;
    const bf16* rsrc = PROJ + (rowbase + lane) * PP + C_KR + (wid & 3) * 8;
    const bf16* vsrc = QM + (rowbase + 16 * (wid & 3) + (lane >> 2)) * QP + Q_KV + h * 128 + 64 + (wid >> 2) * 32 + (lane & 3) * 8;
    const unsigned kdst = lds0 + L_K + wid * 1024, rdst = lds0 + L_K + (8 + (wid & 3)) * 1024, vdst = lds0 + L_V + wid * 1024;
    const int vb0 = (int)(lds0 + L_V) + ((lane >> 4) & 1) * 32 + (lane & 3) * 8 + (4 * hi + ((lane & 15) >> 2)) * 64;
    const lds_cptr kbase = (lds_cptr)(shm + L_K);
    const int NT = 4 * qb + 4, qrel = wid * 32 + r32;
    SmState st; sm_init(st);
    const bool halfB = wid >= 4;
#define MLA_K(t, s) do { glds16(ksrc + (long)(t) * 64 * QP, (unsigned)__builtin_amdgcn_readfirstlane(kdst + (s) * KSLOT)); \
        if (wid < 4) glds16(rsrc + (long)(t) * 64 * PP, (unsigned)__builtin_amdgcn_readfirstlane(rdst + (s) * KSLOT)); } while (0)
#define MLA_V(t, s) glds16(vsrc + (long)(t) * 64 * QP, (unsigned)__builtin_amdgcn_readfirstlane(vdst + (s) * VSLOT))
#define MLA_WODD(t) ATT_WAIT_BAR(0)
#define MLA_WEVEN(t) ATT_WAIT_BAR(0)
    f32x16 p0, p1; bool resc = false; u32x4 pw0, pw1, pw2, pw3;
#define ATT_SKIP(t) ((t) >= NT - 4 && 64 * ((t) - (NT - 4)) > 32 * wid + 31)
#define MLA_PART1(t, sl) do { if (ATT_SKIP(t)) resc = false; else { qkt_lds<6>(p0, p1, kbase + (sl) * KSLOT, qr, st.negm, r32, hi); if ((t) >= NT - 4) cmask(p0, p1, (t) - (NT - 4), qrel, hi); resc = sm_decide64(st, p0, p1, wsf, r32, hi); } } while (0)
#define MLA_PART2(t, sl) do { if (!ATT_SKIP(t)) { VFrag vf_; pv64_read(vf_, vb0 + (sl) * VSLOT); sm_exp64(st, resc, p0, p1, wsf, hi, pw0, pw1, pw2, pw3); \
        pv64_mma(st.o, vf_, __builtin_bit_cast(bf16x8, pw0), __builtin_bit_cast(bf16x8, pw1), __builtin_bit_cast(bf16x8, pw2), __builtin_bit_cast(bf16x8, pw3)); } } while (0)
    MLA_K(0, 0); MLA_V(0, 0);
    ATT_WAIT_BAR(0);
    if (!halfB) { int sc = 0;
        for (int t = 0; t < NT; ++t) { const int sn = sc == 2 ? 0 : sc + 1;
            if (t + 1 < NT) { MLA_K(t + 1, sn); MLA_V(t + 1, sn); }
            MLA_PART1(t, sc); MLA_PART2(t, sc); ATT_WAIT_BAR(0);
            sc = sn; }
        ATT_WAIT_BAR(0);
    } else { int sp = 0, sc = 1;
        if (1 < NT) { MLA_K(1, 1); MLA_V(1, 1); }
        MLA_PART1(0, 0); ATT_WAIT_BAR(0);
        for (int t = 1; t < NT; ++t) { const int sn = sc == 2 ? 0 : sc + 1;
            if (t + 1 < NT) { MLA_K(t + 1, sn); MLA_V(t + 1, sn); }
            MLA_PART2(t - 1, sp); MLA_PART1(t, sc); ATT_WAIT_BAR(0);
            sp = sc; sc = sn; }
        MLA_PART2(NT - 1, sp); ATT_WAIT_BAR(0);
    }
#undef MLA_K
#undef MLA_V
#undef MLA_WODD
#undef MLA_WEVEN
#undef MLA_PART1
#undef MLA_PART2
    (void)sm_finish(st, wsf, (LAS bf16*)(shm + L_OST) + wid * 2048, OB + (rowbase + q0 + wid * 32) * DM + O_B + h * 64, DM, lane, r32, hi, ssq_mix + (size_t)h * M + (rowbase + q0 + wid * 32));
}


typedef short v4i16_t __attribute__((ext_vector_type(4)));
__device__ __forceinline__ s16x4 vtr16(lds_cptr p) { return __builtin_bit_cast(s16x4, __builtin_amdgcn_ds_read_tr16_b64_v4i16((LAS v4i16_t*)p)); }
__device__ __forceinline__ float rowmax64(const f32x16& p0, const f32x16& p1) {
    float a = max3f(p0[0], p0[1], p1[0]), b = max3f(p0[2], p0[3], p1[1]); a = max3f(a, p1[2], p1[3]);
#pragma unroll
    for (int r = 4; r < 16; r += 4) { a = max3f(a, p0[r], p0[r + 1]); b = max3f(b, p0[r + 2], p0[r + 3]); a = max3f(a, p1[r], p1[r + 1]); b = max3f(b, p1[r + 2], p1[r + 3]); }
    return swap_max(fmaxf(a, b));
}
#define PINV(x) asm volatile("" : "+v"(x))
#define MF32(a, b, c) __builtin_amdgcn_mfma_f32_32x32x16_bf16(a, b, c, 0, 0, 0)
__device__ __forceinline__ void mla_unit2(int b, int h, int qb, const bf16* QM, const bf16* PROJ, bf16* OB, float* ssq_mix, LAS unsigned char* shm, const int wid) {
    const int lane = lane_id(), r32 = lane & 31, hi = lane >> 5;
    const long rowbase = (long)b * SEQ; const int q0 = qb * 256;
    const unsigned lds0 = (unsigned)(uintptr_t)shm;
    LAS float* wsf = (LAS float*)(shm + L_WS) + wid * 64;
    const bf16* Qw = QM + (rowbase + q0 + wid * 32 + r32) * QP;
    bf16x8 qr[6];
#pragma unroll
    for (int d0 = 0; d0 < 4; ++d0) qr[d0] = *(const bf16x8*)(Qw + Q_NOPE + h * 64 + d0 * 16 + hi * 8);
#pragma unroll
    for (int d0 = 0; d0 < 2; ++d0) qr[4 + d0] = *(const bf16x8*)(Qw + Q_ROPE + h * 32 + d0 * 16 + hi * 8);
    asm volatile("" : "+v"(qr[0]), "+v"(qr[1]), "+v"(qr[2]), "+v"(qr[3]), "+v"(qr[4]), "+v"(qr[5]));
    const bf16* kbase_g = QM + rowbase * QP + Q_KV + h * 128 + wid * 8; const unsigned koff = (unsigned)(lane * QP * 2);
    const bf16* rbase_g = PROJ + rowbase * PP + C_KR + (wid & 3) * 8; const unsigned roff = (unsigned)(lane * PP * 2);
    const bf16* vbase_g = QM + (rowbase + 16 * (wid & 3)) * QP + Q_KV + h * 128 + 64 + (wid >> 2) * 32; const unsigned voff_ = (unsigned)(((lane >> 2) * QP + (lane & 3) * 8) * 2);
    const unsigned kdst = lds0 + L_K + wid * 1024, rdst = lds0 + L_K + (8 + (wid & 3)) * 1024, vdst = lds0 + L_V + wid * 1024;
#define U2_K(t, s) do { glds16s(kbase_g + (long)(t) * 64 * QP, koff, (unsigned)__builtin_amdgcn_readfirstlane(kdst + (s) * KSLOT)); \
        if (wid < 4) glds16s(rbase_g + (long)(t) * 64 * PP, roff, (unsigned)__builtin_amdgcn_readfirstlane(rdst + (s) * KSLOT)); } while (0)
#define U2_V(t, s) glds16s(vbase_g + (long)(t) * 64 * QP, voff_, (unsigned)__builtin_amdgcn_readfirstlane(vdst + (s) * VSLOT))
    const lds_cptr vp0 = (lds_cptr)(shm + L_V) + ((lane >> 4) & 1) * 32 + (lane & 3) * 8 + (4 * hi + ((lane & 15) >> 2)) * 64;
    const lds_cptr kp0 = (lds_cptr)(shm + L_K) + hi * 1024 + r32 * 16;
    const int NT = 4 * qb + 4, qrel = wid * 32 + r32;
    SmState st; sm_init(st); PINV(st.negm);
    bool resc = false;
    f32x16 pA0, pA1, pB0, pB1; bf16x8 kf[8]; s16x4 vlo[8], vhi[8]; u32x4 pw0, pw1, pw2, pw3;
    int sl_prev = 0, sl_cur = 0, sl_next = 1;
#define U2_ROT() do { sl_prev = sl_cur; sl_cur = sl_next; sl_next = (sl_next == 2) ? 0 : sl_next + 1; } while (0)
#define U2_KLOAD2(kp, d0) do { kf[2 * (d0)] = *(const LAS bf16x8*)((kp) + (d0) * 2048); kf[2 * (d0) + 1] = *(const LAS bf16x8*)((kp) + (d0) * 2048 + 512); } while (0)
#define U2_RESC() do { if (resc) { _Pragma("unroll") for (int d_ = 0; d_ < 2; ++d_) _Pragma("unroll") for (int r = 0; r < 16; ++r) st.o[d_][r] *= wsf[crow(r, hi)]; } } while (0)
    U2_K(0, 0); U2_V(0, 0); U2_K(1, 1); U2_K(2, 2); U2_V(1, 1);
    ATT_WAIT_BAR(0);
    { bf16x8 k0[12];
#pragma unroll
      for (int d0 = 0; d0 < 6; ++d0) { k0[2 * d0] = *(const LAS bf16x8*)(kp0 + d0 * 2048); k0[2 * d0 + 1] = *(const LAS bf16x8*)(kp0 + d0 * 2048 + 512); }
      ATT_SBAR();
      pA0 = MF32(k0[0], qr[0], st.negm); pA1 = MF32(k0[1], qr[0], st.negm);
#pragma unroll
      for (int d0 = 1; d0 < 6; ++d0) { pA0 = MF32(k0[2 * d0], qr[d0], pA0); pA1 = MF32(k0[2 * d0 + 1], qr[d0], pA1); } }
    if (NT == 4) cmask(pA0, pA1, 0, qrel, hi);
    { const float rm = rowmax64(pA0, pA1); st.mhat = rm;
#pragma unroll
      for (int r = 0; r < 16; ++r) { pA0[r] = __builtin_amdgcn_exp2f(pA0[r] - rm); pA1[r] = __builtin_amdgcn_exp2f(pA1[r] - rm); st.negm[r] = -rm; } }
    PINV(pA0); PINV(pA1); PINV(st.negm); ATT_SBAR();
    ATT_WAIT_BAR(0);
    U2_ROT();
#pragma unroll
    for (int d0 = 0; d0 < 4; ++d0) U2_KLOAD2(kp0 + sl_cur * KSLOT, d0);
#define U2_PKW(P, i) cvt_pk_bf16(P[i], P[(i) + 1])
#define U2_PAF(k) __builtin_bit_cast(bf16x8, pw##k)
#define U2_VFR(i) (bf16x8){vlo[i][0], vlo[i][1], vlo[i][2], vlo[i][3], vhi[i][0], vhi[i][1], vhi[i][2], vhi[i][3]}
#define U2_VRD(i) do { vlo[i] = vtr16(vp_ + (((i) >> 2) * 4096 + ((i) & 3) * 1024)); vhi[i] = vtr16(vp_ + (((i) >> 2) * 4096 + ((i) & 3) * 1024 + 512)); } while (0)
#define U2_KRD(G, d0) do { if (G) { U2_KLOAD2(kp0 + sl_next * KSLOT, d0); ATT_SBAR(); } } while (0)
#define U2_GAPA(MF, a0, a1, a2, a3, W0, W1, PW) do { MF; sacc += a0; sacc += a1; sacc += a2; sacc += a3; W0; W1; PINV(PW); PINV(sacc); ATT_SBAR(); } while (0)
#define U2_GAPB(MF, X, i) do { MF; X[i] = __builtin_amdgcn_exp2f(X[i]); X[(i) + 1] = __builtin_amdgcn_exp2f(X[(i) + 1]); X[(i) + 2] = __builtin_amdgcn_exp2f(X[(i) + 2]); X[(i) + 3] = __builtin_amdgcn_exp2f(X[(i) + 3]); PINV(X); ATT_SBAR(); } while (0)
#define U2_STEP(C0, C1, P0, P1, t, MASK, GK, GV, GL) do { ATT_SBAR(); \
    if (GK) U2_K((t) + 2, sl_prev); if (GV) U2_V((t) + 1, sl_next); \
    const lds_cptr vp_ = vp0 + sl_prev * VSLOT; \
    float sacc = P0[0] + P0[1]; \
    U2_GAPA(C0 = MF32(kf[0], qr[0], st.negm), P0[2], P0[3], P0[4], P0[5],     pw0[0] = U2_PKW(P0, 0),  pw0[1] = U2_PKW(P0, 2),  pw0); \
    U2_GAPA(C1 = MF32(kf[1], qr[0], st.negm), P0[6], P0[7], P0[8], P0[9],     pw0[2] = U2_PKW(P0, 4),  pw0[3] = U2_PKW(P0, 6),  pw0); \
    U2_GAPA(C0 = MF32(kf[2], qr[1], C0),      P0[10], P0[11], P0[12], P0[13], pw1[0] = U2_PKW(P0, 8),  pw1[1] = U2_PKW(P0, 10), pw1); \
    U2_GAPA(C1 = MF32(kf[3], qr[1], C1),      P0[14], P0[15], P1[0], P1[1],   pw1[2] = U2_PKW(P0, 12), pw1[3] = U2_PKW(P0, 14), pw1); \
    bf16x8 kr_[4]; { const lds_cptr kq_ = kp0 + sl_cur * KSLOT; kr_[0] = *(const LAS bf16x8*)(kq_ + 4 * 2048); kr_[1] = *(const LAS bf16x8*)(kq_ + 4 * 2048 + 512); kr_[2] = *(const LAS bf16x8*)(kq_ + 5 * 2048); kr_[3] = *(const LAS bf16x8*)(kq_ + 5 * 2048 + 512); } ATT_SBAR();     \
    U2_GAPA(C0 = MF32(kf[4], qr[2], C0),      P1[2], P1[3], P1[4], P1[5],     pw2[0] = U2_PKW(P1, 0),  pw2[1] = U2_PKW(P1, 2),  pw2); \
    U2_GAPA(C1 = MF32(kf[5], qr[2], C1),      P1[6], P1[7], P1[8], P1[9],     pw2[2] = U2_PKW(P1, 4),  pw2[3] = U2_PKW(P1, 6),  pw2); \
    U2_GAPA(C0 = MF32(kf[6], qr[3], C0),      P1[10], P1[11], P1[12], P1[13], pw3[0] = U2_PKW(P1, 8),  pw3[1] = U2_PKW(P1, 10), pw3); \
    U2_GAPA(C1 = MF32(kf[7], qr[3], C1),      P1[14], P1[15], 0.f, 0.f,       pw3[2] = U2_PKW(P1, 12), pw3[3] = U2_PKW(P1, 14), pw3); \
    C0 = MF32(kr_[0], qr[4], C0); C1 = MF32(kr_[1], qr[4], C1); C0 = MF32(kr_[2], qr[5], C0); C1 = MF32(kr_[3], qr[5], C1); \
    U2_VRD(0); U2_VRD(4); U2_VRD(1); U2_VRD(5); U2_VRD(2); U2_VRD(6); U2_VRD(3); U2_VRD(7); ATT_SBAR();     \
    st.l += sacc; \
    if (MASK) cmask(C0, C1, (t) - (NT - 4), qrel, hi); \
    { const float rm = rowmax64(C0, C1); resc = false; \
      if (__builtin_expect(__any(rm > (float)THRL), 0)) { const float dl = fmaxf(rm, 0.f); st.mhat += dl; \
          _Pragma("unroll") for (int r = 0; r < 16; ++r) { C0[r] -= dl; C1[r] -= dl; st.negm[r] = -st.mhat; } \
          const float f = __builtin_amdgcn_exp2f(-dl); st.l *= f; if (hi == 0) wsf[r32] = f; resc = true; } } \
    ATT_SBAR(); \
    U2_GAPB(st.o[0] = MF32(U2_PAF(0), U2_VFR(0), st.o[0]), C0, 0); \
    U2_GAPB(st.o[1] = MF32(U2_PAF(0), U2_VFR(4), st.o[1]), C0, 4);  U2_KRD(GL, 0); \
    U2_GAPB(st.o[0] = MF32(U2_PAF(1), U2_VFR(1), st.o[0]), C0, 8); \
    U2_GAPB(st.o[1] = MF32(U2_PAF(1), U2_VFR(5), st.o[1]), C0, 12); U2_KRD(GL, 1); \
    U2_GAPB(st.o[0] = MF32(U2_PAF(2), U2_VFR(2), st.o[0]), C1, 0);  U2_KRD(GL, 2); \
    U2_GAPB(st.o[1] = MF32(U2_PAF(2), U2_VFR(6), st.o[1]), C1, 4);  U2_KRD(GL, 3); \
    U2_GAPB(st.o[0] = MF32(U2_PAF(3), U2_VFR(3), st.o[0]), C1, 8); \
    U2_GAPB(st.o[1] = MF32(U2_PAF(3), U2_VFR(7), st.o[1]), C1, 12); \
    } while (0)
    ATT_WAIT_BAR(0);
    int t = 1;
    for (; t + 1 < NT - 4; t += 2) {
        U2_STEP(pB0, pB1, pA0, pA1, t, false, true, true, true);     ATT_WAIT_BAR(0); U2_RESC(); U2_ROT();
        U2_STEP(pA0, pA1, pB0, pB1, t + 1, false, true, true, true); ATT_WAIT_BAR(0); U2_RESC(); U2_ROT();
    }
    for (; t + 1 < NT; t += 2) {
        U2_STEP(pB0, pB1, pA0, pA1, t, true, (t + 2 < NT), (t + 1 < NT), (t + 1 < NT));         ATT_WAIT_BAR(0); U2_RESC(); U2_ROT();
        U2_STEP(pA0, pA1, pB0, pB1, t + 1, true, (t + 3 < NT), (t + 2 < NT), (t + 2 < NT));     ATT_WAIT_BAR(0); U2_RESC(); U2_ROT();
    }
    U2_STEP(pB0, pB1, pA0, pA1, NT - 1, true, false, false, false); U2_RESC();
    { float sacc = pB0[0] + pB0[1];
#pragma unroll
      for (int r = 2; r < 16; ++r) sacc += pB0[r];
#pragma unroll
      for (int r = 0; r < 16; ++r) sacc += pB1[r];
      st.l += sacc;
      pw0 = (u32x4){U2_PKW(pB0, 0), U2_PKW(pB0, 2), U2_PKW(pB0, 4), U2_PKW(pB0, 6)}; pw1 = (u32x4){U2_PKW(pB0, 8), U2_PKW(pB0, 10), U2_PKW(pB0, 12), U2_PKW(pB0, 14)};
      pw2 = (u32x4){U2_PKW(pB1, 0), U2_PKW(pB1, 2), U2_PKW(pB1, 4), U2_PKW(pB1, 6)}; pw3 = (u32x4){U2_PKW(pB1, 8), U2_PKW(pB1, 10), U2_PKW(pB1, 12), U2_PKW(pB1, 14)};
      const lds_cptr vp_ = vp0 + sl_cur * VSLOT;
#pragma unroll
      for (int i = 0; i < 8; ++i) U2_VRD(i);
      st.o[0] = MF32(U2_PAF(0), U2_VFR(0), st.o[0]); st.o[1] = MF32(U2_PAF(0), U2_VFR(4), st.o[1]); st.o[0] = MF32(U2_PAF(1), U2_VFR(1), st.o[0]); st.o[1] = MF32(U2_PAF(1), U2_VFR(5), st.o[1]);
      st.o[0] = MF32(U2_PAF(2), U2_VFR(2), st.o[0]); st.o[1] = MF32(U2_PAF(2), U2_VFR(6), st.o[1]); st.o[0] = MF32(U2_PAF(3), U2_VFR(3), st.o[0]); st.o[1] = MF32(U2_PAF(3), U2_VFR(7), st.o[1]); }
    ATT_WAIT_BAR(0);
#undef U2_K
#undef U2_V
#undef U2_ROT
#undef U2_KLOAD2
#undef U2_RESC
#undef U2_PKW
#undef U2_PAF
#undef U2_VFR
#undef U2_VRD
#undef U2_KRD
#undef U2_GAPA
#undef U2_GAPB
#undef U2_STEP
    (void)sm_finish(st, wsf, (LAS bf16*)(shm + L_OST) + wid * 2048, OB + (rowbase + q0 + wid * 32) * DM + O_B + h * 64, DM, lane, r32, hi, ssq_mix + (size_t)h * M + (rowbase + q0 + wid * 32));
}

__device__ __forceinline__ void moba_unit(int b, int h, int j, const bf16* PROJ, const float* kmean, const float* tmoba, bf16* OB, float* ssq_mix, LAS unsigned char* shm, const int wid) {
    const int lane = lane_id(), tid = wid * 64 + lane, r32 = lane & 31, hi = lane >> 5;
    const long rowbase = (long)b * SEQ; const int q0 = j * 256;
    const unsigned lds0 = (unsigned)(uintptr_t)shm;
    LAS float* wsf = (LAS float*)(shm + L_WS) + wid * 64;
    LAS float* tb = (LAS float*)(shm + L_TB);
    { float tv[9];
#pragma unroll
      for (int k = 0; k < 9; ++k) { const int i = tid + k * (NWAVES * 64); tv[k] = (i >= 256 && i < 256 + 4096) ? tmoba[h * 4096 + i - 256] : 0.f; }
#pragma unroll
      for (int k = 0; k < 9; ++k) { const int i = tid + k * (NWAVES * 64); if (i < 256 + 4096) tb[i] = tv[k]; } }
    LAS float* kml = (LAS float*)(shm + L_KM);
    for (int i = tid; i < j * 64; i += NWAVES * 64) kml[i] = kmean[((size_t)(b * 16 + (i >> 6)) * 4 + h) * 64 + (i & 63)];
    asm volatile("s_nop 15\n\ts_waitcnt vmcnt(0) lgkmcnt(0)\n\ts_barrier" ::: "memory");
    const float c31 = tb[256 + 4095];
    const bf16* Qw = PROJ + (rowbase + q0 + wid * 32 + r32) * PP + C_QC + h * 64;
    bf16x8 qr[4];
#pragma unroll
    for (int d0 = 0; d0 < 4; ++d0) qr[d0] = *(const bf16x8*)(Qw + d0 * 16 + hi * 8);
    float g1 = -INFINITY, g2 = -INFINITY, g3 = -INFINITY; float gate[16];
#pragma unroll
    for (int blk = 0; blk < 16; ++blk) { float s = -INFINITY;
        if (blk < j) { const LAS float* km = kml + blk * 64 + hi * 8; float a = 0.f;
#pragma unroll
            for (int d0 = 0; d0 < 4; ++d0) { const f32x4 k0 = *(const LAS f32x4*)(km + d0 * 16), k1 = *(const LAS f32x4*)(km + d0 * 16 + 4); const u32x4 q = __builtin_bit_cast(u32x4, qr[d0]);
                a = fmaf(bf_lo(q.x), k0[0], a); a = fmaf(bf_hi(q.x), k0[1], a); a = fmaf(bf_lo(q.y), k0[2], a); a = fmaf(bf_hi(q.y), k0[3], a);
                a = fmaf(bf_lo(q.z), k1[0], a); a = fmaf(bf_hi(q.z), k1[1], a); a = fmaf(bf_lo(q.w), k1[2], a); a = fmaf(bf_hi(q.w), k1[3], a); }
            s = swap_add(a); }
        gate[blk] = s;
        if (s > g1) { g3 = g2; g2 = g1; g1 = s; } else if (s > g2) { g3 = g2; g2 = s; } else if (s > g3) { g3 = s; } }
    unsigned sel = 0u;
#pragma unroll
    for (int blk = 0; blk < 16; ++blk) if (blk < j && gate[blk] >= g3) sel |= 1u << blk;
    const bf16* ksrc = PROJ + (rowbase + lane) * PP + C_KC + h * 64 + wid * 8;
    const bf16* vsrc = PROJ + (rowbase + 16 * (wid & 3) + (lane >> 2)) * PP + C_VC + h * 64 + (wid >> 2) * 32 + (lane & 3) * 8;
    const unsigned kdst = lds0 + L_K + wid * 1024, vdst = lds0 + L_V + wid * 1024;
    const int vb0 = (int)(lds0 + L_V) + ((lane >> 4) & 1) * 32 + (lane & 3) * 8 + (4 * hi + ((lane & 15) >> 2)) * 64;
    const lds_cptr kbase = (lds_cptr)(shm + L_K);
    const int NT = 4 * j + 4, qrel = wid * 32 + r32;
    SmState st; sm_init(st);
    const bool halfB = wid >= 4;
#define MOBA_K(t, s) glds16(ksrc + (long)(t) * 64 * PP, (unsigned)__builtin_amdgcn_readfirstlane(kdst + (s) * KSLOT))
#define MOBA_V(t, s) glds16(vsrc + (long)(t) * 64 * PP, (unsigned)__builtin_amdgcn_readfirstlane(vdst + (s) * VSLOT))
#define MOBA_W(t) ATT_WAIT_BAR(0)
    f32x16 p0, p1; bool resc = false; u32x4 pw0, pw1, pw2, pw3;
#define MOBA_PART1(t, sl) do { if (ATT_SKIP(t)) resc = false; else { const int blk_ = (t) >> 2; const bool on_ = (blk_ == j) || ((sel >> blk_) & 1u); f32x16 c0_; \
        const bool far_ = (q0 - 64 * (t) - 63) >= 1536;     \
        const float cv_ = on_ ? st.negm[0] + (far_ ? c31 : 0.f) : -INFINITY;     \
        _Pragma("unroll") for (int r = 0; r < 16; ++r) c0_[r] = cv_; \
        if (far_) qkt_lds<4>(p0, p1, kbase + (sl) * KSLOT, qr, c0_, r32, hi); \
        else { float tbv_[32];     \
          const LAS float* lb_ = tb + (256 + q0 + qrel - 64 * (t) - 4 * hi - 27 - 32); \
          _Pragma("unroll") for (int r = 0; r < 16; ++r) { const int c_ = (r & 3) + 8 * (r >> 2); tbv_[r] = lb_[32 + 27 - c_]; tbv_[16 + r] = lb_[27 - c_]; } \
          qkt_lds<4>(p0, p1, kbase + (sl) * KSLOT, qr, c0_, r32, hi); \
          if (blk_ == j) cmask(p0, p1, (t) & 3, qrel, hi); \
          _Pragma("unroll") for (int r = 0; r < 16; ++r) { p0[r] += tbv_[r]; p1[r] += tbv_[16 + r]; } } \
        resc = sm_decide64(st, p0, p1, wsf, r32, hi); } } while (0)
#define MOBA_PART2(t, sl) do { if (!ATT_SKIP(t)) { VFrag vf_; pv64_read(vf_, vb0 + (sl) * VSLOT); sm_exp64(st, resc, p0, p1, wsf, hi, pw0, pw1, pw2, pw3); \
        pv64_mma(st.o, vf_, __builtin_bit_cast(bf16x8, pw0), __builtin_bit_cast(bf16x8, pw1), __builtin_bit_cast(bf16x8, pw2), __builtin_bit_cast(bf16x8, pw3)); } } while (0)
    MOBA_K(0, 0); MOBA_V(0, 0);
    ATT_WAIT_BAR(0);
    if (!halfB) { int sc = 0;
        for (int t = 0; t < NT; ++t) { const int sn = sc == 2 ? 0 : sc + 1;
            if (t + 1 < NT) { MOBA_K(t + 1, sn); MOBA_V(t + 1, sn); }
            MOBA_PART1(t, sc); MOBA_PART2(t, sc); ATT_WAIT_BAR(0);
            sc = sn; }
        ATT_WAIT_BAR(0);
    } else { int sp = 0, sc = 1;
        if (1 < NT) { MOBA_K(1, 1); MOBA_V(1, 1); }
        MOBA_PART1(0, 0); ATT_WAIT_BAR(0);
        for (int t = 1; t < NT; ++t) { const int sn = sc == 2 ? 0 : sc + 1;
            if (t + 1 < NT) { MOBA_K(t + 1, sn); MOBA_V(t + 1, sn); }
            MOBA_PART2(t - 1, sp); MOBA_PART1(t, sc); ATT_WAIT_BAR(0);
            sp = sc; sc = sn; }
        MOBA_PART2(NT - 1, sp); ATT_WAIT_BAR(0);
    }
#undef MOBA_K
#undef MOBA_V
#undef MOBA_W
#undef MOBA_PART1
#undef MOBA_PART2
    (void)sm_finish(st, wsf, (LAS bf16*)(shm + L_OST) + wid * 2048, OB + (rowbase + q0 + wid * 32) * DM + O_C + h * 64, DM, lane, r32, hi, ssq_mix + (size_t)(6 + h) * M + (rowbase + q0 + wid * 32));
}

constexpr int D_V = 0, D_WS = 65536, D_OST = D_WS + 8 * 256, D_TB = D_OST + 8 * 4096, D_Q = D_TB + 3 * 6 * 192 * 4, D_END = D_Q + 16;
static_assert(D_END <= RING_BYTES, "dilated LDS map");
__device__ __forceinline__ void dil_task(int p, int b, int h, int r, int m0, const bf16* PROJ, bf16* OPART, float* LSE, LAS unsigned char* shm, int wid, int lane) {
    const int r32 = lane & 31, hi = lane >> 5, sh = 2 * p;
    const long rowbase = (long)b * SEQ;
    const unsigned lds0 = (unsigned)(uintptr_t)shm;
    LAS float* wsf = (LAS float*)(shm + D_WS) + wid * 64;
    const LAS float* tbl = (const LAS float*)(shm + D_TB) + (p * 6 + h) * 192 + 32;
    const unsigned vslot0 = lds0 + D_V + wid * 8192;
    const int tq = r + ((m0 + r32) << sh);
    const bf16* Qw = PROJ + (rowbase + tq) * PP + C_QA + h * 64;
    bf16x8 qr[4];
#pragma unroll
    for (int d0 = 0; d0 < 4; ++d0) qr[d0] = *(const bf16x8*)(Qw + d0 * 16 + hi * 8);
    const int g0 = (4 - (m0 >> 5)) > 0 ? (4 - (m0 >> 5)) : 0;
    bf16x8 kc[4], kn[4];
#define DIL_LOADK(dst, g) do { const int ks_ = m0 - 128 + 32 * (g) + r32; const bf16* kp_ = PROJ + (rowbase + r + ((long)ks_ << sh)) * PP + C_KA + h * 64 + hi * 8; \
        _Pragma("unroll") for (int d0 = 0; d0 < 4; ++d0) dst[d0] = *(const bf16x8*)(kp_ + d0 * 16); } while (0)
#define DIL_LOADV(VD, g) do { _Pragma("unroll") for (int pc = 0; pc < 4; ++pc) { const int dh_ = pc >> 1, rg_ = pc & 1; const int ks_ = m0 - 128 + 32 * (g) + 16 * rg_ + (lane >> 2); \
            VD[pc] = *(const u32x4*)(PROJ + (rowbase + r + ((long)ks_ << sh)) * PP + C_VA + h * 64 + dh_ * 32 + (lane & 3) * 8); } } while (0)
#define DIL_STV(VS, g) do { _Pragma("unroll") for (int pc = 0; pc < 4; ++pc) *(LAS u32x4*)(shm + D_V + wid * 8192 + ((g) & 1) * 2048 + (pc >> 1) * 4096 + (pc & 1) * 1024 + lane * 16) = VS[pc]; } while (0)
    u32x4 vc[4], vn[4], vf[4]; bf16x8 kf[4];
    const int vb0 = (int)vslot0 + ((lane >> 4) & 1) * 32 + (lane & 3) * 8 + (4 * hi + ((lane & 15) >> 2)) * 64;
    SmState st; sm_init(st);
    DIL_LOADV(vc, g0); DIL_LOADK(kc, g0);
    if (g0 + 1 < 5) { DIL_LOADV(vn, g0 + 1); DIL_LOADK(kn, g0 + 1); } else { _Pragma("unroll") for (int d0 = 0; d0 < 4; ++d0) { kn[d0] = kc[d0]; vn[d0] = vc[d0]; } }
    for (int g = g0; g < 5; ++g) {
        if (g + 2 < 5) { DIL_LOADV(vf, g + 2); DIL_LOADK(kf, g + 2); } else { _Pragma("unroll") for (int d0 = 0; d0 < 4; ++d0) { kf[d0] = kn[d0]; vf[d0] = vn[d0]; } }
        DIL_STV(vc, g);
        float tb_[16];
        { const LAS float* lb = tbl + (128 - 32 * g) + r32 - 4 * hi - 27;
#pragma unroll
          for (int rr = 0; rr < 16; ++rr) tb_[rr] = lb[27 - ((rr & 3) + 8 * (rr >> 2))]; }
        ATT_SBAR();
        f32x16 p0;
#pragma unroll
        for (int d0 = 0; d0 < 4; ++d0) p0 = __builtin_amdgcn_mfma_f32_32x32x16_bf16(kc[d0], qr[d0], d0 == 0 ? st.negm : p0, 0, 0, 0);
        MFMA_FENCE1(p0);
        if (g == 0) {
#pragma unroll
            for (int rr = 0; rr < 16; ++rr) if (crow(rr, hi) < r32) p0[rr] = -INFINITY; }
        if (g == 4) {
#pragma unroll
            for (int rr = 0; rr < 16; ++rr) if (crow(rr, hi) > r32) p0[rr] = -INFINITY; }
#pragma unroll
        for (int rr = 0; rr < 16; ++rr) p0[rr] += tb_[rr];
        u32x4 pw0, pw1; sm_step32(st, p0, wsf, r32, hi, pw0, pw1);
        pv32(st.o, vb0 + (g & 1) * 2048, __builtin_bit_cast(bf16x8, pw0), __builtin_bit_cast(bf16x8, pw1));
#pragma unroll
        for (int d0 = 0; d0 < 4; ++d0) { kc[d0] = kn[d0]; kn[d0] = kf[d0]; vc[d0] = vn[d0]; vn[d0] = vf[d0]; }
    }
#undef DIL_LOADV
#undef DIL_LOADK
#undef DIL_STV
    bf16* orow0 = OPART + ((size_t)p * M + rowbase + r + ((long)m0 << sh)) * 384 + h * 64;
    const float lse = sm_finish(st, wsf, (LAS bf16*)(shm + D_OST) + wid * 2048, orow0, (long)384 << sh, lane, r32, hi);
    if (hi == 0) LSE[((size_t)(p * NB + b) * 6 + h) * SEQ + (size_t)r * (SEQ >> sh) + m0 + r32] = lse;
}

constexpr int DU_K = 0, DU_V = 49152, DU_WS = 98304, DU_OST = 0;
static_assert(DU_WS + 8 * 256 == D_TB && DU_V + 6 * 8192 == DU_WS, "dilated unit LDS map");
__device__ __forceinline__ int du_swz(int c) { return (c & 7) ^ ((c & 1) << 3); }
struct DuId { int p, b, h, r, m0u; };
__device__ __forceinline__ DuId du_decode(int id) { DuId d; d.h = id % H_DIL; const int rest = id / H_DIL; d.p = rest >> 7; d.b = (rest >> 4) & 7; const int uu = rest & 15, per = 16 >> (2 * d.p); d.r = uu / per; d.m0u = 256 * (uu % per); return d; }
constexpr int DU_N = 3 * NB * 16 * H_DIL;
struct DuRegs { u32x4 kv[6], vv[6]; bf16x8 qr[4]; };
__device__ __forceinline__ void du_load(DuRegs& R, const DuId& u, const bf16* PROJ, int wid, int lane) {
    const int r32 = lane & 31, hi = lane >> 5, sh = 2 * u.p; const long rowbase = (long)u.b * SEQ;
    const bf16* Qw = PROJ + (rowbase + u.r + ((long)(u.m0u + 32 * wid + r32) << sh)) * PP + C_QA + u.h * 64;
#pragma unroll
    for (int d0 = 0; d0 < 4; ++d0) R.qr[d0] = *(const bf16x8*)(Qw + d0 * 16 + hi * 8);
    const int t = wid * 64 + lane, row8 = t >> 3, c8 = t & 7;
#pragma unroll
    for (int n = 0; n < 6; ++n) { const int ks = u.m0u - 128 + n * 64 + row8;
        const bf16* src = PROJ + (rowbase + u.r + ((long)(ks < 0 ? 0 : ks) << sh)) * PP + u.h * 64 + c8 * 8;
        R.kv[n] = *(const u32x4*)(src + C_KA); R.vv[n] = *(const u32x4*)(src + C_VA); }
}
__device__ __forceinline__ void dil_units(unsigned* qctr, const bf16* PROJ, bf16* OPART, float* LSE, LAS unsigned char* shm, const int wid) {
    const int lane = lane_id(), r32 = lane & 31, hi = lane >> 5;
    const unsigned lds0 = (unsigned)(uintptr_t)shm;
    LAS float* wsf = (LAS float*)(shm + DU_WS) + wid * 64;
    volatile LAS unsigned* slot = (volatile LAS unsigned*)(shm + D_Q);
    int cur = wg_next(qctr, shm, D_Q, wid); if (cur >= DU_N) return;
    int nxt = wg_next(qctr, shm, D_Q, wid);
    DuRegs R; du_load(R, du_decode(cur), PROJ, wid, lane);
    const bool t0 = wid == 0 && lane == 0;
    for (;;) {
        const DuId u = du_decode(cur); const int sh = 2 * u.p; const long rowbase = (long)u.b * SEQ;
        unsigned ahead = 0u; if (t0) ahead = __hip_atomic_fetch_add(qctr, 1u, __ATOMIC_RELAXED, __HIP_MEMORY_SCOPE_AGENT);
        { const int t = wid * 64 + lane, row8 = t >> 3, c8 = t & 7;
#pragma unroll
          for (int n = 0; n < 6; ++n) { const int i = n * 64 + row8, G = i >> 5, kk = i & 31;
              *(LAS u32x4*)(shm + DU_K + G * 4096 + c8 * 512 + ((kk ^ du_swz(c8)) * 16)) = R.kv[n];
              *(LAS u32x4*)(shm + DU_V + (G >> 1) * 8192 + (G & 1) * 2048 + (c8 >> 2) * 4096 + (kk >> 4) * 1024 + (kk & 15) * 64 + (c8 & 3) * 16) = R.vv[n]; } }
        bf16x8 qr[4];
#pragma unroll
        for (int d0 = 0; d0 < 4; ++d0) qr[d0] = R.qr[d0];
        asm volatile("s_nop 15\n\ts_waitcnt lgkmcnt(0)\n\ts_barrier" ::: "memory");
        if (nxt < DU_N) du_load(R, du_decode(nxt), PROJ, wid, lane);
        const LAS float* tbl = (const LAS float*)(shm + D_TB) + (u.p * 6 + u.h) * 192 + 32;
        const int m0 = u.m0u + 32 * wid;
        const int g0 = (4 - (m0 >> 5)) > 0 ? (4 - (m0 >> 5)) : 0;
        const int vbl = (int)(lds0 + DU_V) + ((lane >> 4) & 1) * 32 + (lane & 3) * 8 + (4 * hi + ((lane & 15) >> 2)) * 64;
        SmState st; sm_init(st);
        for (int g = g0; g < 5; ++g) { const int G = wid + g;
            float tb_[16]; bf16x8 kf[4];
            { const LAS float* lb = tbl + (128 - 32 * g) + r32 - 4 * hi - 27;
#pragma unroll
              for (int rr = 0; rr < 16; ++rr) tb_[rr] = lb[27 - ((rr & 3) + 8 * (rr >> 2))]; }
#pragma unroll
            for (int d0 = 0; d0 < 4; ++d0) kf[d0] = *(const LAS bf16x8*)(shm + DU_K + G * 4096 + (2 * d0 + hi) * 512 + ((r32 ^ du_swz(2 * d0 + hi)) * 16));
            ATT_SBAR();
            f32x16 p0;
#pragma unroll
            for (int d0 = 0; d0 < 4; ++d0) p0 = __builtin_amdgcn_mfma_f32_32x32x16_bf16(kf[d0], qr[d0], d0 == 0 ? st.negm : p0, 0, 0, 0);
            V32 vf_; pv32_read(vf_, vbl + (G >> 1) * 8192 + (G & 1) * 2048);
            MFMA_FENCE1(p0);
            if (g == 0) {
#pragma unroll
                for (int rr = 0; rr < 16; ++rr) if (crow(rr, hi) < r32) p0[rr] = -INFINITY; }
            if (g == 4) {
#pragma unroll
                for (int rr = 0; rr < 16; ++rr) if (crow(rr, hi) > r32) p0[rr] = -INFINITY; }
#pragma unroll
            for (int rr = 0; rr < 16; ++rr) p0[rr] += tb_[rr];
            u32x4 pw0, pw1; sm_step32(st, p0, wsf, r32, hi, pw0, pw1);
            pv32_mma(st.o, vf_, __builtin_bit_cast(bf16x8, pw0), __builtin_bit_cast(bf16x8, pw1));
        }
        if (t0) slot[0] = ahead;
        asm volatile("s_nop 15\n\ts_waitcnt lgkmcnt(0)\n\ts_barrier" ::: "memory");
        const int nn = (int)__builtin_amdgcn_readfirstlane(slot[0]);
        bf16* orow0 = OPART + ((size_t)u.p * M + rowbase + u.r + ((long)m0 << sh)) * 384 + u.h * 64;
        const float lse = sm_finish(st, wsf, (LAS bf16*)(shm + DU_OST) + wid * 2048, orow0, (long)384 << sh, lane, r32, hi);
        if (hi == 0) LSE[((size_t)(u.p * NB + u.b) * 6 + u.h) * SEQ + (size_t)u.r * (SEQ >> sh) + m0 + r32] = lse;
        asm volatile("s_nop 15\n\ts_waitcnt lgkmcnt(0)\n\ts_barrier" ::: "memory");
        if (nxt >= DU_N) break;
        cur = nxt; nxt = nn;
    }
}
}

__device__ __forceinline__ int ilv32(int n) { return n < 16 ? 2 * n : 2 * (n - 16) + 1; }
__device__ __forceinline__ void tr_item(const float* W, int N, const float* gain, float cscale, bf16* WT, int ldt, int dcol, int drow, bool il, LAS float* scr, int k0, int n0, int lane) {
    { f32x4 v[8]; float gsc[8];
#pragma unroll
      for (int i = 0; i < 8; ++i) { const int kk = 8 * i + (lane >> 3); v[i] = *(const f32x4*)(W + (size_t)(k0 + kk) * N + n0 + 4 * (lane & 7)); gsc[i] = (gain ? gain[k0 + kk] : 1.0f) * cscale; }
#pragma unroll
      for (int i = 0; i < 8; ++i) { const int kk = 8 * i + (lane >> 3); LAS float* d = scr + kk * 33 + 4 * (lane & 7); d[0] = v[i][0] * gsc[i]; d[1] = v[i][1] * gsc[i]; d[2] = v[i][2] * gsc[i]; d[3] = v[i][3] * gsc[i]; } }
    LDS_WAIT(); asm volatile("" ::: "memory");
    const int c = lane & 7;
#pragma unroll
    for (int j = 0; j < 4; ++j) { const int n = (lane >> 3) + 8 * j; const LAS float* s = scr + (8 * c) * 33 + n;
        u32x4 o; o.x = cvt_pk_bf16(s[0 * 33], s[1 * 33]); o.y = cvt_pk_bf16(s[2 * 33], s[3 * 33]); o.z = cvt_pk_bf16(s[4 * 33], s[5 * 33]); o.w = cvt_pk_bf16(s[6 * 33], s[7 * 33]);
        const int dr = drow + (il ? ilv32(n) : n);
        *(u32x4*)(WT + (size_t)dr * ldt + dcol + k0 + 8 * c) = o; }
    LDS_WAIT(); asm volatile("" ::: "memory");
}
__device__ __forceinline__ void tr_item8(const float* W, int N, float cscale, unsigned char* WT, int ldt, int drow, LAS float* scr, int k0, int n0, int lane) {
    { f32x4 v[8];
#pragma unroll
      for (int i = 0; i < 8; ++i) { const int kk = 8 * i + (lane >> 3); v[i] = *(const f32x4*)(W + (size_t)(k0 + kk) * N + n0 + 4 * (lane & 7)); }
#pragma unroll
      for (int i = 0; i < 8; ++i) { const int kk = 8 * i + (lane >> 3); LAS float* d = scr + kk * 33 + 4 * (lane & 7); d[0] = v[i][0] * cscale; d[1] = v[i][1] * cscale; d[2] = v[i][2] * cscale; d[3] = v[i][3] * cscale; } }
    LDS_WAIT(); asm volatile("" ::: "memory");
    const int c = lane & 7;
#pragma unroll
    for (int j = 0; j < 4; ++j) { const int n = (lane >> 3) + 8 * j; const LAS float* sp = scr + (8 * c) * 33 + n;
        u32x2 o; o.x = pg8::pk4_fp8((f32x4){sp[0 * 33], sp[1 * 33], sp[2 * 33], sp[3 * 33]}); o.y = pg8::pk4_fp8((f32x4){sp[4 * 33], sp[5 * 33], sp[6 * 33], sp[7 * 33]});
        *(u32x2*)(WT + (size_t)(drow + n) * ldt + k0 + 8 * c) = o; }
    LDS_WAIT(); asm volatile("" ::: "memory");
}
__device__ __forceinline__ int t5_bucket(int n) {
    if (n < 16) return n;
    int large = 16 + (int)(log2f((float)n * (1.0f / 16.0f)) * (16.0f / 7.0f));
    return large < 31 ? large : 31;
}

struct Args { const float* in[14]; float* out; unsigned char* ws; int ph_lo, ph_hi, li, pad; };

__global__ void __launch_bounds__(NWAVES * 64, 2) mk_fwd(Args args) {
    extern __shared__ __attribute__((aligned(16))) unsigned char lds_raw[];
    LAS unsigned char* lds0 = (LAS unsigned char*)lds_raw;
    volatile LAS unsigned* MISC = (volatile LAS unsigned*)(lds0 + MISC_OFF);
    const int wave0 = __builtin_amdgcn_readfirstlane((int)threadIdx.x >> 6);
#define PHASE_LOCALS \
    int z_; asm volatile("s_mov_b32 %0, 0" : "=s"(z_)); const int wave = wave0 + z_; \
    GAS unsigned char* wsg_ = (GAS unsigned char*)args.ws; GAS float* outg_ = (GAS float*)args.out; asm volatile("" : "+s"(wsg_), "+s"(outg_));     \
    unsigned char* ws = (unsigned char*)wsg_; const int G = (int)gridDim.x + z_; float* out = (float*)outg_; LAS unsigned char* lds = lds0 + z_; (void)lds; \
    const int bid = (int)blockIdx.x + z_; const int gw = bid * NWAVES + wave, NGW = G * NWAVES, NGT = NGW * 64; (void)bid; \
    unsigned* ctl = (unsigned*)(ws + WS_CTL); float* ssq_all = (float*)(ws + WS_SSQ); const f32x2* rope_cs = (const f32x2*)(ws + WS_ROPE); \
    float* tmoba = (float*)(ws + WS_TMOBA); float* tdil = (float*)(ws + WS_TDIL); float* kmean = (float*)(ws + WS_KMEAN); \
    bf16* XB = (bf16*)(ws + WS_XB); bf16* PROJ = (bf16*)(ws + WS_PROJ); bf16* QM = (bf16*)(ws + WS_QM); bf16* OB = (bf16*)(ws + WS_O); bf16* UB = (bf16*)(ws + WS_U); \
    (void)out; (void)gw; (void)NGW; (void)NGT; (void)ctl; (void)ssq_all; (void)rope_cs; (void)tmoba; (void)tdil; (void)kmean; (void)XB; (void)PROJ; (void)QM; (void)OB; (void)UB
#define LAYER_LOCALS PHASE_LOCALS; const int lz_ = l + z_; unsigned char* wl = ws + WS_W + (size_t)lz_ * W_STRIDE; float* ssq_x = ssq_all; float* ssq_c = ssq_all + (size_t)M * 16; float* ssq_mlp = ssq_all + (size_t)M * 32; \
    (void)wl; (void)ssq_x; (void)ssq_c; (void)ssq_mlp
    unsigned* ctl0 = (unsigned*)(args.ws + WS_CTL);
    for (int u = wave0 * 64 + lane_id(); u < (LDS_BYTES - LDSCTL_OFF) / 4; u += NWAVES * 64) ((LAS unsigned*)(lds0 + LDSCTL_OFF))[u] = 0u;
    __syncthreads();
    XcdBarrier bar; bar.bar = ctl0 + CW_BAR + args.li * XCD_BAR_WORDS; bar.x = 0; bar.st = nullptr;
    if (!MK_PER_PHASE) bar = xcd_barrier_post(ctl0 + CW_BAR + args.li * XCD_BAR_WORDS, MISC + 8, wave0 == 0 && lane_id() == 0);
    const int lo = MK_PER_PHASE ? args.ph_lo : 0, hi = MK_PER_PHASE ? args.ph_hi : N_PHASES;
#define IN(k) (lo <= (k) && (k) < hi)
#define SEAM(k) do { if (IN(k) && IN((k) + 1)) xcd_barrier(bar, wave0 == 0 && lane_id() == 0); } while (0)

    if (IN(0)) {
        PHASE_LOCALS; const float* x_in = args.in[0];
        const int lane = lane_id(), gt = bid * (NWAVES * 64) + wave * 64 + lane;
        LAS float* scr = (LAS float*)(lds + wave * 16384);
        constexpr int I_IN = 16 * 77, I_UQ = 6 * 18, I_UKV = 2 * 24, I_O = 16 * 32, I_UP = 16 * 128, I_DN = 64 * 32, I_L = I_IN + I_UQ + I_UKV + I_O + I_UP + I_DN;
        for (int it = gw; it < DEPTH * I_L; it += NGW) {
            const int l = it / I_L; int r = it % I_L;
            unsigned char* wl = ws + WS_W + (size_t)l * W_STRIDE;
            if (r < I_IN) { const int kb = r / 77, nb = r % 77, n0 = 32 * nb;
                int drow = n0; bool il = false; float sc = 1.0f;
                if (n0 < 384) sc = QS_64;
                else if (n0 == 1664) il = true;
                else if (n0 >= 1696) { drow = n0 + 32; if (n0 < 1952) sc = QS_64; }
                tr_item(args.in[2] + (size_t)l * DM * DIN, DIN, args.in[1] + l * DM, sc, (bf16*)(wl + W_IN), DM, 0, drow, il, scr, 64 * kb, n0, lane); continue; }
            r -= I_IN;
            if (r < I_UQ) { const int kb = r / 18, nb = r % 18, n0 = 32 * nb, h = n0 / 96, rr = n0 % 96;
                const int drow = (rr < 64) ? (Q_NOPE + 64 * h + rr) : (Q_ROPE + 32 * h);
                tr_item(args.in[5] + (size_t)l * 384 * 576, 576, args.in[3] + l * 384, QS_96, (bf16*)(wl + W_MLA), 512, 0, drow, rr == 64, scr, 64 * kb, n0, lane); continue; }
            r -= I_UQ;
            if (r < I_UKV) { const int kb = r / 24, nb = r % 24, n0 = 32 * nb;
                tr_item(args.in[6] + (size_t)l * 128 * 768, 768, args.in[4] + l * 128, 1.0f, (bf16*)(wl + W_MLA), 512, 384, Q_KV + n0, false, scr, 64 * kb, n0, lane); continue; }
            r -= I_UKV;
            if (r < I_O) { const int kb = r / 32, nb = r % 32;
                tr_item(args.in[9] + (size_t)l * DM * DM, DM, args.in[8] + l * DM, 1.0f, (bf16*)(wl + W_O), DM, 0, 32 * nb, false, scr, 64 * kb, 32 * nb, lane); continue; }
            r -= I_O;
            if (r < I_UP) { const int kb = r / 128, nb = r % 128;
                tr_item(args.in[11] + (size_t)l * DM * DFF, DFF, args.in[10] + l * DM, 1.0f, (bf16*)(wl + W_UP), DM, 0, 32 * nb, false, scr, 64 * kb, 32 * nb, lane); continue; }
            r -= I_UP;
            { const int kb = r % 64, nb = r / 64;
#if FP8_DOWN
                tr_item8(args.in[12] + (size_t)l * DFF * DM, DM, 64.0f, (unsigned char*)(wl + W_DOWN), DFF, 32 * nb, scr, 64 * kb, 32 * nb, lane); }
#else
                tr_item(args.in[12] + (size_t)l * DFF * DM, DM, nullptr, 1.0f, (bf16*)(wl + W_DOWN), DFF, 0, 32 * nb, false, scr, 64 * kb, 32 * nb, lane); }
#endif
        }
        for (int it = gt; it < DEPTH * (96 * 128 + 1536 * 64); it += NGT) {
            const int l = it / (96 * 128 + 1536 * 64); int r = it % (96 * 128 + 1536 * 64);
            unsigned char* wl = ws + WS_W + (size_t)l * W_STRIDE;
            if (r < 96 * 128) { const int rr = r / 128, ch = r % 128; const int row = rr < 32 ? 1696 + rr : 2496 + (rr - 32);
                *(u32x4*)((bf16*)(wl + W_IN) + (size_t)row * DM + ch * 8) = (u32x4){0u, 0u, 0u, 0u}; }
            else { r -= 96 * 128; const int row = r / 64, ch = r % 64; const int col = ch * 8;
                const bool data = (row < 576 && col < 384) || (row >= 768 && col >= 384);
                if (!data) *(u32x4*)((bf16*)(wl + W_MLA) + (size_t)row * 512 + col) = (u32x4){0u, 0u, 0u, 0u}; }
        }
        for (int it = gt; it < SEQ * 16; it += NGT) { const int t = it >> 4, i = it & 15;
            const float inv_freq = exp2f(-(float)i * (13.287712379549449f / 16.0f));
            const float ang = (float)t * inv_freq;
            double rev = (double)ang * 0.15915494309189535; rev -= floor(rev); const float rv = (float)rev;
            ((f32x2*)(ws + WS_ROPE))[it] = (f32x2){__builtin_amdgcn_cosf(rv), __builtin_amdgcn_sinf(rv)}; }
        const float* rel_bias = args.in[7];
        for (int it = gt; it < 4 * 4096; it += NGT) { const int h = it >> 12, d = it & 4095; tmoba[it] = rel_bias[t5_bucket(d) * 10 + 6 + h] * LOG2E; }
        for (int it = gt; it < 3 * 6 * 192; it += NGT) { const int p = it / (6 * 192), h = (it / 192) % 6, d = it % 192 - 32; const int dil = p == 0 ? 1 : (p == 1 ? 4 : 16);
            tdil[it] = (d >= 0 && d <= 128) ? rel_bias[t5_bucket(d * dil) * 10 + h] * LOG2E : 0.f; }
        for (int g32 = bid; g32 < M / 32; g32 += G) { const int m0 = g32 * 32 + 4 * wave;
            f32x4 v[4][4]; float s[4];
#pragma unroll
            for (int q = 0; q < 4; ++q) { const f32x4* xr = (const f32x4*)(x_in + (size_t)(m0 + q) * DM) + 2 * lane;
#pragma unroll
                for (int j = 0; j < 2; ++j) { v[q][2 * j] = xr[128 * j]; v[q][2 * j + 1] = xr[128 * j + 1]; } }
#pragma unroll
            for (int q = 0; q < 4; ++q) { const int m = m0 + q;
                s[q] = 0.f;
#pragma unroll
                for (int j = 0; j < 4; ++j) s[q] += (v[q][j][0] * v[q][j][0] + v[q][j][1] * v[q][j][1]) + (v[q][j][2] * v[q][j][2] + v[q][j][3] * v[q][j][3]);
                s[q] = wave_sum(s[q]);
                u32x4* o16 = (u32x4*)(XB + (size_t)m * DM) + lane;
#pragma unroll
                for (int j = 0; j < 2; ++j) { u32x4 w; w.x = cvt_pk_bf16(v[q][2 * j][0], v[q][2 * j][1]); w.y = cvt_pk_bf16(v[q][2 * j][2], v[q][2 * j][3]);
                    w.z = cvt_pk_bf16(v[q][2 * j + 1][0], v[q][2 * j + 1][1]); w.w = cvt_pk_bf16(v[q][2 * j + 1][2], v[q][2 * j + 1][3]); o16[64 * j] = w; } }
            { const int q_ = lane & 3, sl = lane >> 2; const float sv = q_ == 0 ? s[0] : (q_ == 1 ? s[1] : (q_ == 2 ? s[2] : s[3]));
              ssq_all[(size_t)sl * M + m0 + q_] = sl == 0 ? sv : 0.f; }
        }
    }
    SEAM(0);

    for (int l = 0; l < DEPTH; ++l) {
        const int pb = 1 + 7 * l;
        if (pb + 7 <= lo || pb >= hi) continue;

        if (IN(pb + 0)) {
            LAYER_LOCALS;
            pg8::Gemm g{XB, (const bf16*)(wl + W_IN), M, PP, DM, DM}; pg8::StaticOrder S; S.init(M, PP, G, bid);
            pg8::stage_rs<0>((LAS float*)(lds + RS_OFF), ssq_x, S, wave);
            pg8::EpiProj E{PROJ, ssq_x, ssq_c, rope_cs};
            pg8::gemm_phase<pg8::EpiProj>(lds, g, S, E, wave);
        }
        SEAM(pb + 0);
        if (IN(pb + 1)) {
            LAYER_LOCALS;
            pg8::Gemm g{PROJ + C_CQ, (const bf16*)(wl + W_MLA), M, QP, 512, PP}; pg8::MlaOrder S{G == 256 ? bid : (bid == 0 ? 0 : 256)};
            pg8::stage_rs<1>((LAS float*)(lds + RS_OFF), ssq_c, S, wave);
            pg8::EpiMla E{QM, ssq_c, rope_cs};
            pg8::gemm_phase<pg8::EpiMla, false, pg8::MlaOrder>(lds, g, S, E, wave);
            { const int ln = lane_id();
              for (int it = gw; it < NB * 16 * H_MOBA; it += NGW) { const int blk = it >> 2, h = it & 3;
                  const bf16* p = PROJ + ((size_t)blk * 256 + (ln >> 3)) * PP + C_KC + h * 64 + (ln & 7) * 8; float a[8];
#pragma unroll
                  for (int e = 0; e < 8; ++e) a[e] = 0.f;
#pragma unroll 8
                  for (int i = 0; i < 32; ++i) { const u32x4 v = *(const u32x4*)(p + (size_t)i * 8 * PP);
                      a[0] += bf_lo(v.x); a[1] += bf_hi(v.x); a[2] += bf_lo(v.y); a[3] += bf_hi(v.y); a[4] += bf_lo(v.z); a[5] += bf_hi(v.z); a[6] += bf_lo(v.w); a[7] += bf_hi(v.w); }
#pragma unroll
                  for (int e = 0; e < 8; ++e) { a[e] += swz_xor<8>(a[e]); a[e] += swz_xor<16>(a[e]); a[e] = xsum32(a[e]); }
                  if (ln < 8) { float* o = kmean + (size_t)it * 64 + ln * 8;
                      *(f32x4*)o = (f32x4){a[0], a[1], a[2], a[3]} * (1.0f / 256.0f); *(f32x4*)(o + 4) = (f32x4){a[4], a[5], a[6], a[7]} * (1.0f / 256.0f); } } }
        }
        SEAM(pb + 1);
        if (IN(pb + 2)) {
            LAYER_LOCALS;
            { unsigned* qctr = ctl + CW_Q + 64 * (3 * l + 0);
              for (;;) { const int i = att::wg_next(qctr, lds, att::L_Q, wave); if (i >= NB * H_MLA * 16) break;
                  const int qb = 15 - i / (NB * H_MLA), bh = i % (NB * H_MLA); att::mla_unit2(bh / H_MLA, bh % H_MLA, qb, QM, PROJ, OB, ssq_c, lds, wave); } }
            { unsigned* qctr = ctl + CW_Q + 64 * (3 * l + 1);
              for (;;) { const int i = att::wg_next(qctr, lds, att::L_Q, wave); if (i >= NB * H_MOBA * 16) break;
                  const int j = 15 - i / (NB * H_MOBA), bh = i % (NB * H_MOBA); att::moba_unit(bh / H_MOBA, bh % H_MOBA, j, PROJ, kmean, tmoba, OB, ssq_c, lds, wave); } }
            { unsigned* qctr = ctl + CW_Q + 64 * (3 * l + 2);
              asm volatile("s_nop 15\n\ts_waitcnt vmcnt(0) lgkmcnt(0)\n\ts_barrier" ::: "memory");
              { const int t2 = wave * 64 + lane_id(); for (int i = t2; i < 3 * 6 * 192; i += NWAVES * 64) ((LAS float*)(lds + att::D_TB))[i] = tdil[i]; }
              asm volatile("s_nop 15\n\ts_waitcnt vmcnt(0) lgkmcnt(0)\n\ts_barrier" ::: "memory");
              const int ln = lane_id();
              (void)ln; att::dil_units(qctr, PROJ, (bf16*)out, (float*)((unsigned char*)out + 72 * MiB), lds, wave); }
        }
        SEAM(pb + 2);
        if (IN(pb + 3)) {
            LAYER_LOCALS;
            const int lane = lane_id();
            float* rowsc = (float*)(ws + WS_ROWSC);
            for (int m0 = gw; m0 < M; m0 += 4 * NGW) {
                u32x4 av[4][3]; float lv[4][3]; float qv[4];
                const float* lp = (const float*)((const unsigned char*)out + 72 * MiB);
                const int lc = lane < 48 ? lane : 47, hh_ = lc >> 3, sq = lane < 48 ? 0 : (lane < 58 ? lane - 48 : 9);
#pragma unroll
                for (int q = 0; q < 4; ++q) { const int m = m0 + q * NGW;
                    const bf16* op = (const bf16*)out + (size_t)m * 384 + 8 * lc; const int bb_ = m >> 12, tt_ = m & (SEQ - 1);
                    av[q][0] = *(const u32x4*)op; av[q][1] = *(const u32x4*)(op + (size_t)M * 384); av[q][2] = *(const u32x4*)(op + (size_t)2 * M * 384);
                    lv[q][0] = lp[((size_t)(0 * NB + bb_) * 6 + hh_) * SEQ + tt_];
                    lv[q][1] = lp[((size_t)(1 * NB + bb_) * 6 + hh_) * SEQ + (size_t)(tt_ & 3) * (SEQ >> 2) + (tt_ >> 2)];
                    lv[q][2] = lp[((size_t)(2 * NB + bb_) * 6 + hh_) * SEQ + (size_t)(tt_ & 15) * (SEQ >> 4) + (tt_ >> 4)];
                    qv[q] = ssq_c[(size_t)sq * M + m]; }
#pragma unroll
                for (int q = 0; q < 4; ++q) { const int m = m0 + q * NGW; float f0[8];
                    const u32x4 a0 = av[q][0], a1 = av[q][1], a2 = av[q][2]; const float l0 = lv[q][0], l1 = lv[q][1], l2 = lv[q][2]; const float mx = fmaxf(l0, fmaxf(l1, l2));
                    float w0 = exp2f(l0 - mx), w1 = exp2f(l1 - mx), w2 = exp2f(l2 - mx); const float iw = 1.0f / (w0 + w1 + w2); w0 *= iw; w1 *= iw; w2 *= iw;
                    f0[0] = w0 * bf_lo(a0.x) + w1 * bf_lo(a1.x) + w2 * bf_lo(a2.x); f0[1] = w0 * bf_hi(a0.x) + w1 * bf_hi(a1.x) + w2 * bf_hi(a2.x);
                    f0[2] = w0 * bf_lo(a0.y) + w1 * bf_lo(a1.y) + w2 * bf_lo(a2.y); f0[3] = w0 * bf_hi(a0.y) + w1 * bf_hi(a1.y) + w2 * bf_hi(a2.y);
                    f0[4] = w0 * bf_lo(a0.z) + w1 * bf_lo(a1.z) + w2 * bf_lo(a2.z); f0[5] = w0 * bf_hi(a0.z) + w1 * bf_hi(a1.z) + w2 * bf_hi(a2.z);
                    f0[6] = w0 * bf_lo(a0.w) + w1 * bf_lo(a1.w) + w2 * bf_lo(a2.w); f0[7] = w0 * bf_hi(a0.w) + w1 * bf_hi(a1.w) + w2 * bf_hi(a2.w);
                    u32x4 w; w.x = cvt_pk_bf16(f0[0], f0[1]); w.y = cvt_pk_bf16(f0[2], f0[3]); w.z = cvt_pk_bf16(f0[4], f0[5]); w.w = cvt_pk_bf16(f0[6], f0[7]);
                    if (lane < 48) *((u32x4*)(OB + (size_t)m * DM) + lane) = w;
                    float s0 = bf_lo(w.x) * bf_lo(w.x) + bf_hi(w.x) * bf_hi(w.x) + bf_lo(w.y) * bf_lo(w.y) + bf_hi(w.y) * bf_hi(w.y) + bf_lo(w.z) * bf_lo(w.z) + bf_hi(w.z) * bf_hi(w.z) + bf_lo(w.w) * bf_lo(w.w) + bf_hi(w.w) * bf_hi(w.w);
                    const float sa = wave_sum(lane < 48 ? s0 : 0.f);
                    const float sb = wave_sum((lane >= 48 && lane < 54) ? qv[q] : 0.f), sc = wave_sum((lane >= 54 && lane < 58) ? qv[q] : 0.f);
                    if (lane == 0) {
                        const float ra = rsqrtf(sa * (1.0f / 384.0f) + EPS), rb_ = rsqrtf(sb * (1.0f / 384.0f) + EPS), rc = rsqrtf(sc * (1.0f / 256.0f) + EPS);
                        *(f32x4*)(rowsc + (size_t)m * 4) = (f32x4){ra / rb_, rb_ / rc, rc, 0.f}; } }
            }
        }
        SEAM(pb + 3);
        if (IN(pb + 4)) {
            LAYER_LOCALS;
            pg8::Gemm g{OB, (const bf16*)(wl + W_O), M, DM, DM, DM}; pg8::StaticOrder S; S.init(M, DM, G, bid);
            { const float* rowsc = (const float*)(ws + WS_ROWSC); LAS float* rst = (LAS float*)(lds + RS_OFF); const int t = wave * 64 + lane_id(); pg8::Unit uu;
              for (int i = 0; i < 2 && S.next(i, uu); ++i) if (t < 256) *(LAS f32x4*)(rst + (i * 256 + t) * 4) = *(const f32x4*)(rowsc + (size_t)(uu.pm * 256 + t) * 4);
              asm volatile("s_nop 15\n\ts_waitcnt vmcnt(0) lgkmcnt(0)\n\ts_barrier" ::: "memory"); }
            pg8::EpiRes<true> E{XB, ssq_mlp, 1.0f};
            pg8::gemm_phase<pg8::EpiRes<true>, false, pg8::StaticOrder, true>(lds, g, S, E, wave);
        }
        SEAM(pb + 4);
        if (IN(pb + 5)) {
            LAYER_LOCALS;
            pg8::Gemm g{XB, (const bf16*)(wl + W_UP), M, DFF, DM, DM}; pg8::StaticOrder S; S.init(M, DFF, G, bid);
            pg8::stage_rs<0>((LAS float*)(lds + RS_OFF), ssq_mlp, S, wave);
#if FP8_DOWN
            pg8::EpiUp8 E{(unsigned char*)UB, ssq_mlp};
            pg8::gemm_phase<pg8::EpiUp8>(lds, g, S, E, wave);
#else
            pg8::EpiUp E{UB, ssq_mlp};
            pg8::gemm_phase<pg8::EpiUp>(lds, g, S, E, wave);
#endif
        }
        SEAM(pb + 5);
        if (IN(pb + 6)) {
            LAYER_LOCALS;
            pg8::Gemm g{UB, (const bf16*)(wl + W_DOWN), M, DM, DFF, DFF}; pg8::StaticOrder S; S.init(M, DM, G, bid);
#if FP8_DOWN
            pg8::EpiRes<false> E{XB, ssq_x, 1.0f / 512.0f};
            pg8::gemm_phase<pg8::EpiRes<false>, true>(lds, g, S, E, wave);
#else
            pg8::EpiRes<false> E{XB, ssq_x, 1.0f};
            pg8::gemm_phase<pg8::EpiRes<false>>(lds, g, S, E, wave);
#endif
        }
        SEAM(pb + 6);
    }
    if (IN(29)) {
        PHASE_LOCALS;
        const float* ssq_f = ssq_all; const float* gf = args.in[13];
        const int lane = lane_id();
        for (int m = gw; m < M; m += NGW) {
            const float rs = rsqrtf(ssq16(ssq_f + m, (size_t)M) * (1.0f / DM) + EPS);
#pragma unroll
            for (int j = 0; j < 2; ++j) { const int c = 8 * (lane + 64 * j); const u32x4 v = *(const u32x4*)(XB + (size_t)m * DM + c);
                const f32x4 ga = *(const f32x4*)(gf + c), gb = *(const f32x4*)(gf + c + 4);
                f32x4 oa = (f32x4){bf_lo(v.x), bf_hi(v.x), bf_lo(v.y), bf_hi(v.y)} * rs * ga, ob = (f32x4){bf_lo(v.z), bf_hi(v.z), bf_lo(v.w), bf_hi(v.w)} * rs * gb;
                *(f32x4*)(out + (size_t)m * DM + c) = oa; *(f32x4*)(out + (size_t)m * DM + c + 4) = ob; }
        }
    }
#undef IN
#undef SEAM
}

extern "C" void kernel_launch(void* const* d_in, const int* in_sizes, int n_in, void* d_out, int out_size, void* d_ws, size_t ws_size, hipStream_t stream) {
    static int grid = 0;
    if (grid == 0) {
        if (n_in != 14 || in_sizes[0] != M * DM || out_size != M * DM || ws_size < WS_END) { fprintf(stderr, "kernel_launch: unexpected shapes (n_in %d, in0 %d, out %d, ws %zu); nothing launched\n", n_in, n_in > 0 ? in_sizes[0] : -1, out_size, ws_size); grid = -1; return; }
        int dev = 0, cus = 0, per_cu = 0;
        if (hipGetDevice(&dev) != hipSuccess || hipDeviceGetAttribute(&cus, hipDeviceAttributeMultiprocessorCount, dev) != hipSuccess) { grid = -1; return; }
        if (hipFuncSetAttribute((const void*)mk_fwd, hipFuncAttributeMaxDynamicSharedMemorySize, LDS_BYTES) != hipSuccess) { fprintf(stderr, "kernel_launch: hipFuncSetAttribute failed\n"); grid = -1; return; }
        if (hipOccupancyMaxActiveBlocksPerMultiprocessor(&per_cu, (const void*)mk_fwd, NWAVES * 64, LDS_BYTES) != hipSuccess || per_cu < 1)
            fprintf(stderr, "kernel_launch: note: occupancy query reports %d workgroups per CU\n", per_cu);
        (void)hipGetLastError();
        grid = cus;
    }
    if (grid < 0) return;
    if (hipMemsetAsync((char*)d_ws + WS_CTL, 0, CTL_ZERO_BYTES, stream) != hipSuccess) { fprintf(stderr, "kernel_launch: memset failed\n"); return; }
    Args a{};
    for (int i = 0; i < 14; ++i) a.in[i] = (const float*)d_in[i];
    a.out = (float*)d_out; a.ws = (unsigned char*)d_ws; a.pad = 0;
#if MK_PER_PHASE
    for (int p = 0; p < N_PHASES; ++p) { a.ph_lo = p; a.ph_hi = p + 1; a.li = 0;
        hipLaunchKernelGGL(mk_fwd, dim3(grid), dim3(NWAVES * 64), LDS_BYTES, stream, a); }
#else
    a.ph_lo = 0; a.ph_hi = N_PHASES; a.li = 0;
    hipLaunchKernelGGL(mk_fwd, dim3(grid), dim3(NWAVES * 64), LDS_BYTES, stream, a);
#endif
    const hipError_t le = hipPeekAtLastError();
    if (le != hipSuccess) fprintf(stderr, "kernel_launch: launch failed: %s\n", hipGetErrorName(le));
}
```

```cpp
#include <hip/hip_runtime.h>
#include <cstdio>
#include <cstdint>

#define LAS __attribute__((address_space(3)))
#define GAS __attribute__((address_space(1)))
typedef unsigned short bf16;
typedef short bf16x8 __attribute__((ext_vector_type(8)));
typedef float f32x4 __attribute__((ext_vector_type(4)));
typedef float f32x2 __attribute__((ext_vector_type(2)));
typedef unsigned u32x4 __attribute__((ext_vector_type(4)));
typedef unsigned u32x2 __attribute__((ext_vector_type(2)));
typedef int i32x4 __attribute__((ext_vector_type(4)));
typedef int i32x8 __attribute__((ext_vector_type(8)));

#ifndef FP8_DOWN
#define FP8_DOWN 1
#endif
#ifndef MK_PER_PHASE
#define MK_PER_PHASE 0
#endif

constexpr int NB = 8, SEQ = 4096, DM = 1024, DEPTH = 4, M = NB * SEQ, DFF = 4096;
constexpr int DIN = 2464, PP = 2560  , QP = 1536  ;
constexpr int H_DIL = 6, H_MLA = 6, H_MOBA = 4;
constexpr int C_QA = 0, C_KA = 384, C_VA = 768, C_CQ = 1152, C_CKV = 1536, C_KR = 1664, C_QC = 1728, C_KC = 1984, C_VC = 2240;
constexpr int Q_NOPE = 0, Q_ROPE = 384, Q_KV = 768;
constexpr int O_A = 0, O_B = 384, O_C = 768;
constexpr float EPS = 1e-6f;
constexpr float LOG2E = 1.4426950408889634f;
constexpr float QS_64 = 0.125f * LOG2E;
constexpr float QS_96 = 0.10206207261596575f * LOG2E;

constexpr size_t MiB = 1u << 20;
constexpr size_t WS_CTL = 0, CTL_ZERO_BYTES = 1 * MiB;
constexpr size_t WS_SSQ = 1 * MiB;
constexpr size_t WS_ROPE = 7 * MiB;
constexpr size_t WS_TMOBA = 7 * MiB + 512 * 1024;
constexpr size_t WS_TDIL = WS_TMOBA + 64 * 1024;
constexpr size_t WS_KMEAN = 7 * MiB + 768 * 1024;
constexpr size_t WS_W = 8 * MiB, W_STRIDE = 25 * MiB;
constexpr size_t W_IN = 0, W_MLA = 5 * MiB, W_O = 6 * MiB + 512 * 1024, W_UP = 8 * MiB + 512 * 1024, W_DOWN = 16 * MiB + 512 * 1024;
constexpr size_t WS_ROWSC = 108 * MiB;
constexpr size_t WS_XB = 112 * MiB;
constexpr size_t WS_PROJ = 176 * MiB;
constexpr size_t WS_QM = 336 * MiB;
constexpr size_t WS_O = 432 * MiB;
constexpr size_t WS_U = WS_PROJ;
constexpr size_t WS_END = 496 * MiB;
static_assert(WS_PROJ + (size_t)M * PP * 2 == WS_QM && WS_QM + (size_t)M * QP * 2 == WS_O && WS_U + (size_t)M * DFF * 2 <= WS_O && WS_O + (size_t)M * DM * 2 == WS_END, "ws map");
static_assert(WS_W + DEPTH * W_STRIDE <= WS_XB && WS_XB + (size_t)M * DM * 2 == WS_PROJ, "ws map 2");
constexpr int CW_Q = 1024;
constexpr int CW_BAR = 16384;
constexpr int N_PHASES = 30;

constexpr int RING_BYTES = 131072;
constexpr int LDSCTL_OFF = RING_BYTES, MISC_OFF = LDSCTL_OFF + 320;
constexpr int RS_OFF = 132096;
constexpr int LDS_BYTES = 147456;
constexpr int NWAVES = 8;

#define LDS_WAIT() asm volatile("s_waitcnt lgkmcnt(0)" ::: "memory")
#define VM_WAIT() asm volatile("s_waitcnt vmcnt(0)" ::: "memory")
typedef __bf16 bf16x2_t __attribute__((ext_vector_type(2)));
__device__ __forceinline__ unsigned cvt_pk_bf16(float lo, float hi) { const f32x2 v = {lo, hi}; const bf16x2_t b = __builtin_convertvector(v, bf16x2_t); return __builtin_bit_cast(unsigned, b); }
__device__ __forceinline__ float bf_lo(unsigned u) { return __uint_as_float(u << 16); }
__device__ __forceinline__ float bf_hi(unsigned u) { return __uint_as_float(u & 0xffff0000u); }
__device__ __forceinline__ float dot8(u32x4 a, u32x4 b, float s) {
    s = fmaf(bf_lo(a.x), bf_lo(b.x), s); s = fmaf(bf_hi(a.x), bf_hi(b.x), s);
    s = fmaf(bf_lo(a.y), bf_lo(b.y), s); s = fmaf(bf_hi(a.y), bf_hi(b.y), s);
    s = fmaf(bf_lo(a.z), bf_lo(b.z), s); s = fmaf(bf_hi(a.z), bf_hi(b.z), s);
    s = fmaf(bf_lo(a.w), bf_lo(b.w), s); s = fmaf(bf_hi(a.w), bf_hi(b.w), s);
    return s;
}
__device__ __forceinline__ int lane_id() { int l; asm volatile("v_mbcnt_lo_u32_b32 %0, -1, 0\n\tv_mbcnt_hi_u32_b32 %0, -1, %0" : "=v"(l)); return l; }
template <int X> __device__ __forceinline__ float swz_xor(float v) { return __int_as_float(__builtin_amdgcn_ds_swizzle(__float_as_int(v), (X << 10) | 0x1f)); }
__device__ __forceinline__ float xsum32(float v) { auto rr = __builtin_amdgcn_permlane32_swap(__float_as_uint(v), __float_as_uint(v), false, false); return __uint_as_float(rr[0]) + __uint_as_float(rr[1]); }
__device__ __forceinline__ float wave_sum(float v) { v += swz_xor<1>(v); v += swz_xor<2>(v); v += swz_xor<4>(v); v += swz_xor<8>(v); v += swz_xor<16>(v); return xsum32(v); }
__device__ __forceinline__ float sum4(const f32x4& a) { return (a[0] + a[1]) + (a[2] + a[3]); }
__device__ __forceinline__ float ssq16(const float* p, size_t st) { float a[16];
#pragma unroll
    for (int i = 0; i < 16; ++i) a[i] = p[(size_t)i * st];
    return ((((a[0] + a[1]) + (a[2] + a[3])) + ((a[4] + a[5]) + (a[6] + a[7]))) + (((a[8] + a[9]) + (a[10] + a[11])) + ((a[12] + a[13]) + (a[14] + a[15])))); }

namespace pg8 {
constexpr int BM = 256, BK = 64, HALF = 128, HTB = HALF * BK * 2, STAGE_BYTES = 8 * HTB, NXCD = 8, WGM = 8;
__host__ __device__ __forceinline__ int lds_byte(int r, int c) { const int st = (r >> 4) * 2 + (c >> 5), rr = r & 15, cc = c & 31, ob = rr * 64 + cc * 2; return st * 1024 + (ob ^ (((ob >> 9) & 1) << 5)); }
__host__ __device__ __forceinline__ void stage_rc(int b, int& R, int& C) { const int st = b / 1024, sb = b % 1024, swz = sb ^ (((sb >> 9) & 1) << 5); R = (st >> 1) * 16 + swz / 64; C = (st & 1) * 32 + (swz % 64) / 2; }
__host__ __device__ __forceinline__ int perm32(int rho) { const int n = rho >> 4, i = rho & 15; return 8 * (i >> 2) + 4 * n + (i & 3); }

struct Unit { int pm, pn; };
struct Gemm { const bf16* A; const bf16* Bt; int M, N, K, lda; };

struct StaticOrder {
    int nM, nN, nwg, G, c;
    __host__ __device__ __forceinline__ void init(int M_, int N_, int G_, int c_) { nM = M_ / BM; nN = N_ / BM; nwg = nM * nN; G = G_; c = c_; }
    __host__ __device__ __forceinline__ bool next(int i, Unit& u) const {
        const long L = (long)i * G + c; if (L >= nwg) return false;
        int wgid = (int)L; { const int q = nwg / NXCD, r = nwg % NXCD, xcd = wgid % NXCD, off = wgid / NXCD; wgid = (xcd < r ? xcd * (q + 1) : r * (q + 1) + (xcd - r) * q) + off; }
        const int nig = WGM * nN, gid = wgid / nig, fm = gid * WGM, gsz = (nM - fm) < WGM ? (nM - fm) : WGM;
        u.pm = fm + ((wgid % nig) % gsz); u.pn = (wgid % nig) / gsz; return true;
    }
    __host__ __device__ __forceinline__ void krange(const Unit&, int& kt0, int& ntu, int ntfull) const { kt0 = 0; ntu = ntfull; }
};
struct MlaOrder {
    int c;
    __host__ __device__ __forceinline__ bool next(int i, Unit& u) const { if (i >= 3 || c >= 256) return false; u.pm = c >> 1; const int odd = c & 1; u.pn = odd ? (i == 0 ? 2 : 3 + i) : (i == 2 ? 3 : i); return true; }
    __host__ __device__ __forceinline__ void krange(const Unit& u, int& kt0, int& ntu, int) const { if (u.pn < 3) { kt0 = 0; ntu = 6; } else { kt0 = 6; ntu = 2; } }
};

template <class Epi, bool F8 = false, class Sched = StaticOrder, bool RSC = false>
__device__ __forceinline__ void gemm_phase(LAS unsigned char* lds, const Gemm g, const Sched& S, const Epi& E, const int wid  ) {
    const int lane = lane_id(), tid = wid * 64 + lane;
    const int wr = wid >> 2, wc = wid & 3, fr = lane & 15, fq = lane >> 4;
    constexpr int ESZ = F8 ? 1 : 2;
    const int K = g.K, ntfull = K * ESZ / (BK * 2), lda = g.lda;
    unsigned voffA[2], voffB[2];
#pragma unroll
    for (int i = 0; i < 2; ++i) { int R, C; stage_rc(tid * 16 + i * 8192, R, C); const int Rb = Epi::PERM ? ((R & ~31) + perm32(R & 31)) : R;
        voffA[i] = (unsigned)(R * lda * ESZ + C * 2); voffB[i] = (unsigned)(Rb * K * ESZ + C * 2); }
    const size_t kstep = (size_t)(BK * 2);
    const size_t hstepA = (size_t)HALF * lda * ESZ, hstepB = (size_t)HALF * K * ESZ;
    const size_t tstepA = 2 * hstepA, tstepB = 2 * hstepB;
    const unsigned ldsw = (unsigned)wid * 1024u;
    const int aoff = lds_byte(wr * 64 + fr, fq * 8), boff = lds_byte(wc * 32 + fr, fq * 8);
#define PG8_SA(b, h) (((b) * 2 + (h)) * HTB)
#define PG8_SB(b, h) ((4 + (b) * 2 + (h)) * HTB)
#define PG8_STAGE(bufoff, gbase, voff) do { _Pragma("unroll") for (int _i = 0; _i < 2; ++_i) { unsigned vo_ = (voff)[_i]; asm volatile("" : "+v"(vo_));   \
        __builtin_amdgcn_global_load_lds((const unsigned*)((const char*)(gbase) + vo_), (LAS unsigned*)(lds + (bufoff) + ldsw + _i * 8192), 16, 0, 0); } } while (0)
#define PG8_RD2(p) __builtin_shufflevector(*(const LAS i32x4*)(p), *(const LAS i32x4*)((p) + 1024), 0, 1, 2, 3, 4, 5, 6, 7)
#define PG8_LDA(dst, b, h) do { _Pragma("unroll") for (int m = 0; m < 4; ++m) dst[m] = PG8_RD2(lds + PG8_SA(b, h) + aoff + m * 2048); } while (0)
#define PG8_LDB(dst, b, h) do { _Pragma("unroll") for (int n = 0; n < 2; ++n) dst[n] = PG8_RD2(lds + PG8_SB(b, h) + boff + n * 2048); } while (0)
#define PG8_LO(x) __builtin_bit_cast(bf16x8, __builtin_shufflevector(x, x, 0, 1, 2, 3))
#define PG8_HI(x) __builtin_bit_cast(bf16x8, __builtin_shufflevector(x, x, 4, 5, 6, 7))
#define PG8_MMA(ai, bj, At, Bt) do { __builtin_amdgcn_s_setprio(1); _Pragma("unroll") for (int m = 0; m < 4; ++m) _Pragma("unroll") for (int n = 0; n < 2; ++n) { \
        if constexpr (F8) acc[ai][bj][m][n] = __builtin_amdgcn_mfma_scale_f32_16x16x128_f8f6f4(Bt[n], At[m], acc[ai][bj][m][n], 0, 0, 0, 0x7f7f7f7f, 0, 0x7f7f7f7f); \
        else { acc[ai][bj][m][n] = __builtin_amdgcn_mfma_f32_16x16x32_bf16(PG8_LO(Bt[n]), PG8_LO(At[m]), acc[ai][bj][m][n], 0, 0, 0); \
               acc[ai][bj][m][n] = __builtin_amdgcn_mfma_f32_16x16x32_bf16(PG8_HI(Bt[n]), PG8_HI(At[m]), acc[ai][bj][m][n], 0, 0, 0); } } \
        __builtin_amdgcn_s_setprio(0); } while (0)
#define PG8_WAIT_V(n) asm volatile("s_waitcnt vmcnt(" #n ")" ::: "memory")
#define PG8_WAIT_L(n) asm volatile("s_waitcnt lgkmcnt(" #n ")" ::: "memory")
#define PG8_BAR __builtin_amdgcn_s_barrier()
#define PG8_SCHED __builtin_amdgcn_sched_barrier(0)
    Unit cur, nxt; int ui = 0;
    if (!S.next(0, cur)) return;
    f32x4 acc[2][2][4][2];
#pragma unroll
    for (int a = 0; a < 2; ++a)
#pragma unroll
        for (int b = 0; b < 2; ++b)
#pragma unroll
            for (int m = 0; m < 4; ++m)
#pragma unroll
                for (int n = 0; n < 2; ++n) acc[a][b][m][n] = (f32x4){0.f, 0.f, 0.f, 0.f};
    i32x8 At[4], B0[2], B1[2];
    int kt0, nt; S.krange(cur, kt0, nt, ntfull);
    const char* cA = (const char*)g.A + (size_t)cur.pm * tstepA + (size_t)kt0 * kstep; const char* cB = (const char*)g.Bt + (size_t)cur.pn * tstepB + (size_t)kt0 * kstep;
    PG8_STAGE(PG8_SB(0, 0), cB, voffB); PG8_STAGE(PG8_SB(0, 1), cB + hstepB, voffB); PG8_STAGE(PG8_SA(0, 0), cA, voffA); PG8_STAGE(PG8_SA(0, 1), cA + hstepA, voffA);
    if (wr == 1) PG8_BAR;
    PG8_WAIT_V(2); PG8_BAR;
    PG8_STAGE(PG8_SB(1, 0), cB + kstep, voffB); PG8_STAGE(PG8_SA(1, 0), cA + kstep, voffA); PG8_STAGE(PG8_SB(1, 1), cB + hstepB + kstep, voffB);
    PG8_WAIT_V(6); PG8_BAR;
    for (;;) {
        const bool has_next = S.next(ui + 1, nxt);
        int nkt0 = kt0, nnt = nt; if (has_next) S.krange(nxt, nkt0, nnt, ntfull);
        const char* nA = has_next ? (const char*)g.A + (size_t)nxt.pm * tstepA + (size_t)nkt0 * kstep : cA; const char* nB = has_next ? (const char*)g.Bt + (size_t)nxt.pn * tstepB + (size_t)nkt0 * kstep : cB;
        for (int t = 0; t < nt; t += 2) {
            if constexpr (RSC) { if (t == 6 || t == 12) { const LAS float* rr_ = (const LAS float*)(lds + RS_OFF) + (ui * 256 + wr * 64 + fr) * 4 + (t == 6 ? 0 : 1);
#pragma unroll
                for (int ai = 0; ai < 2; ++ai)
#pragma unroll
                    for (int m = 0; m < 4; ++m) { const float f_ = rr_[(ai * HALF + m * 16) * 4];
#pragma unroll
                        for (int bj = 0; bj < 2; ++bj)
#pragma unroll
                            for (int n = 0; n < 2; ++n) acc[ai][bj][m][n] *= f_; } } }
            const bool last = (t == nt - 2);
            const char* a1 = cA + (size_t)(t + 1) * kstep;
            const char* a2 = last ? nA : cA + (size_t)(t + 2) * kstep; const char* b2 = last ? nB : cB + (size_t)(t + 2) * kstep;
            const char* a3 = a2 + kstep; const char* b3 = b2 + kstep;
            PG8_LDB(B0, 0, 0); PG8_LDB(B1, 0, 1); PG8_SCHED; PG8_LDA(At, 0, 0); PG8_STAGE(PG8_SA(1, 1), a1 + hstepA, voffA);
            PG8_WAIT_V(8); PG8_WAIT_L(0); PG8_BAR; PG8_MMA(0, 0, At, B0); PG8_MMA(0, 1, At, B1); PG8_BAR; PG8_SCHED;
            PG8_LDA(At, 0, 1); PG8_STAGE(PG8_SB(0, 0), b2, voffB); PG8_STAGE(PG8_SB(0, 1), b2 + hstepB, voffB); PG8_STAGE(PG8_SA(0, 0), a2, voffA);
            PG8_WAIT_V(8); PG8_WAIT_L(0); PG8_BAR; PG8_MMA(1, 0, At, B0); PG8_MMA(1, 1, At, B1); PG8_BAR; PG8_SCHED;
            PG8_LDB(B0, 1, 0); PG8_LDB(B1, 1, 1); PG8_SCHED; PG8_LDA(At, 1, 0); PG8_STAGE(PG8_SA(0, 1), a2 + hstepA, voffA);
            PG8_WAIT_V(8); PG8_WAIT_L(0); PG8_BAR; PG8_MMA(0, 0, At, B0); PG8_MMA(0, 1, At, B1); PG8_BAR; PG8_SCHED;
            PG8_LDA(At, 1, 1); PG8_STAGE(PG8_SB(1, 0), b3, voffB); PG8_STAGE(PG8_SB(1, 1), b3 + hstepB, voffB); PG8_STAGE(PG8_SA(1, 0), a3, voffA);
            PG8_WAIT_V(8); PG8_WAIT_L(0); PG8_BAR; PG8_MMA(1, 0, At, B0); PG8_MMA(1, 1, At, B1); PG8_BAR; PG8_SCHED;
        }
        if (wr == 0) PG8_BAR;
        { const int le = lane_id(); E(acc, cur, ui, (const LAS float*)(lds + RS_OFF - 0), wr, wc, le & 15, le >> 4); }
        if (!has_next) break;
#pragma unroll
        for (int a = 0; a < 2; ++a)
#pragma unroll
            for (int b = 0; b < 2; ++b)
#pragma unroll
                for (int m = 0; m < 4; ++m)
#pragma unroll
                    for (int n = 0; n < 2; ++n) acc[a][b][m][n] = (f32x4){0.f, 0.f, 0.f, 0.f};
        cur = nxt; cA = nA; cB = nB; nt = nnt; kt0 = nkt0; ++ui;
        if (wr == 1) PG8_BAR;
    }
    PG8_WAIT_V(0);
    PG8_BAR;
#undef PG8_SA
#undef PG8_SB
#undef PG8_STAGE
#undef PG8_LDA
#undef PG8_LDB
#undef PG8_MMA
#undef PG8_LO
#undef PG8_HI
#undef PG8_RD2
#undef PG8_WAIT_V
#undef PG8_WAIT_L
#undef PG8_BAR
#undef PG8_SCHED
}

template <int MODE, class Sched> __device__ __forceinline__ void stage_rs(LAS float* rst, const float* ssq, const Sched& S, int wave) {
    const int t = wave * 64 + lane_id(), half = t >> 8, row = t & 255;
    f32x4 q[4][4]; int pn_[4]; bool ok[4];
#pragma unroll
    for (int k = 0; k < 4; ++k) { Unit u; ok[k] = S.next(2 * k + half, u); pn_[k] = ok[k] ? u.pn : 0; const int pm = ok[k] ? u.pm : 0;
        const float* p = ssq + (size_t)(pm * BM + row);
#pragma unroll
        for (int j = 0; j < 4; ++j) q[k][j] = (f32x4){p[(size_t)(4 * j) * M], p[(size_t)(4 * j + 1) * M], p[(size_t)(4 * j + 2) * M], p[(size_t)(4 * j + 3) * M]}; }
#pragma unroll
    for (int k = 0; k < 4; ++k) if (ok[k]) { float r;
        if (MODE == 0) r = rsqrtf(((sum4(q[k][0]) + sum4(q[k][1])) + (sum4(q[k][2]) + sum4(q[k][3]))) * (1.0f / DM) + EPS);
        else r = pn_[k] < 3 ? rsqrtf(((sum4(q[k][0]) + sum4(q[k][1])) + sum4(q[k][2])) * (1.0f / 384.0f) + EPS) : rsqrtf(sum4(q[k][3]) * (1.0f / 128.0f) + EPS);
        rst[(2 * k + half) * 256 + row] = r; }
    asm volatile("s_nop 15\n\ts_waitcnt vmcnt(0) lgkmcnt(0)\n\ts_barrier" ::: "memory");
}

__device__ __forceinline__ void rope_consts(float (&crev)[4], int i0) {
#pragma unroll
    for (int p = 0; p < 4; ++p) crev[p] = __builtin_amdgcn_exp2f(-(float)(i0 + p) * (13.287712379549449f / 16.0f)) * 0.15915494309189535f;
}
__device__ __forceinline__ void rope8(f32x4& v0, f32x4& v1, int pos, const float (&crev)[4]) {
    float c[4], sn[4];
#pragma unroll
    for (int p = 0; p < 4; ++p) { float rev = (float)pos * crev[p]; rev = __builtin_amdgcn_fractf(rev); c[p] = __builtin_amdgcn_cosf(rev); sn[p] = __builtin_amdgcn_sinf(rev); }
    f32x4 a, b;
    a[0] = v0[0] * c[0] - v0[1] * sn[0]; a[1] = v0[1] * c[0] + v0[0] * sn[0];
    a[2] = v0[2] * c[1] - v0[3] * sn[1]; a[3] = v0[3] * c[1] + v0[2] * sn[1];
    b[0] = v1[0] * c[2] - v1[1] * sn[2]; b[1] = v1[1] * c[2] + v1[0] * sn[2];
    b[2] = v1[2] * c[3] - v1[3] * sn[3]; b[3] = v1[3] * c[3] + v1[2] * sn[3];
    v0 = a; v1 = b;
}
__device__ __forceinline__ float sumsq8(const f32x4& a, const f32x4& b) { return (a[0] * a[0] + a[1] * a[1]) + (a[2] * a[2] + a[3] * a[3]) + (b[0] * b[0] + b[1] * b[1]) + (b[2] * b[2] + b[3] * b[3]); }
__device__ __forceinline__ u32x4 pack8(const f32x4& a, const f32x4& b) { u32x4 w; w.x = cvt_pk_bf16(a[0], a[1]); w.y = cvt_pk_bf16(a[2], a[3]); w.z = cvt_pk_bf16(b[0], b[1]); w.w = cvt_pk_bf16(b[2], b[3]); return w; }

struct EpiProj {
    static constexpr bool PERM = true;
    bf16* O; const float* ssq_x; float* ssq_c; const f32x2* cs;
    __device__ __forceinline__ void operator()(const f32x4 (&acc)[2][2][4][2], const Unit& u, int ui, const LAS float* rst, int wr, int wc, int fr, int fq) const {
        const int row0 = u.pm * BM + wr * 64 + fr, colb = u.pn * BM + wc * 32 + 8 * fq;
        const bool sp = (u.pn >= 4 && u.pn <= 6);
        float crev[4]; rope_consts(crev, 4 * fq);
#pragma unroll
        for (int ai = 0; ai < 2; ++ai)
#pragma unroll
            for (int m = 0; m < 4; ++m) { const int row = row0 + ai * HALF + m * 16; const float rs = rst[ui * 256 + row - u.pm * BM];
                bf16* rowp = O + (size_t)row * PP + colb;
#pragma unroll
                for (int bj = 0; bj < 2; ++bj) { f32x4 v0 = acc[ai][bj][m][0] * rs, v1 = acc[ai][bj][m][1] * rs;
                    if (sp) {
                        if (u.pn == 6 && bj == 1 && wc == 0) rope8(v0, v1, row & (SEQ - 1), crev);
                        const bool is_cq = (u.pn == 4 && bj == 1) || (u.pn == 5), is_ckv = (u.pn == 6 && bj == 0);
                        if (is_cq || is_ckv) { float s = sumsq8(v0, v1); s += swz_xor<16>(s); s = xsum32(s);
                            const int slot = (is_ckv ? 12 : (u.pn == 4 ? 0 : 4 + 4 * bj)) + wc;
                            if (fq == 0) ssq_c[(size_t)slot * M + row] = s; }
                    }
                    *(u32x4*)(rowp + bj * HALF) = pack8(v0, v1); } }
    }
};
struct EpiMla {
    static constexpr bool PERM = true;
    bf16* O; const float* ssq_c; const f32x2* cs;
    __device__ __forceinline__ void operator()(const f32x4 (&acc)[2][2][4][2], const Unit& u, int ui, const LAS float* rst, int wr, int wc, int fr, int fq) const {
        const int row0 = u.pm * BM + wr * 64 + fr, colb = u.pn * BM + wc * 32 + 8 * fq;
        const bool isq = u.pn < 3;
        float crev[4]; rope_consts(crev, 4 * fq);
#pragma unroll
        for (int ai = 0; ai < 2; ++ai)
#pragma unroll
            for (int m = 0; m < 4; ++m) { const int row = row0 + ai * HALF + m * 16;
                const float rs = rst[ui * 256 + row - u.pm * BM];
                bf16* rowp = O + (size_t)row * QP + colb;
#pragma unroll
                for (int bj = 0; bj < 2; ++bj) { f32x4 v0 = acc[ai][bj][m][0] * rs, v1 = acc[ai][bj][m][1] * rs;
                    if ((u.pn == 1 && bj == 1) || (u.pn == 2 && bj == 0)) rope8(v0, v1, row & (SEQ - 1), crev);
                    *(u32x4*)(rowp + bj * HALF) = pack8(v0, v1); } }
    }
};
template <bool RS> struct EpiRes {
    static constexpr bool PERM = true;
    bf16* xb; float* ssq; float ascale;
    __device__ __forceinline__ void operator()(const f32x4 (&acc)[2][2][4][2], const Unit& u, int ui, const LAS float* rst, int wr, int wc, int fr, int fq) const {
        const int row0 = u.pm * BM + wr * 64 + fr, colb = u.pn * BM + wc * 32 + 8 * fq;
        u32x4 old[2][4][2];
#pragma unroll
        for (int ai = 0; ai < 2; ++ai)
#pragma unroll
            for (int m = 0; m < 4; ++m)
#pragma unroll
                for (int bj = 0; bj < 2; ++bj) old[ai][m][bj] = *(const u32x4*)(xb + (size_t)(row0 + ai * HALF + m * 16) * DM + colb + bj * HALF);
#pragma unroll
        for (int ai = 0; ai < 2; ++ai)
#pragma unroll
            for (int m = 0; m < 4; ++m) { const int row = row0 + ai * HALF + m * 16; bf16* rowp = xb + (size_t)row * DM + colb; float s = 0.f;
                const float asc = RS ? ascale * rst[(ui * 256 + row - u.pm * BM) * 4 + 2] : ascale;
#pragma unroll
                for (int bj = 0; bj < 2; ++bj) { const u32x4 o4 = old[ai][m][bj];
                    const f32x4 v0 = acc[ai][bj][m][0] * asc + (f32x4){bf_lo(o4.x), bf_hi(o4.x), bf_lo(o4.y), bf_hi(o4.y)}, v1 = acc[ai][bj][m][1] * asc + (f32x4){bf_lo(o4.z), bf_hi(o4.z), bf_lo(o4.w), bf_hi(o4.w)};
                    s += sumsq8(v0, v1); *(u32x4*)(rowp + bj * HALF) = pack8(v0, v1); }
                s += swz_xor<16>(s); s = xsum32(s);
                if (fq == 0) ssq[(size_t)(u.pn * 4 + wc) * M + row] = s; }
    }
};
struct EpiUp {
    static constexpr bool PERM = true;
    bf16* O; const float* ssq;
    __device__ __forceinline__ void operator()(const f32x4 (&acc)[2][2][4][2], const Unit& u, int ui, const LAS float* rst, int wr, int wc, int fr, int fq) const {
        const int row0 = u.pm * BM + wr * 64 + fr, colb = u.pn * BM + wc * 32 + 8 * fq;
#pragma unroll
        for (int ai = 0; ai < 2; ++ai)
#pragma unroll
            for (int m = 0; m < 4; ++m) { const int row = row0 + ai * HALF + m * 16; const float rs = rst[ui * 256 + row - u.pm * BM];
                bf16* rowp = O + (size_t)row * DFF + colb;
#pragma unroll
                for (int bj = 0; bj < 2; ++bj) { f32x4 v0 = acc[ai][bj][m][0] * rs, v1 = acc[ai][bj][m][1] * rs;
#pragma unroll
                    for (int e = 0; e < 4; ++e) { const float a = fmaxf(v0[e], 0.f), b = fmaxf(v1[e], 0.f); v0[e] = a * a; v1[e] = b * b; }
                    *(u32x4*)(rowp + bj * HALF) = pack8(v0, v1); } }
    }
};
__device__ __forceinline__ unsigned pk4_fp8(const f32x4& v) { unsigned w = 0u; w = __builtin_amdgcn_cvt_pk_fp8_f32(v[0], v[1], w, false); w = __builtin_amdgcn_cvt_pk_fp8_f32(v[2], v[3], w, true); return w; }
struct EpiUp8 {
    static constexpr bool PERM = true;
    unsigned char* O; const float* ssq;
    __device__ __forceinline__ void operator()(const f32x4 (&acc)[2][2][4][2], const Unit& u, int ui, const LAS float* rst, int wr, int wc, int fr, int fq) const {
        const int row0 = u.pm * BM + wr * 64 + fr, colb = u.pn * BM + wc * 32 + 8 * fq;
#pragma unroll
        for (int ai = 0; ai < 2; ++ai)
#pragma unroll
            for (int m = 0; m < 4; ++m) { const int row = row0 + ai * HALF + m * 16; const float rs = rst[ui * 256 + row - u.pm * BM];
                unsigned char* rowp = O + (size_t)row * DFF + colb;
                u32x2 w[2];
#pragma unroll
                for (int bj = 0; bj < 2; ++bj) { f32x4 v0 = acc[ai][bj][m][0] * rs, v1 = acc[ai][bj][m][1] * rs;
#pragma unroll
                    for (int e = 0; e < 4; ++e) { const float a = fmaxf(v0[e], 0.f), b = fmaxf(v1[e], 0.f); v0[e] = fminf(a * a * 8.0f, 448.0f); v1[e] = fminf(b * b * 8.0f, 448.0f); }
                    w[bj].x = pk4_fp8(v0); w[bj].y = pk4_fp8(v1); }
                { auto sx = __builtin_amdgcn_permlane16_swap(w[0].x, w[1].x, false, false); auto sy = __builtin_amdgcn_permlane16_swap(w[0].y, w[1].y, false, false);
                  const u32x4 o = {sx[0], sy[0], sx[1], sy[1]};
                  *(u32x4*)(rowp + ((fq & 1) ? HALF - 8 : 0)) = o; } }
    }
};
}

#define XB_TMO      128
#define XB_XCNT(j)  (256  + 64 * (j))
#define XB_XSUB(j)  (1280 + 64 * (j))
#define XB_XGEN(j)  (2304 + 64 * (j))
#define XB_TOP      3328
#define XB_TOPGEN   3392
#define XCD_BAR_WORDS 3456
#define XB_SPIN_CAP (1u << 18)
__device__ __forceinline__ unsigned xb_ld(unsigned* p)              { return __hip_atomic_load(p, __ATOMIC_RELAXED, __HIP_MEMORY_SCOPE_AGENT); }
__device__ __forceinline__ unsigned xb_add(unsigned* p, unsigned v) { return __hip_atomic_fetch_add(p, v, __ATOMIC_RELAXED, __HIP_MEMORY_SCOPE_AGENT); }
__device__ __forceinline__ unsigned xb_xcc_id() { return (unsigned)__builtin_amdgcn_s_getreg((3 << 11) | 20) & 0xFu; }
#define XB_SPIN(cond, bar) do { unsigned _sp = 0; while (cond) { __builtin_amdgcn_s_sleep(1); \
    if ((++_sp & 255u) == 0u) { if (xb_ld(&(bar)[XB_TMO])) break; if (_sp > XB_SPIN_CAP) { atomicAdd(&(bar)[XB_TMO], 1u); break; } } } } while (0)
struct XcdBarrier { unsigned* bar; unsigned x; volatile LAS unsigned* st; };
__device__ __forceinline__ XcdBarrier xcd_barrier_post(unsigned* bar, volatile LAS unsigned* st, bool t0  ) {
    XcdBarrier b; b.bar = bar; b.x = xb_xcc_id(); b.st = st;
    if (t0) (void)xb_add(&bar[XB_XCNT(b.x)], 1u);
    return b;
}
__device__ __forceinline__ void xcd_barrier_complete(unsigned* bar, unsigned x, unsigned& nloc, unsigned& nx) {
    const unsigned G = gridDim.x * gridDim.y * gridDim.z;
    unsigned sum, cnt, mine, sp = 0u;
    for (;;) {
        sum = 0u; cnt = 0u; mine = 0u;
#pragma unroll
        for (unsigned j = 0; j < 16; ++j) { const unsigned c = xb_ld(&bar[XB_XCNT(j)]); sum += c; cnt += (c > 0u) ? 1u : 0u; mine = (j == x) ? c : mine; }
        if (sum == G) break;
        __builtin_amdgcn_s_sleep(1);
        if ((++sp & 255u) == 0u) { if (xb_ld(&bar[XB_TMO])) break; if (sp > XB_SPIN_CAP) { atomicAdd(&bar[XB_TMO], 1u); break; } }
    }
    nloc = mine > 0u ? mine : 1u; nx = cnt > 0u ? cnt : 1u;
}
__device__ __forceinline__ void xcd_barrier(const XcdBarrier& b, bool t0  ) {
    asm volatile("s_waitcnt vmcnt(0)" ::: "memory");
    __syncthreads();
    if (t0) {
        GAS unsigned* barg_ = (GAS unsigned*)b.bar; unsigned bx = b.x;
        asm volatile("" : "+s"(barg_), "+s"(bx)); unsigned* bar = (unsigned*)barg_;
        __builtin_amdgcn_s_waitcnt(0);
        unsigned nloc = b.st[0], nx = b.st[1];
        if (nloc == 0u) { xcd_barrier_complete(bar, bx, nloc, nx); b.st[0] = nloc; b.st[1] = nx; }
        const unsigned old = xb_add(&bar[XB_XSUB(bx)], 1u);
        const unsigned gen = old / nloc;
        if (old + 1u == (gen + 1u) * nloc) {
            __builtin_amdgcn_fence(__ATOMIC_RELEASE, "agent");
            asm volatile("s_waitcnt vmcnt(0)" ::: "memory");
            const unsigned og = xb_add(&bar[XB_TOP], 1u);
            const unsigned tg = og / nx;
            if (og + 1u == (tg + 1u) * nx) xb_add(&bar[XB_TOPGEN], 1u);
            else XB_SPIN(xb_ld(&bar[XB_TOPGEN]) == tg, bar);
            __builtin_amdgcn_fence(__ATOMIC_ACQUIRE, "agent");
            xb_add(&bar[XB_XGEN(bx)], 1u);
            asm volatile("s_waitcnt vmcnt(0)" ::: "memory");
        } else {
            XB_SPIN(xb_ld(&bar[XB_XGEN(bx)]) == gen, bar);
            __builtin_amdgcn_fence(__ATOMIC_ACQUIRE, "agent");
            asm volatile("s_waitcnt vmcnt(0)" ::: "memory");
        }
    }
    __syncthreads();
}

namespace att {
typedef float f32x16 __attribute__((ext_vector_type(16)));
typedef short s16x4 __attribute__((ext_vector_type(4)));
typedef LAS const char* lds_cptr;
constexpr int THRL = 8;
constexpr int NEXP1 = 8;
__device__ __forceinline__ int crow(int r, int hi) { return (r & 3) + 8 * (r >> 2) + 4 * hi; }
__device__ __forceinline__ void glds16s(const void* sbase  , unsigned voff  , unsigned lds_dst) { unsigned keep;
    asm volatile("s_mov_b32 %0, m0\n\ts_mov_b32 m0, %3\n\ts_nop 0\n\tglobal_load_lds_dwordx4 %1, %2\n\ts_mov_b32 m0, %0" : "=&s"(keep) : "v"(voff), "s"(sbase), "s"(lds_dst) : "memory"); }
__device__ __forceinline__ void glds16(const void* gsrc, unsigned lds_dst) { unsigned keep;
    asm volatile("s_mov_b32 %0, m0\n\ts_mov_b32 m0, %2\n\ts_nop 0\n\tglobal_load_lds_dwordx4 %1, off\n\ts_mov_b32 m0, %0" : "=&s"(keep) : "v"(gsrc), "s"(lds_dst) : "memory"); }
__device__ __forceinline__ float max3f(float a, float b, float c) { return __builtin_fmaxf(__builtin_fmaxf(a, b), c); }
#define ATT_WAIT_BAR(N) asm volatile("s_nop 15\n\ts_waitcnt vmcnt(" #N ") lgkmcnt(0)\n\ts_barrier" ::: "memory")
#define ATT_SBAR() __builtin_amdgcn_sched_barrier(0)
__device__ __forceinline__ float swap_add(float v) { auto rr = __builtin_amdgcn_permlane32_swap(__float_as_uint(v), __float_as_uint(v), false, false); return __uint_as_float(rr[0]) + __uint_as_float(rr[1]); }
__device__ __forceinline__ float swap_max(float v) { auto rr = __builtin_amdgcn_permlane32_swap(__float_as_uint(v), __float_as_uint(v), false, false); return fmaxf(__uint_as_float(rr[0]), __uint_as_float(rr[1])); }

#define MFMA_FENCE1(a) asm volatile("s_nop 15\n\ts_nop 1" : "+v"(a))
#define MFMA_FENCE2(a, b) asm volatile("s_nop 15\n\ts_nop 1" : "+v"(a), "+v"(b))
template <int ND0> __device__ __forceinline__ void qkt_lds(f32x16& p0, f32x16& p1, lds_cptr kslot, const bf16x8* qr, const f32x16& c0, int r32, int hi) {
    lds_cptr kb = kslot + hi * 1024 + r32 * 16;
    bf16x8 kf[2 * ND0];
#pragma unroll
    for (int d0 = 0; d0 < ND0; ++d0) { kf[2 * d0] = *(const LAS bf16x8*)(kb + d0 * 2048); kf[2 * d0 + 1] = *(const LAS bf16x8*)(kb + d0 * 2048 + 512); }
    ATT_SBAR();
#pragma unroll
    for (int d0 = 0; d0 < ND0; ++d0) {
        if (d0 == 0) { p0 = __builtin_amdgcn_mfma_f32_32x32x16_bf16(kf[0], qr[0], c0, 0, 0, 0); p1 = __builtin_amdgcn_mfma_f32_32x32x16_bf16(kf[1], qr[0], c0, 0, 0, 0); }
        else { p0 = __builtin_amdgcn_mfma_f32_32x32x16_bf16(kf[2 * d0], qr[d0], p0, 0, 0, 0); p1 = __builtin_amdgcn_mfma_f32_32x32x16_bf16(kf[2 * d0 + 1], qr[d0], p1, 0, 0, 0); } }
}
struct VFrag { s16x4 lo[8], hi[8]; };
__device__ __forceinline__ void pv64_read(VFrag& v, int vb) {
#pragma unroll
    for (int d0 = 0; d0 < 2; ++d0)
#pragma unroll
        for (int ks = 0; ks < 4; ++ks) {
            asm volatile("ds_read_b64_tr_b16 %0,%1 offset:%c2" : "=&v"(v.lo[d0 * 4 + ks]) : "v"(vb), "i"(d0 * 4096 + ks * 1024) : "memory");
            asm volatile("ds_read_b64_tr_b16 %0,%1 offset:%c2" : "=&v"(v.hi[d0 * 4 + ks]) : "v"(vb), "i"(d0 * 4096 + ks * 1024 + 512) : "memory"); }
}
#define ATT_PK(k) (bf16x8){lo[k][0], lo[k][1], lo[k][2], lo[k][3], hi[k][0], hi[k][1], hi[k][2], hi[k][3]}
__device__ __forceinline__ void pv64_mma(f32x16* o, VFrag& v, bf16x8 pa0, bf16x8 pa1, bf16x8 pa2, bf16x8 pa3) {
    asm volatile("s_waitcnt lgkmcnt(0)" : "+v"(v.lo[0]), "+v"(v.lo[1]), "+v"(v.lo[2]), "+v"(v.lo[3]), "+v"(v.lo[4]), "+v"(v.lo[5]), "+v"(v.lo[6]), "+v"(v.lo[7]),
                 "+v"(v.hi[0]), "+v"(v.hi[1]), "+v"(v.hi[2]), "+v"(v.hi[3]), "+v"(v.hi[4]), "+v"(v.hi[5]), "+v"(v.hi[6]), "+v"(v.hi[7]) :: "memory");
#pragma unroll
    for (int d0 = 0; d0 < 2; ++d0) { const s16x4* lo = v.lo + 4 * d0; const s16x4* hi = v.hi + 4 * d0;
        o[d0] = __builtin_amdgcn_mfma_f32_32x32x16_bf16(pa0, ATT_PK(0), o[d0], 0, 0, 0);
        o[d0] = __builtin_amdgcn_mfma_f32_32x32x16_bf16(pa1, ATT_PK(1), o[d0], 0, 0, 0);
        o[d0] = __builtin_amdgcn_mfma_f32_32x32x16_bf16(pa2, ATT_PK(2), o[d0], 0, 0, 0);
        o[d0] = __builtin_amdgcn_mfma_f32_32x32x16_bf16(pa3, ATT_PK(3), o[d0], 0, 0, 0); }
}
struct V32 { s16x4 lo[4], hi[4]; };
__device__ __forceinline__ void pv32_read(V32& v, int vb) {
#pragma unroll
    for (int d0 = 0; d0 < 2; ++d0)
#pragma unroll
        for (int ks = 0; ks < 2; ++ks) {
            asm volatile("ds_read_b64_tr_b16 %0,%1 offset:%c2" : "=&v"(v.lo[d0 * 2 + ks]) : "v"(vb), "i"(d0 * 4096 + ks * 1024) : "memory");
            asm volatile("ds_read_b64_tr_b16 %0,%1 offset:%c2" : "=&v"(v.hi[d0 * 2 + ks]) : "v"(vb), "i"(d0 * 4096 + ks * 1024 + 512) : "memory"); }
}
__device__ __forceinline__ void pv32_mma(f32x16* o, V32& v, bf16x8 pa0, bf16x8 pa1) {
    asm volatile("s_waitcnt lgkmcnt(0)" : "+v"(v.lo[0]), "+v"(v.lo[1]), "+v"(v.lo[2]), "+v"(v.lo[3]), "+v"(v.hi[0]), "+v"(v.hi[1]), "+v"(v.hi[2]), "+v"(v.hi[3]) :: "memory");
#pragma unroll
    for (int d0 = 0; d0 < 2; ++d0) {
        o[d0] = __builtin_amdgcn_mfma_f32_32x32x16_bf16(pa0, ((bf16x8){v.lo[2 * d0][0], v.lo[2 * d0][1], v.lo[2 * d0][2], v.lo[2 * d0][3], v.hi[2 * d0][0], v.hi[2 * d0][1], v.hi[2 * d0][2], v.hi[2 * d0][3]}), o[d0], 0, 0, 0);
        o[d0] = __builtin_amdgcn_mfma_f32_32x32x16_bf16(pa1, ((bf16x8){v.lo[2 * d0 + 1][0], v.lo[2 * d0 + 1][1], v.lo[2 * d0 + 1][2], v.lo[2 * d0 + 1][3], v.hi[2 * d0 + 1][0], v.hi[2 * d0 + 1][1], v.hi[2 * d0 + 1][2], v.hi[2 * d0 + 1][3]}), o[d0], 0, 0, 0); }
}
__device__ __forceinline__ void pv32(f32x16* o, int vb, bf16x8 pa0, bf16x8 pa1) {
#pragma unroll
    for (int d0 = 0; d0 < 2; ++d0) { s16x4 lo[2], hi[2];
#pragma unroll
        for (int ks = 0; ks < 2; ++ks) {
            asm volatile("ds_read_b64_tr_b16 %0,%1 offset:%c2" : "=&v"(lo[ks]) : "v"(vb), "i"(d0 * 4096 + ks * 1024) : "memory");
            asm volatile("ds_read_b64_tr_b16 %0,%1 offset:%c2" : "=&v"(hi[ks]) : "v"(vb), "i"(d0 * 4096 + ks * 1024 + 512) : "memory"); }
        asm volatile("s_waitcnt lgkmcnt(0)" ::: "memory"); ATT_SBAR();
        o[d0] = __builtin_amdgcn_mfma_f32_32x32x16_bf16(pa0, ATT_PK(0), o[d0], 0, 0, 0);
        o[d0] = __builtin_amdgcn_mfma_f32_32x32x16_bf16(pa1, ATT_PK(1), o[d0], 0, 0, 0);
#undef ATT_PK
    }
}
__device__ __forceinline__ void cmask(f32x16& p0, f32x16& p1, int jb, int qrel, int hi) {
    const int kb = 64 * jb + 4 * hi;
#pragma unroll
    for (int r = 0; r < 16; ++r) { const int kv = kb + (r & 3) + 8 * (r >> 2); if (kv > qrel) p0[r] = -INFINITY; if (kv + 32 > qrel) p1[r] = -INFINITY; }
}
struct SmState { float mhat, l; f32x16 negm; f32x16 o[2]; };
__device__ __forceinline__ void sm_init(SmState& s) { s.mhat = 0.f; s.l = 0.f; s.negm = f32x16{}; s.o[0] = f32x16{}; s.o[1] = f32x16{}; }
__device__ __forceinline__ bool sm_decide64(SmState& s, f32x16& p0, f32x16& p1, LAS float* wsf, int r32, int hi) {
    float a = max3f(p0[0], p0[1], p1[0]), b = max3f(p0[2], p0[3], p1[1]); a = max3f(a, p1[2], p1[3]);
#pragma unroll
    for (int r = 4; r < 16; r += 4) { a = max3f(a, p0[r], p0[r + 1]); b = max3f(b, p0[r + 2], p0[r + 3]); a = max3f(a, p1[r], p1[r + 1]); b = max3f(b, p1[r + 2], p1[r + 3]); }
    const float rm = swap_max(fmaxf(a, b)); bool resc_ = false;
    if (__any(rm > (float)THRL)) { const float dl = fmaxf(rm, 0.f); s.mhat += dl;
#pragma unroll
        for (int r = 0; r < 16; ++r) { p0[r] -= dl; p1[r] -= dl; s.negm[r] = -s.mhat; }
        const float f = __builtin_amdgcn_exp2f(-dl); s.l *= f; if (hi == 0) wsf[r32] = f;
        resc_ = true; }
#pragma unroll
    for (int r = 0; r < NEXP1; ++r) p0[r] = __builtin_amdgcn_exp2f(p0[r]);
    asm volatile("" : "+v"(p0));
    return resc_;
}
__device__ __forceinline__ void sm_exp64(SmState& s, bool resc, f32x16& p0, f32x16& p1, LAS float* wsf, int hi, u32x4& pw0, u32x4& pw1, u32x4& pw2, u32x4& pw3) {
    if (resc) { asm volatile("s_waitcnt lgkmcnt(0)" ::: "memory"); MFMA_FENCE2(s.o[0], s.o[1]);
#pragma unroll
        for (int d = 0; d < 2; ++d)
#pragma unroll
            for (int r = 0; r < 16; ++r) s.o[d][r] *= wsf[crow(r, hi)];
        asm volatile("s_waitcnt lgkmcnt(0)" ::: "memory"); }
    float sa0 = 0.f, sa1 = 0.f, sb0 = 0.f, sb1 = 0.f;
#pragma unroll
    for (int r = 0; r < 16; r += 2) { if (r >= NEXP1) { p0[r] = __builtin_amdgcn_exp2f(p0[r]); p0[r + 1] = __builtin_amdgcn_exp2f(p0[r + 1]); }
        p1[r] = __builtin_amdgcn_exp2f(p1[r]); p1[r + 1] = __builtin_amdgcn_exp2f(p1[r + 1]);
        sa0 += p0[r]; sa1 += p0[r + 1]; sb0 += p1[r]; sb1 += p1[r + 1]; }
    asm volatile("" : "+v"(sa0), "+v"(sa1), "+v"(sb0), "+v"(sb1));
    s.l += (sa0 + sa1) + (sb0 + sb1);
    pw0 = (u32x4){cvt_pk_bf16(p0[0], p0[1]), cvt_pk_bf16(p0[2], p0[3]), cvt_pk_bf16(p0[4], p0[5]), cvt_pk_bf16(p0[6], p0[7])};
    pw1 = (u32x4){cvt_pk_bf16(p0[8], p0[9]), cvt_pk_bf16(p0[10], p0[11]), cvt_pk_bf16(p0[12], p0[13]), cvt_pk_bf16(p0[14], p0[15])};
    pw2 = (u32x4){cvt_pk_bf16(p1[0], p1[1]), cvt_pk_bf16(p1[2], p1[3]), cvt_pk_bf16(p1[4], p1[5]), cvt_pk_bf16(p1[6], p1[7])};
    pw3 = (u32x4){cvt_pk_bf16(p1[8], p1[9]), cvt_pk_bf16(p1[10], p1[11]), cvt_pk_bf16(p1[12], p1[13]), cvt_pk_bf16(p1[14], p1[15])};
}
__device__ __forceinline__ void sm_step32(SmState& s, f32x16& p0, LAS float* wsf, int r32, int hi, u32x4& pw0, u32x4& pw1) {
    float a = max3f(p0[0], p0[1], p0[2]), b = max3f(p0[3], p0[4], p0[5]);
    a = max3f(a, p0[6], p0[7]); b = max3f(b, p0[8], p0[9]); a = max3f(a, p0[10], p0[11]); b = max3f(b, p0[12], p0[13]); a = max3f(a, p0[14], p0[15]);
    const float rm = swap_max(fmaxf(a, b));
    if (__any(rm > (float)THRL)) { const float dl = fmaxf(rm, 0.f); s.mhat += dl;
#pragma unroll
        for (int r = 0; r < 16; ++r) { p0[r] -= dl; s.negm[r] = -s.mhat; }
        const float f = __builtin_amdgcn_exp2f(-dl); s.l *= f; if (hi == 0) wsf[r32] = f;
        asm volatile("s_waitcnt lgkmcnt(0)" ::: "memory"); MFMA_FENCE2(s.o[0], s.o[1]);
#pragma unroll
        for (int d = 0; d < 2; ++d)
#pragma unroll
            for (int r = 0; r < 16; ++r) s.o[d][r] *= wsf[crow(r, hi)];
        asm volatile("s_waitcnt lgkmcnt(0)" ::: "memory"); }
    float sum = 0.f;
#pragma unroll
    for (int r = 0; r < 16; ++r) { p0[r] = __builtin_amdgcn_exp2f(p0[r]); sum += p0[r]; }
    s.l += sum;
    pw0 = (u32x4){cvt_pk_bf16(p0[0], p0[1]), cvt_pk_bf16(p0[2], p0[3]), cvt_pk_bf16(p0[4], p0[5]), cvt_pk_bf16(p0[6], p0[7])};
    pw1 = (u32x4){cvt_pk_bf16(p0[8], p0[9]), cvt_pk_bf16(p0[10], p0[11]), cvt_pk_bf16(p0[12], p0[13]), cvt_pk_bf16(p0[14], p0[15])};
}
__device__ __forceinline__ float sm_finish(SmState& s, LAS float* wsf, LAS bf16* stg, bf16* orow0, long rstride, int lane, int r32, int hi, float* ssq_row0 = nullptr) {
    MFMA_FENCE2(s.o[0], s.o[1]);
    const float lt = swap_add(s.l);
    if (hi == 0) wsf[32 + r32] = lt;
    asm volatile("s_waitcnt lgkmcnt(0)" ::: "memory");
    float rl[16];
#pragma unroll
    for (int r = 0; r < 16; ++r) rl[r] = wsf[32 + crow(r, hi)];
    asm volatile("s_waitcnt lgkmcnt(0)" : "+v"(rl[0]), "+v"(rl[1]), "+v"(rl[2]), "+v"(rl[3]), "+v"(rl[4]), "+v"(rl[5]), "+v"(rl[6]), "+v"(rl[7]), "+v"(rl[8]), "+v"(rl[9]), "+v"(rl[10]), "+v"(rl[11]), "+v"(rl[12]), "+v"(rl[13]), "+v"(rl[14]), "+v"(rl[15]) :: "memory");
#pragma unroll
    for (int r = 0; r < 16; ++r) { const int orow = crow(r, hi); const float ri = __builtin_amdgcn_rcpf(rl[r]);
#pragma unroll
        for (int d0 = 0; d0 < 2; ++d0) stg[orow * 64 + d0 * 32 + r32] = (bf16)(cvt_pk_bf16(s.o[d0][r] * ri, 0.f) & 0xffffu); }
    asm volatile("s_waitcnt lgkmcnt(0)" ::: "memory");
#pragma unroll
    for (int i = 0; i < 4; ++i) { const int row = i * 8 + (lane >> 3), ch = lane & 7; const u32x4 v = *(const LAS u32x4*)(stg + row * 64 + ch * 8); *(u32x4*)(orow0 + (long)row * rstride + ch * 8) = v;
        if (ssq_row0) { float q = bf_lo(v.x) * bf_lo(v.x) + bf_hi(v.x) * bf_hi(v.x) + bf_lo(v.y) * bf_lo(v.y) + bf_hi(v.y) * bf_hi(v.y) + bf_lo(v.z) * bf_lo(v.z) + bf_hi(v.z) * bf_hi(v.z) + bf_lo(v.w) * bf_lo(v.w) + bf_hi(v.w) * bf_hi(v.w);
            q += swz_xor<1>(q); q += swz_xor<2>(q); q += swz_xor<4>(q); if (ch == 0) ssq_row0[row] = q; } }
    asm volatile("s_waitcnt lgkmcnt(0)" ::: "memory");
    return s.mhat + __builtin_amdgcn_logf(lt);
}

constexpr int L_K = 0, KSLOT = 12288, L_V = 3 * KSLOT, VSLOT = 8192, L_WS = L_V + 3 * VSLOT, L_OST = L_WS + 8 * 256, L_TB = L_OST + 8 * 4096, L_Q = L_TB + (256 + 4096) * 4, L_KM = L_Q + 16, L_END = L_KM + 16 * 64 * 4;
static_assert(L_END <= RING_BYTES, "attention LDS map");

__device__ __forceinline__ int wg_next(unsigned* ctr, LAS unsigned char* shm, int slot_off, int wave) {
    volatile LAS unsigned* slot = (volatile LAS unsigned*)(shm + slot_off);
    asm volatile("s_nop 15\n\ts_waitcnt vmcnt(0) lgkmcnt(0)\n\ts_barrier" ::: "memory");
    if (wave == 0 && lane_id() == 0) slot[0] = __hip_atomic_fetch_add(ctr, 1u, __ATOMIC_RELAXED, __HIP_MEMORY_SCOPE_AGENT);
    asm volatile("s_nop 15\n\ts_waitcnt vmcnt(0) lgkmcnt(0)\n\ts_barrier" ::: "memory");
    const unsigned v = slot[0];
    return (int)__builtin_amdgcn_readfirstlane(v);
}

__device__ __forceinline__ int wg_next8(unsigned* ctr8  , int nloc, int myx, LAS unsigned char* shm, int slot_off, int wave) {
    volatile LAS unsigned* slot = (volatile LAS unsigned*)(shm + slot_off);
    asm volatile("s_nop 15\n\ts_waitcnt vmcnt(0) lgkmcnt(0)\n\ts_barrier" ::: "memory");
    if (wave == 0 && lane_id() == 0) { unsigned r = 0xffffffffu;
        for (int xx = 0; xx < 8; ++xx) { const int x = (myx + xx) & 7; unsigned* c = ctr8 + 64 * x;
            if (__hip_atomic_load(c, __ATOMIC_RELAXED, __HIP_MEMORY_SCOPE_AGENT) >= (unsigned)nloc) continue;
            const unsigned v = __hip_atomic_fetch_add(c, 1u, __ATOMIC_RELAXED, __HIP_MEMORY_SCOPE_AGENT);
            if (v < (unsigned)nloc) { r = ((unsigned)x << 16) | v; break; } }
        slot[0] = r; }
    asm volatile("s_nop 15\n\ts_waitcnt vmcnt(0) lgkmcnt(0)\n\ts_barrier" ::: "memory");
    const unsigned v = slot[0];
    return (int)__builtin_amdgcn_readfirstlane(v);
}

__device__ __forceinline__ void mla_unit(int b, int h, int qb, const bf16* QM, const bf16* PROJ, bf16* OB, float* ssq_mix, LAS unsigned char* shm, const int wid) {
    const int lane = lane_id(), tid = wid * 64 + lane, r32 = lane & 31, hi = lane >> 5; (void)tid;
    const long rowbase = (long)b * SEQ; const int q0 = qb * 256;
    const unsigned lds0 = (unsigned)(uintptr_t)shm;
    LAS float* wsf = (LAS float*)(shm + L_WS) + wid * 64;
    const bf16* Qw = QM + (rowbase + q0 + wid * 32 + r32) * QP;
    bf16x8 qr[6];
#pragma unroll
    for (int d0 = 0; d0 < 4; ++d0) qr[d0] = *(const bf16x8*)(Qw + Q_NOPE + h * 64 + d0 * 16 + hi * 8);
#pragma unroll
    for (int d0 = 0; d0 < 2; ++d0) qr[4 + d0] = *(const bf16x8*)(Qw + Q_ROPE + h * 32 + d0 * 16 + hi * 8);
    asm volatile("" : "+v"(qr[0]), "+v"(qr[1]), "+v"(qr[2]), "+v"(qr[3]), "+v"(qr[4]), "+v"(qr[5]));
    const bf16* ksrc = QM + (rowbase + lane) * QP + Q_KV + h * 128 + wid * 8;
    const bf16* rsrc = PROJ + (rowbase + lane) * PP + C_KR + (wid & 3) * 8;
    const bf16* vsrc = QM + (rowbase + 16 * (wid & 3) + (lane >> 2)) * QP + Q_KV + h * 128 + 64 + (wid >> 2) * 32 + (lane & 3) * 8;
    const unsigned kdst = lds0 + L_K + wid * 1024, rdst = lds0 + L_K + (8 + (wid & 3)) * 1024, vdst = lds0 + L_V + wid * 1024;
    const int vb0 = (int)(lds0 + L_V) + ((lane >> 4) & 1) * 32 + (lane & 3) * 8 + (4 * hi + ((lane & 15) >> 2)) * 64;
    const lds_cptr kbase = (lds_cptr)(shm + L_K);
    const int NT = 4 * qb + 4, qrel = wid * 32 + r32;
    SmState st; sm_init(st);
    const bool halfB = wid >= 4;
#define MLA_K(t, s) do { glds16(ksrc + (long)(t) * 64 * QP, (unsigned)__builtin_amdgcn_readfirstlane(kdst + (s) * KSLOT)); \
        if (wid < 4) glds16(rsrc + (long)(t) * 64 * PP, (unsigned)__builtin_amdgcn_readfirstlane(rdst + (s) * KSLOT)); } while (0)
#define MLA_V(t, s) glds16(vsrc + (long)(t) * 64 * QP, (unsigned)__builtin_amdgcn_readfirstlane(vdst + (s) * VSLOT))
#define MLA_WODD(t) ATT_WAIT_BAR(0)
#define MLA_WEVEN(t) ATT_WAIT_BAR(0)
    f32x16 p0, p1; bool resc = false; u32x4 pw0, pw1, pw2, pw3;
#define ATT_SKIP(t) ((t) >= NT - 4 && 64 * ((t) - (NT - 4)) > 32 * wid + 31)
#define MLA_PART1(t, sl) do { if (ATT_SKIP(t)) resc = false; else { qkt_lds<6>(p0, p1, kbase + (sl) * KSLOT, qr, st.negm, r32, hi); if ((t) >= NT - 4) cmask(p0, p1, (t) - (NT - 4), qrel, hi); resc = sm_decide64(st, p0, p1, wsf, r32, hi); } } while (0)
#define MLA_PART2(t, sl) do { if (!ATT_SKIP(t)) { VFrag vf_; pv64_read(vf_, vb0 + (sl) * VSLOT); sm_exp64(st, resc, p0, p1, wsf, hi, pw0, pw1, pw2, pw3); \
        pv64_mma(st.o, vf_, __builtin_bit_cast(bf16x8, pw0), __builtin_bit_cast(bf16x8, pw1), __builtin_bit_cast(bf16x8, pw2), __builtin_bit_cast(bf16x8, pw3)); } } while (0)
    MLA_K(0, 0); MLA_V(0, 0);
    ATT_WAIT_BAR(0);
    if (!halfB) { int sc = 0;
        for (int t = 0; t < NT; ++t) { const int sn = sc == 2 ? 0 : sc + 1;
            if (t + 1 < NT) { MLA_K(t + 1, sn); MLA_V(t + 1, sn); }
            MLA_PART1(t, sc); MLA_PART2(t, sc); ATT_WAIT_BAR(0);
            sc = sn; }
        ATT_WAIT_BAR(0);
    } else { int sp = 0, sc = 1;
        if (1 < NT) { MLA_K(1, 1); MLA_V(1, 1); }
        MLA_PART1(0, 0); ATT_WAIT_BAR(0);
        for (int t = 1; t < NT; ++t) { const int sn = sc == 2 ? 0 : sc + 1;
            if (t + 1 < NT) { MLA_K(t + 1, sn); MLA_V(t + 1, sn); }
            MLA_PART2(t - 1, sp); MLA_PART1(t, sc); ATT_WAIT_BAR(0);
            sp = sc; sc = sn; }
        MLA_PART2(NT - 1, sp); ATT_WAIT_BAR(0);
    }
#undef MLA_K
#undef MLA_V
#undef MLA_WODD
#undef MLA_WEVEN
#undef MLA_PART1
#undef MLA_PART2
    (void)sm_finish(st, wsf, (LAS bf16*)(shm + L_OST) + wid * 2048, OB + (rowbase + q0 + wid * 32) * DM + O_B + h * 64, DM, lane, r32, hi, ssq_mix + (size_t)h * M + (rowbase + q0 + wid * 32));
}


typedef short v4i16_t __attribute__((ext_vector_type(4)));
__device__ __forceinline__ s16x4 vtr16(lds_cptr p) { return __builtin_bit_cast(s16x4, __builtin_amdgcn_ds_read_tr16_b64_v4i16((LAS v4i16_t*)p)); }
__device__ __forceinline__ float rowmax64(const f32x16& p0, const f32x16& p1) {
    float a = max3f(p0[0], p0[1], p1[0]), b = max3f(p0[2], p0[3], p1[1]); a = max3f(a, p1[2], p1[3]);
#pragma unroll
    for (int r = 4; r < 16; r += 4) { a = max3f(a, p0[r], p0[r + 1]); b = max3f(b, p0[r + 2], p0[r + 3]); a = max3f(a, p1[r], p1[r + 1]); b = max3f(b, p1[r + 2], p1[r + 3]); }
    return swap_max(fmaxf(a, b));
}
#define PINV(x) asm volatile("" : "+v"(x))
#define MF32(a, b, c) __builtin_amdgcn_mfma_f32_32x32x16_bf16(a, b, c, 0, 0, 0)
__device__ __forceinline__ void mla_unit2(int b, int h, int qb, const bf16* QM, const bf16* PROJ, bf16* OB, float* ssq_mix, LAS unsigned char* shm, const int wid) {
    const int lane = lane_id(), r32 = lane & 31, hi = lane >> 5;
    const long rowbase = (long)b * SEQ; const int q0 = qb * 256;
    const unsigned lds0 = (unsigned)(uintptr_t)shm;
    LAS float* wsf = (LAS float*)(shm + L_WS) + wid * 64;
    const bf16* Qw = QM + (rowbase + q0 + wid * 32 + r32) * QP;
    bf16x8 qr[6];
#pragma unroll
    for (int d0 = 0; d0 < 4; ++d0) qr[d0] = *(const bf16x8*)(Qw + Q_NOPE + h * 64 + d0 * 16 + hi * 8);
#pragma unroll
    for (int d0 = 0; d0 < 2; ++d0) qr[4 + d0] = *(const bf16x8*)(Qw + Q_ROPE + h * 32 + d0 * 16 + hi * 8);
    asm volatile("" : "+v"(qr[0]), "+v"(qr[1]), "+v"(qr[2]), "+v"(qr[3]), "+v"(qr[4]), "+v"(qr[5]));
    const bf16* kbase_g = QM + rowbase * QP + Q_KV + h * 128 + wid * 8; const unsigned koff = (unsigned)(lane * QP * 2);
    const bf16* rbase_g = PROJ + rowbase * PP + C_KR + (wid & 3) * 8; const unsigned roff = (unsigned)(lane * PP * 2);
    const bf16* vbase_g = QM + (rowbase + 16 * (wid & 3)) * QP + Q_KV + h * 128 + 64 + (wid >> 2) * 32; const unsigned voff_ = (unsigned)(((lane >> 2) * QP + (lane & 3) * 8) * 2);
    const unsigned kdst = lds0 + L_K + wid * 1024, rdst = lds0 + L_K + (8 + (wid & 3)) * 1024, vdst = lds0 + L_V + wid * 1024;
#define U2_K(t, s) do { glds16s(kbase_g + (long)(t) * 64 * QP, koff, (unsigned)__builtin_amdgcn_readfirstlane(kdst + (s) * KSLOT)); \
        if (wid < 4) glds16s(rbase_g + (long)(t) * 64 * PP, roff, (unsigned)__builtin_amdgcn_readfirstlane(rdst + (s) * KSLOT)); } while (0)
#define U2_V(t, s) glds16s(vbase_g + (long)(t) * 64 * QP, voff_, (unsigned)__builtin_amdgcn_readfirstlane(vdst + (s) * VSLOT))
    const lds_cptr vp0 = (lds_cptr)(shm + L_V) + ((lane >> 4) & 1) * 32 + (lane & 3) * 8 + (4 * hi + ((lane & 15) >> 2)) * 64;
    const lds_cptr kp0 = (lds_cptr)(shm + L_K) + hi * 1024 + r32 * 16;
    const int NT = 4 * qb + 4, qrel = wid * 32 + r32;
    SmState st; sm_init(st); PINV(st.negm);
    bool resc = false;
    f32x16 pA0, pA1, pB0, pB1; bf16x8 kf[8]; s16x4 vlo[8], vhi[8]; u32x4 pw0, pw1, pw2, pw3;
    int sl_prev = 0, sl_cur = 0, sl_next = 1;
#define U2_ROT() do { sl_prev = sl_cur; sl_cur = sl_next; sl_next = (sl_next == 2) ? 0 : sl_next + 1; } while (0)
#define U2_KLOAD2(kp, d0) do { kf[2 * (d0)] = *(const LAS bf16x8*)((kp) + (d0) * 2048); kf[2 * (d0) + 1] = *(const LAS bf16x8*)((kp) + (d0) * 2048 + 512); } while (0)
#define U2_RESC() do { if (resc) { _Pragma("unroll") for (int d_ = 0; d_ < 2; ++d_) _Pragma("unroll") for (int r = 0; r < 16; ++r) st.o[d_][r] *= wsf[crow(r, hi)]; } } while (0)
    U2_K(0, 0); U2_V(0, 0); U2_K(1, 1); U2_K(2, 2); U2_V(1, 1);
    ATT_WAIT_BAR(0);
    { bf16x8 k0[12];
#pragma unroll
      for (int d0 = 0; d0 < 6; ++d0) { k0[2 * d0] = *(const LAS bf16x8*)(kp0 + d0 * 2048); k0[2 * d0 + 1] = *(const LAS bf16x8*)(kp0 + d0 * 2048 + 512); }
      ATT_SBAR();
      pA0 = MF32(k0[0], qr[0], st.negm); pA1 = MF32(k0[1], qr[0], st.negm);
#pragma unroll
      for (int d0 = 1; d0 < 6; ++d0) { pA0 = MF32(k0[2 * d0], qr[d0], pA0); pA1 = MF32(k0[2 * d0 + 1], qr[d0], pA1); } }
    if (NT == 4) cmask(pA0, pA1, 0, qrel, hi);
    { const float rm = rowmax64(pA0, pA1); st.mhat = rm;
#pragma unroll
      for (int r = 0; r < 16; ++r) { pA0[r] = __builtin_amdgcn_exp2f(pA0[r] - rm); pA1[r] = __builtin_amdgcn_exp2f(pA1[r] - rm); st.negm[r] = -rm; } }
    PINV(pA0); PINV(pA1); PINV(st.negm); ATT_SBAR();
    ATT_WAIT_BAR(0);
    U2_ROT();
#pragma unroll
    for (int d0 = 0; d0 < 4; ++d0) U2_KLOAD2(kp0 + sl_cur * KSLOT, d0);
#define U2_PKW(P, i) cvt_pk_bf16(P[i], P[(i) + 1])
#define U2_PAF(k) __builtin_bit_cast(bf16x8, pw##k)
#define U2_VFR(i) (bf16x8){vlo[i][0], vlo[i][1], vlo[i][2], vlo[i][3], vhi[i][0], vhi[i][1], vhi[i][2], vhi[i][3]}
#define U2_VRD(i) do { vlo[i] = vtr16(vp_ + (((i) >> 2) * 4096 + ((i) & 3) * 1024)); vhi[i] = vtr16(vp_ + (((i) >> 2) * 4096 + ((i) & 3) * 1024 + 512)); } while (0)
#define U2_KRD(G, d0) do { if (G) { U2_KLOAD2(kp0 + sl_next * KSLOT, d0); ATT_SBAR(); } } while (0)
#define U2_GAPA(MF, a0, a1, a2, a3, W0, W1, PW) do { MF; sacc += a0; sacc += a1; sacc += a2; sacc += a3; W0; W1; PINV(PW); PINV(sacc); ATT_SBAR(); } while (0)
#define U2_GAPB(MF, X, i) do { MF; X[i] = __builtin_amdgcn_exp2f(X[i]); X[(i) + 1] = __builtin_amdgcn_exp2f(X[(i) + 1]); X[(i) + 2] = __builtin_amdgcn_exp2f(X[(i) + 2]); X[(i) + 3] = __builtin_amdgcn_exp2f(X[(i) + 3]); PINV(X); ATT_SBAR(); } while (0)
#define U2_STEP(C0, C1, P0, P1, t, MASK, GK, GV, GL) do { ATT_SBAR(); \
    if (GK) U2_K((t) + 2, sl_prev); if (GV) U2_V((t) + 1, sl_next); \
    const lds_cptr vp_ = vp0 + sl_prev * VSLOT; \
    float sacc = P0[0] + P0[1]; \
    U2_GAPA(C0 = MF32(kf[0], qr[0], st.negm), P0[2], P0[3], P0[4], P0[5],     pw0[0] = U2_PKW(P0, 0),  pw0[1] = U2_PKW(P0, 2),  pw0); \
    U2_GAPA(C1 = MF32(kf[1], qr[0], st.negm), P0[6], P0[7], P0[8], P0[9],     pw0[2] = U2_PKW(P0, 4),  pw0[3] = U2_PKW(P0, 6),  pw0); \
    U2_GAPA(C0 = MF32(kf[2], qr[1], C0),      P0[10], P0[11], P0[12], P0[13], pw1[0] = U2_PKW(P0, 8),  pw1[1] = U2_PKW(P0, 10), pw1); \
    U2_GAPA(C1 = MF32(kf[3], qr[1], C1),      P0[14], P0[15], P1[0], P1[1],   pw1[2] = U2_PKW(P0, 12), pw1[3] = U2_PKW(P0, 14), pw1); \
    bf16x8 kr_[4]; { const lds_cptr kq_ = kp0 + sl_cur * KSLOT; kr_[0] = *(const LAS bf16x8*)(kq_ + 4 * 2048); kr_[1] = *(const LAS bf16x8*)(kq_ + 4 * 2048 + 512); kr_[2] = *(const LAS bf16x8*)(kq_ + 5 * 2048); kr_[3] = *(const LAS bf16x8*)(kq_ + 5 * 2048 + 512); } ATT_SBAR();     \
    U2_GAPA(C0 = MF32(kf[4], qr[2], C0),      P1[2], P1[3], P1[4], P1[5],     pw2[0] = U2_PKW(P1, 0),  pw2[1] = U2_PKW(P1, 2),  pw2); \
    U2_GAPA(C1 = MF32(kf[5], qr[2], C1),      P1[6], P1[7], P1[8], P1[9],     pw2[2] = U2_PKW(P1, 4),  pw2[3] = U2_PKW(P1, 6),  pw2); \
    U2_GAPA(C0 = MF32(kf[6], qr[3], C0),      P1[10], P1[11], P1[12], P1[13], pw3[0] = U2_PKW(P1, 8),  pw3[1] = U2_PKW(P1, 10), pw3); \
    U2_GAPA(C1 = MF32(kf[7], qr[3], C1),      P1[14], P1[15], 0.f, 0.f,       pw3[2] = U2_PKW(P1, 12), pw3[3] = U2_PKW(P1, 14), pw3); \
    C0 = MF32(kr_[0], qr[4], C0); C1 = MF32(kr_[1], qr[4], C1); C0 = MF32(kr_[2], qr[5], C0); C1 = MF32(kr_[3], qr[5], C1); \
    U2_VRD(0); U2_VRD(4); U2_VRD(1); U2_VRD(5); U2_VRD(2); U2_VRD(6); U2_VRD(3); U2_VRD(7); ATT_SBAR();     \
    st.l += sacc; \
    if (MASK) cmask(C0, C1, (t) - (NT - 4), qrel, hi); \
    { const float rm = rowmax64(C0, C1); resc = false; \
      if (__builtin_expect(__any(rm > (float)THRL), 0)) { const float dl = fmaxf(rm, 0.f); st.mhat += dl; \
          _Pragma("unroll") for (int r = 0; r < 16; ++r) { C0[r] -= dl; C1[r] -= dl; st.negm[r] = -st.mhat; } \
          const float f = __builtin_amdgcn_exp2f(-dl); st.l *= f; if (hi == 0) wsf[r32] = f; resc = true; } } \
    ATT_SBAR(); \
    U2_GAPB(st.o[0] = MF32(U2_PAF(0), U2_VFR(0), st.o[0]), C0, 0); \
    U2_GAPB(st.o[1] = MF32(U2_PAF(0), U2_VFR(4), st.o[1]), C0, 4);  U2_KRD(GL, 0); \
    U2_GAPB(st.o[0] = MF32(U2_PAF(1), U2_VFR(1), st.o[0]), C0, 8); \
    U2_GAPB(st.o[1] = MF32(U2_PAF(1), U2_VFR(5), st.o[1]), C0, 12); U2_KRD(GL, 1); \
    U2_GAPB(st.o[0] = MF32(U2_PAF(2), U2_VFR(2), st.o[0]), C1, 0);  U2_KRD(GL, 2); \
    U2_GAPB(st.o[1] = MF32(U2_PAF(2), U2_VFR(6), st.o[1]), C1, 4);  U2_KRD(GL, 3); \
    U2_GAPB(st.o[0] = MF32(U2_PAF(3), U2_VFR(3), st.o[0]), C1, 8); \
    U2_GAPB(st.o[1] = MF32(U2_PAF(3), U2_VFR(7), st.o[1]), C1, 12); \
    } while (0)
    ATT_WAIT_BAR(0);
    int t = 1;
    for (; t + 1 < NT - 4; t += 2) {
        U2_STEP(pB0, pB1, pA0, pA1, t, false, true, true, true);     ATT_WAIT_BAR(0); U2_RESC(); U2_ROT();
        U2_STEP(pA0, pA1, pB0, pB1, t + 1, false, true, true, true); ATT_WAIT_BAR(0); U2_RESC(); U2_ROT();
    }
    for (; t + 1 < NT; t += 2) {
        U2_STEP(pB0, pB1, pA0, pA1, t, true, (t + 2 < NT), (t + 1 < NT), (t + 1 < NT));         ATT_WAIT_BAR(0); U2_RESC(); U2_ROT();
        U2_STEP(pA0, pA1, pB0, pB1, t + 1, true, (t + 3 < NT), (t + 2 < NT), (t + 2 < NT));     ATT_WAIT_BAR(0); U2_RESC(); U2_ROT();
    }
    U2_STEP(pB0, pB1, pA0, pA1, NT - 1, true, false, false, false); U2_RESC();
    { float sacc = pB0[0] + pB0[1];
#pragma unroll
      for (int r = 2; r < 16; ++r) sacc += pB0[r];
#pragma unroll
      for (int r = 0; r < 16; ++r) sacc += pB1[r];
      st.l += sacc;
      pw0 = (u32x4){U2_PKW(pB0, 0), U2_PKW(pB0, 2), U2_PKW(pB0, 4), U2_PKW(pB0, 6)}; pw1 = (u32x4){U2_PKW(pB0, 8), U2_PKW(pB0, 10), U2_PKW(pB0, 12), U2_PKW(pB0, 14)};
      pw2 = (u32x4){U2_PKW(pB1, 0), U2_PKW(pB1, 2), U2_PKW(pB1, 4), U2_PKW(pB1, 6)}; pw3 = (u32x4){U2_PKW(pB1, 8), U2_PKW(pB1, 10), U2_PKW(pB1, 12), U2_PKW(pB1, 14)};
      const lds_cptr vp_ = vp0 + sl_cur * VSLOT;
#pragma unroll
      for (int i = 0; i < 8; ++i) U2_VRD(i);
      st.o[0] = MF32(U2_PAF(0), U2_VFR(0), st.o[0]); st.o[1] = MF32(U2_PAF(0), U2_VFR(4), st.o[1]); st.o[0] = MF32(U2_PAF(1), U2_VFR(1), st.o[0]); st.o[1] = MF32(U2_PAF(1), U2_VFR(5), st.o[1]);
      st.o[0] = MF32(U2_PAF(2), U2_VFR(2), st.o[0]); st.o[1] = MF32(U2_PAF(2), U2_VFR(6), st.o[1]); st.o[0] = MF32(U2_PAF(3), U2_VFR(3), st.o[0]); st.o[1] = MF32(U2_PAF(3), U2_VFR(7), st.o[1]); }
    ATT_WAIT_BAR(0);
#undef U2_K
#undef U2_V
#undef U2_ROT
#undef U2_KLOAD2
#undef U2_RESC
#undef U2_PKW
#undef U2_PAF
#undef U2_VFR
#undef U2_VRD
#undef U2_KRD
#undef U2_GAPA
#undef U2_GAPB
#undef U2_STEP
    (void)sm_finish(st, wsf, (LAS bf16*)(shm + L_OST) + wid * 2048, OB + (rowbase + q0 + wid * 32) * DM + O_B + h * 64, DM, lane, r32, hi, ssq_mix + (size_t)h * M + (rowbase + q0 + wid * 32));
}

__device__ __forceinline__ void moba_unit(int b, int h, int j, const bf16* PROJ, const float* kmean, const float* tmoba, bf16* OB, float* ssq_mix, LAS unsigned char* shm, const int wid) {
    const int lane = lane_id(), tid = wid * 64 + lane, r32 = lane & 31, hi = lane >> 5;
    const long rowbase = (long)b * SEQ; const int q0 = j * 256;
    const unsigned lds0 = (unsigned)(uintptr_t)shm;
    LAS float* wsf = (LAS float*)(shm + L_WS) + wid * 64;
    LAS float* tb = (LAS float*)(shm + L_TB);
    { float tv[9];
#pragma unroll
      for (int k = 0; k < 9; ++k) { const int i = tid + k * (NWAVES * 64); tv[k] = (i >= 256 && i < 256 + 4096) ? tmoba[h * 4096 + i - 256] : 0.f; }
#pragma unroll
      for (int k = 0; k < 9; ++k) { const int i = tid + k * (NWAVES * 64); if (i < 256 + 4096) tb[i] = tv[k]; } }
    LAS float* kml = (LAS float*)(shm + L_KM);
    for (int i = tid; i < j * 64; i += NWAVES * 64) kml[i] = kmean[((size_t)(b * 16 + (i >> 6)) * 4 + h) * 64 + (i & 63)];
    asm volatile("s_nop 15\n\ts_waitcnt vmcnt(0) lgkmcnt(0)\n\ts_barrier" ::: "memory");
    const float c31 = tb[256 + 4095];
    const bf16* Qw = PROJ + (rowbase + q0 + wid * 32 + r32) * PP + C_QC + h * 64;
    bf16x8 qr[4];
#pragma unroll
    for (int d0 = 0; d0 < 4; ++d0) qr[d0] = *(const bf16x8*)(Qw + d0 * 16 + hi * 8);
    float g1 = -INFINITY, g2 = -INFINITY, g3 = -INFINITY; float gate[16];
#pragma unroll
    for (int blk = 0; blk < 16; ++blk) { float s = -INFINITY;
        if (blk < j) { const LAS float* km = kml + blk * 64 + hi * 8; float a = 0.f;
#pragma unroll
            for (int d0 = 0; d0 < 4; ++d0) { const f32x4 k0 = *(const LAS f32x4*)(km + d0 * 16), k1 = *(const LAS f32x4*)(km + d0 * 16 + 4); const u32x4 q = __builtin_bit_cast(u32x4, qr[d0]);
                a = fmaf(bf_lo(q.x), k0[0], a); a = fmaf(bf_hi(q.x), k0[1], a); a = fmaf(bf_lo(q.y), k0[2], a); a = fmaf(bf_hi(q.y), k0[3], a);
                a = fmaf(bf_lo(q.z), k1[0], a); a = fmaf(bf_hi(q.z), k1[1], a); a = fmaf(bf_lo(q.w), k1[2], a); a = fmaf(bf_hi(q.w), k1[3], a); }
            s = swap_add(a); }
        gate[blk] = s;
        if (s > g1) { g3 = g2; g2 = g1; g1 = s; } else if (s > g2) { g3 = g2; g2 = s; } else if (s > g3) { g3 = s; } }
    unsigned sel = 0u;
#pragma unroll
    for (int blk = 0; blk < 16; ++blk) if (blk < j && gate[blk] >= g3) sel |= 1u << blk;
    const bf16* ksrc = PROJ + (rowbase + lane) * PP + C_KC + h * 64 + wid * 8;
    const bf16* vsrc = PROJ + (rowbase + 16 * (wid & 3) + (lane >> 2)) * PP + C_VC + h * 64 + (wid >> 2) * 32 + (lane & 3) * 8;
    const unsigned kdst = lds0 + L_K + wid * 1024, vdst = lds0 + L_V + wid * 1024;
    const int vb0 = (int)(lds0 + L_V) + ((lane >> 4) & 1) * 32 + (lane & 3) * 8 + (4 * hi + ((lane & 15) >> 2)) * 64;
    const lds_cptr kbase = (lds_cptr)(shm + L_K);
    const int NT = 4 * j + 4, qrel = wid * 32 + r32;
    SmState st; sm_init(st);
    const bool halfB = wid >= 4;
#define MOBA_K(t, s) glds16(ksrc + (long)(t) * 64 * PP, (unsigned)__builtin_amdgcn_readfirstlane(kdst + (s) * KSLOT))
#define MOBA_V(t, s) glds16(vsrc + (long)(t) * 64 * PP, (unsigned)__builtin_amdgcn_readfirstlane(vdst + (s) * VSLOT))
#define MOBA_W(t) ATT_WAIT_BAR(0)
    f32x16 p0, p1; bool resc = false; u32x4 pw0, pw1, pw2, pw3;
#define MOBA_PART1(t, sl) do { if (ATT_SKIP(t)) resc = false; else { const int blk_ = (t) >> 2; const bool on_ = (blk_ == j) || ((sel >> blk_) & 1u); f32x16 c0_; \
        const bool far_ = (q0 - 64 * (t) - 63) >= 1536;     \
        const float cv_ = on_ ? st.negm[0] + (far_ ? c31 : 0.f) : -INFINITY;     \
        _Pragma("unroll") for (int r = 0; r < 16; ++r) c0_[r] = cv_; \
        if (far_) qkt_lds<4>(p0, p1, kbase + (sl) * KSLOT, qr, c0_, r32, hi); \
        else { float tbv_[32];     \
          const LAS float* lb_ = tb + (256 + q0 + qrel - 64 * (t) - 4 * hi - 27 - 32); \
          _Pragma("unroll") for (int r = 0; r < 16; ++r) { const int c_ = (r & 3) + 8 * (r >> 2); tbv_[r] = lb_[32 + 27 - c_]; tbv_[16 + r] = lb_[27 - c_]; } \
          qkt_lds<4>(p0, p1, kbase + (sl) * KSLOT, qr, c0_, r32, hi); \
          if (blk_ == j) cmask(p0, p1, (t) & 3, qrel, hi); \
          _Pragma("unroll") for (int r = 0; r < 16; ++r) { p0[r] += tbv_[r]; p1[r] += tbv_[16 + r]; } } \
        resc = sm_decide64(st, p0, p1, wsf, r32, hi); } } while (0)
#define MOBA_PART2(t, sl) do { if (!ATT_SKIP(t)) { VFrag vf_; pv64_read(vf_, vb0 + (sl) * VSLOT); sm_exp64(st, resc, p0, p1, wsf, hi, pw0, pw1, pw2, pw3); \
        pv64_mma(st.o, vf_, __builtin_bit_cast(bf16x8, pw0), __builtin_bit_cast(bf16x8, pw1), __builtin_bit_cast(bf16x8, pw2), __builtin_bit_cast(bf16x8, pw3)); } } while (0)
    MOBA_K(0, 0); MOBA_V(0, 0);
    ATT_WAIT_BAR(0);
    if (!halfB) { int sc = 0;
        for (int t = 0; t < NT; ++t) { const int sn = sc == 2 ? 0 : sc + 1;
            if (t + 1 < NT) { MOBA_K(t + 1, sn); MOBA_V(t + 1, sn); }
            MOBA_PART1(t, sc); MOBA_PART2(t, sc); ATT_WAIT_BAR(0);
            sc = sn; }
        ATT_WAIT_BAR(0);
    } else { int sp = 0, sc = 1;
        if (1 < NT) { MOBA_K(1, 1); MOBA_V(1, 1); }
        MOBA_PART1(0, 0); ATT_WAIT_BAR(0);
        for (int t = 1; t < NT; ++t) { const int sn = sc == 2 ? 0 : sc + 1;
            if (t + 1 < NT) { MOBA_K(t + 1, sn); MOBA_V(t + 1, sn); }
            MOBA_PART2(t - 1, sp); MOBA_PART1(t, sc); ATT_WAIT_BAR(0);
            sp = sc; sc = sn; }
        MOBA_PART2(NT - 1, sp); ATT_WAIT_BAR(0);
    }
#undef MOBA_K
#undef MOBA_V
#undef MOBA_W
#undef MOBA_PART1
#undef MOBA_PART2
    (void)sm_finish(st, wsf, (LAS bf16*)(shm + L_OST) + wid * 2048, OB + (rowbase + q0 + wid * 32) * DM + O_C + h * 64, DM, lane, r32, hi, ssq_mix + (size_t)(6 + h) * M + (rowbase + q0 + wid * 32));
}

constexpr int D_V = 0, D_WS = 65536, D_OST = D_WS + 8 * 256, D_TB = D_OST + 8 * 4096, D_Q = D_TB + 3 * 6 * 192 * 4, D_END = D_Q + 16;
static_assert(D_END <= RING_BYTES, "dilated LDS map");
__device__ __forceinline__ void dil_task(int p, int b, int h, int r, int m0, const bf16* PROJ, bf16* OPART, float* LSE, LAS unsigned char* shm, int wid, int lane) {
    const int r32 = lane & 31, hi = lane >> 5, sh = 2 * p;
    const long rowbase = (long)b * SEQ;
    const unsigned lds0 = (unsigned)(uintptr_t)shm;
    LAS float* wsf = (LAS float*)(shm + D_WS) + wid * 64;
    const LAS float* tbl = (const LAS float*)(shm + D_TB) + (p * 6 + h) * 192 + 32;
    const unsigned vslot0 = lds0 + D_V + wid * 8192;
    const int tq = r + ((m0 + r32) << sh);
    const bf16* Qw = PROJ + (rowbase + tq) * PP + C_QA + h * 64;
    bf16x8 qr[4];
#pragma unroll
    for (int d0 = 0; d0 < 4; ++d0) qr[d0] = *(const bf16x8*)(Qw + d0 * 16 + hi * 8);
    const int g0 = (4 - (m0 >> 5)) > 0 ? (4 - (m0 >> 5)) : 0;
    bf16x8 kc[4], kn[4];
#define DIL_LOADK(dst, g) do { const int ks_ = m0 - 128 + 32 * (g) + r32; const bf16* kp_ = PROJ + (rowbase + r + ((long)ks_ << sh)) * PP + C_KA + h * 64 + hi * 8; \
        _Pragma("unroll") for (int d0 = 0; d0 < 4; ++d0) dst[d0] = *(const bf16x8*)(kp_ + d0 * 16); } while (0)
#define DIL_LOADV(VD, g) do { _Pragma("unroll") for (int pc = 0; pc < 4; ++pc) { const int dh_ = pc >> 1, rg_ = pc & 1; const int ks_ = m0 - 128 + 32 * (g) + 16 * rg_ + (lane >> 2); \
            VD[pc] = *(const u32x4*)(PROJ + (rowbase + r + ((long)ks_ << sh)) * PP + C_VA + h * 64 + dh_ * 32 + (lane & 3) * 8); } } while (0)
#define DIL_STV(VS, g) do { _Pragma("unroll") for (int pc = 0; pc < 4; ++pc) *(LAS u32x4*)(shm + D_V + wid * 8192 + ((g) & 1) * 2048 + (pc >> 1) * 4096 + (pc & 1) * 1024 + lane * 16) = VS[pc]; } while (0)
    u32x4 vc[4], vn[4], vf[4]; bf16x8 kf[4];
    const int vb0 = (int)vslot0 + ((lane >> 4) & 1) * 32 + (lane & 3) * 8 + (4 * hi + ((lane & 15) >> 2)) * 64;
    SmState st; sm_init(st);
    DIL_LOADV(vc, g0); DIL_LOADK(kc, g0);
    if (g0 + 1 < 5) { DIL_LOADV(vn, g0 + 1); DIL_LOADK(kn, g0 + 1); } else { _Pragma("unroll") for (int d0 = 0; d0 < 4; ++d0) { kn[d0] = kc[d0]; vn[d0] = vc[d0]; } }
    for (int g = g0; g < 5; ++g) {
        if (g + 2 < 5) { DIL_LOADV(vf, g + 2); DIL_LOADK(kf, g + 2); } else { _Pragma("unroll") for (int d0 = 0; d0 < 4; ++d0) { kf[d0] = kn[d0]; vf[d0] = vn[d0]; } }
        DIL_STV(vc, g);
        float tb_[16];
        { const LAS float* lb = tbl + (128 - 32 * g) + r32 - 4 * hi - 27;
#pragma unroll
          for (int rr = 0; rr < 16; ++rr) tb_[rr] = lb[27 - ((rr & 3) + 8 * (rr >> 2))]; }
        ATT_SBAR();
        f32x16 p0;
#pragma unroll
        for (int d0 = 0; d0 < 4; ++d0) p0 = __builtin_amdgcn_mfma_f32_32x32x16_bf16(kc[d0], qr[d0], d0 == 0 ? st.negm : p0, 0, 0, 0);
        MFMA_FENCE1(p0);
        if (g == 0) {
#pragma unroll
            for (int rr = 0; rr < 16; ++rr) if (crow(rr, hi) < r32) p0[rr] = -INFINITY; }
        if (g == 4) {
#pragma unroll
            for (int rr = 0; rr < 16; ++rr) if (crow(rr, hi) > r32) p0[rr] = -INFINITY; }
#pragma unroll
        for (int rr = 0; rr < 16; ++rr) p0[rr] += tb_[rr];
        u32x4 pw0, pw1; sm_step32(st, p0, wsf, r32, hi, pw0, pw1);
        pv32(st.o, vb0 + (g & 1) * 2048, __builtin_bit_cast(bf16x8, pw0), __builtin_bit_cast(bf16x8, pw1));
#pragma unroll
        for (int d0 = 0; d0 < 4; ++d0) { kc[d0] = kn[d0]; kn[d0] = kf[d0]; vc[d0] = vn[d0]; vn[d0] = vf[d0]; }
    }
#undef DIL_LOADV
#undef DIL_LOADK
#undef DIL_STV
    bf16* orow0 = OPART + ((size_t)p * M + rowbase + r + ((long)m0 << sh)) * 384 + h * 64;
    const float lse = sm_finish(st, wsf, (LAS bf16*)(shm + D_OST) + wid * 2048, orow0, (long)384 << sh, lane, r32, hi);
    if (hi == 0) LSE[((size_t)(p * NB + b) * 6 + h) * SEQ + (size_t)r * (SEQ >> sh) + m0 + r32] = lse;
}

constexpr int DU_K = 0, DU_V = 49152, DU_WS = 98304, DU_OST = 0;
static_assert(DU_WS + 8 * 256 == D_TB && DU_V + 6 * 8192 == DU_WS, "dilated unit LDS map");
__device__ __forceinline__ int du_swz(int c) { return (c & 7) ^ ((c & 1) << 3); }
struct DuId { int p, b, h, r, m0u; };
__device__ __forceinline__ DuId du_decode(int id) { DuId d; d.h = id % H_DIL; const int rest = id / H_DIL; d.p = rest >> 7; d.b = (rest >> 4) & 7; const int uu = rest & 15, per = 16 >> (2 * d.p); d.r = uu / per; d.m0u = 256 * (uu % per); return d; }
constexpr int DU_N = 3 * NB * 16 * H_DIL;
struct DuRegs { u32x4 kv[6], vv[6]; bf16x8 qr[4]; };
__device__ __forceinline__ void du_load(DuRegs& R, const DuId& u, const bf16* PROJ, int wid, int lane) {
    const int r32 = lane & 31, hi = lane >> 5, sh = 2 * u.p; const long rowbase = (long)u.b * SEQ;
    const bf16* Qw = PROJ + (rowbase + u.r + ((long)(u.m0u + 32 * wid + r32) << sh)) * PP + C_QA + u.h * 64;
#pragma unroll
    for (int d0 = 0; d0 < 4; ++d0) R.qr[d0] = *(const bf16x8*)(Qw + d0 * 16 + hi * 8);
    const int t = wid * 64 + lane, row8 = t >> 3, c8 = t & 7;
#pragma unroll
    for (int n = 0; n < 6; ++n) { const int ks = u.m0u - 128 + n * 64 + row8;
        const bf16* src = PROJ + (rowbase + u.r + ((long)(ks < 0 ? 0 : ks) << sh)) * PP + u.h * 64 + c8 * 8;
        R.kv[n] = *(const u32x4*)(src + C_KA); R.vv[n] = *(const u32x4*)(src + C_VA); }
}
__device__ __forceinline__ void dil_units(unsigned* qctr, const bf16* PROJ, bf16* OPART, float* LSE, LAS unsigned char* shm, const int wid) {
    const int lane = lane_id(), r32 = lane & 31, hi = lane >> 5;
    const unsigned lds0 = (unsigned)(uintptr_t)shm;
    LAS float* wsf = (LAS float*)(shm + DU_WS) + wid * 64;
    volatile LAS unsigned* slot = (volatile LAS unsigned*)(shm + D_Q);
    int cur = wg_next(qctr, shm, D_Q, wid); if (cur >= DU_N) return;
    int nxt = wg_next(qctr, shm, D_Q, wid);
    DuRegs R; du_load(R, du_decode(cur), PROJ, wid, lane);
    const bool t0 = wid == 0 && lane == 0;
    for (;;) {
        const DuId u = du_decode(cur); const int sh = 2 * u.p; const long rowbase = (long)u.b * SEQ;
        unsigned ahead = 0u; if (t0) ahead = __hip_atomic_fetch_add(qctr, 1u, __ATOMIC_RELAXED, __HIP_MEMORY_SCOPE_AGENT);
        { const int t = wid * 64 + lane, row8 = t >> 3, c8 = t & 7;
#pragma unroll
          for (int n = 0; n < 6; ++n) { const int i = n * 64 + row8, G = i >> 5, kk = i & 31;
              *(LAS u32x4*)(shm + DU_K + G * 4096 + c8 * 512 + ((kk ^ du_swz(c8)) * 16)) = R.kv[n];
              *(LAS u32x4*)(shm + DU_V + (G >> 1) * 8192 + (G & 1) * 2048 + (c8 >> 2) * 4096 + (kk >> 4) * 1024 + (kk & 15) * 64 + (c8 & 3) * 16) = R.vv[n]; } }
        bf16x8 qr[4];
#pragma unroll
        for (int d0 = 0; d0 < 4; ++d0) qr[d0] = R.qr[d0];
        asm volatile("s_nop 15\n\ts_waitcnt lgkmcnt(0)\n\ts_barrier" ::: "memory");
        if (nxt < DU_N) du_load(R, du_decode(nxt), PROJ, wid, lane);
        const LAS float* tbl = (const LAS float*)(shm + D_TB) + (u.p * 6 + u.h) * 192 + 32;
        const int m0 = u.m0u + 32 * wid;
        const int g0 = (4 - (m0 >> 5)) > 0 ? (4 - (m0 >> 5)) : 0;
        const int vbl = (int)(lds0 + DU_V) + ((lane >> 4) & 1) * 32 + (lane & 3) * 8 + (4 * hi + ((lane & 15) >> 2)) * 64;
        SmState st; sm_init(st);
        for (int g = g0; g < 5; ++g) { const int G = wid + g;
            float tb_[16]; bf16x8 kf[4];
            { const LAS float* lb = tbl + (128 - 32 * g) + r32 - 4 * hi - 27;
#pragma unroll
              for (int rr = 0; rr < 16; ++rr) tb_[rr] = lb[27 - ((rr & 3) + 8 * (rr >> 2))]; }
#pragma unroll
            for (int d0 = 0; d0 < 4; ++d0) kf[d0] = *(const LAS bf16x8*)(shm + DU_K + G * 4096 + (2 * d0 + hi) * 512 + ((r32 ^ du_swz(2 * d0 + hi)) * 16));
            ATT_SBAR();
            f32x16 p0;
#pragma unroll
            for (int d0 = 0; d0 < 4; ++d0) p0 = __builtin_amdgcn_mfma_f32_32x32x16_bf16(kf[d0], qr[d0], d0 == 0 ? st.negm : p0, 0, 0, 0);
            V32 vf_; pv32_read(vf_, vbl + (G >> 1) * 8192 + (G & 1) * 2048);
            MFMA_FENCE1(p0);
            if (g == 0) {
#pragma unroll
                for (int rr = 0; rr < 16; ++rr) if (crow(rr, hi) < r32) p0[rr] = -INFINITY; }
            if (g == 4) {
#pragma unroll
                for (int rr = 0; rr < 16; ++rr) if (crow(rr, hi) > r32) p0[rr] = -INFINITY; }
#pragma unroll
            for (int rr = 0; rr < 16; ++rr) p0[rr] += tb_[rr];
            u32x4 pw0, pw1; sm_step32(st, p0, wsf, r32, hi, pw0, pw1);
            pv32_mma(st.o, vf_, __builtin_bit_cast(bf16x8, pw0), __builtin_bit_cast(bf16x8, pw1));
        }
        if (t0) slot[0] = ahead;
        asm volatile("s_nop 15\n\ts_waitcnt lgkmcnt(0)\n\ts_barrier" ::: "memory");
        const int nn = (int)__builtin_amdgcn_readfirstlane(slot[0]);
        bf16* orow0 = OPART + ((size_t)u.p * M + rowbase + u.r + ((long)m0 << sh)) * 384 + u.h * 64;
        const float lse = sm_finish(st, wsf, (LAS bf16*)(shm + DU_OST) + wid * 2048, orow0, (long)384 << sh, lane, r32, hi);
        if (hi == 0) LSE[((size_t)(u.p * NB + u.b) * 6 + u.h) * SEQ + (size_t)u.r * (SEQ >> sh) + m0 + r32] = lse;
        asm volatile("s_nop 15\n\ts_waitcnt lgkmcnt(0)\n\ts_barrier" ::: "memory");
        if (nxt >= DU_N) break;
        cur = nxt; nxt = nn;
    }
}
}

__device__ __forceinline__ int ilv32(int n) { return n < 16 ? 2 * n : 2 * (n - 16) + 1; }
__device__ __forceinline__ void tr_item(const float* W, int N, const float* gain, float cscale, bf16* WT, int ldt, int dcol, int drow, bool il, LAS float* scr, int k0, int n0, int lane) {
    { f32x4 v[8]; float gsc[8];
#pragma unroll
      for (int i = 0; i < 8; ++i) { const int kk = 8 * i + (lane >> 3); v[i] = *(const f32x4*)(W + (size_t)(k0 + kk) * N + n0 + 4 * (lane & 7)); gsc[i] = (gain ? gain[k0 + kk] : 1.0f) * cscale; }
#pragma unroll
      for (int i = 0; i < 8; ++i) { const int kk = 8 * i + (lane >> 3); LAS float* d = scr + kk * 33 + 4 * (lane & 7); d[0] = v[i][0] * gsc[i]; d[1] = v[i][1] * gsc[i]; d[2] = v[i][2] * gsc[i]; d[3] = v[i][3] * gsc[i]; } }
    LDS_WAIT(); asm volatile("" ::: "memory");
    const int c = lane & 7;
#pragma unroll
    for (int j = 0; j < 4; ++j) { const int n = (lane >> 3) + 8 * j; const LAS float* s = scr + (8 * c) * 33 + n;
        u32x4 o; o.x = cvt_pk_bf16(s[0 * 33], s[1 * 33]); o.y = cvt_pk_bf16(s[2 * 33], s[3 * 33]); o.z = cvt_pk_bf16(s[4 * 33], s[5 * 33]); o.w = cvt_pk_bf16(s[6 * 33], s[7 * 33]);
        const int dr = drow + (il ? ilv32(n) : n);
        *(u32x4*)(WT + (size_t)dr * ldt + dcol + k0 + 8 * c) = o; }
    LDS_WAIT(); asm volatile("" ::: "memory");
}
__device__ __forceinline__ void tr_item8(const float* W, int N, float cscale, unsigned char* WT, int ldt, int drow, LAS float* scr, int k0, int n0, int lane) {
    { f32x4 v[8];
#pragma unroll
      for (int i = 0; i < 8; ++i) { const int kk = 8 * i + (lane >> 3); v[i] = *(const f32x4*)(W + (size_t)(k0 + kk) * N + n0 + 4 * (lane & 7)); }
#pragma unroll
      for (int i = 0; i < 8; ++i) { const int kk = 8 * i + (lane >> 3); LAS float* d = scr + kk * 33 + 4 * (lane & 7); d[0] = v[i][0] * cscale; d[1] = v[i][1] * cscale; d[2] = v[i][2] * cscale; d[3] = v[i][3] * cscale; } }
    LDS_WAIT(); asm volatile("" ::: "memory");
    const int c = lane & 7;
#pragma unroll
    for (int j = 0; j < 4; ++j) { const int n = (lane >> 3) + 8 * j; const LAS float* sp = scr + (8 * c) * 33 + n;
        u32x2 o; o.x = pg8::pk4_fp8((f32x4){sp[0 * 33], sp[1 * 33], sp[2 * 33], sp[3 * 33]}); o.y = pg8::pk4_fp8((f32x4){sp[4 * 33], sp[5 * 33], sp[6 * 33], sp[7 * 33]});
        *(u32x2*)(WT + (size_t)(drow + n) * ldt + k0 + 8 * c) = o; }
    LDS_WAIT(); asm volatile("" ::: "memory");
}
__device__ __forceinline__ int t5_bucket(int n) {
    if (n < 16) return n;
    int large = 16 + (int)(log2f((float)n * (1.0f / 16.0f)) * (16.0f / 7.0f));
    return large < 31 ? large : 31;
}

struct Args { const float* in[14]; float* out; unsigned char* ws; int ph_lo, ph_hi, li, pad; };

__global__ void __launch_bounds__(NWAVES * 64, 2) mk_fwd(Args args) {
    extern __shared__ __attribute__((aligned(16))) unsigned char lds_raw[];
    LAS unsigned char* lds0 = (LAS unsigned char*)lds_raw;
    volatile LAS unsigned* MISC = (volatile LAS unsigned*)(lds0 + MISC_OFF);
    const int wave0 = __builtin_amdgcn_readfirstlane((int)threadIdx.x >> 6);
#define PHASE_LOCALS \
    int z_; asm volatile("s_mov_b32 %0, 0" : "=s"(z_)); const int wave = wave0 + z_; \
    GAS unsigned char* wsg_ = (GAS unsigned char*)args.ws; GAS float* outg_ = (GAS float*)args.out; asm volatile("" : "+s"(wsg_), "+s"(outg_));     \
    unsigned char* ws = (unsigned char*)wsg_; const int G = (int)gridDim.x + z_; float* out = (float*)outg_; LAS unsigned char* lds = lds0 + z_; (void)lds; \
    const int bid = (int)blockIdx.x + z_; const int gw = bid * NWAVES + wave, NGW = G * NWAVES, NGT = NGW * 64; (void)bid; \
    unsigned* ctl = (unsigned*)(ws + WS_CTL); float* ssq_all = (float*)(ws + WS_SSQ); const f32x2* rope_cs = (const f32x2*)(ws + WS_ROPE); \
    float* tmoba = (float*)(ws + WS_TMOBA); float* tdil = (float*)(ws + WS_TDIL); float* kmean = (float*)(ws + WS_KMEAN); \
    bf16* XB = (bf16*)(ws + WS_XB); bf16* PROJ = (bf16*)(ws + WS_PROJ); bf16* QM = (bf16*)(ws + WS_QM); bf16* OB = (bf16*)(ws + WS_O); bf16* UB = (bf16*)(ws + WS_U); \
    (void)out; (void)gw; (void)NGW; (void)NGT; (void)ctl; (void)ssq_all; (void)rope_cs; (void)tmoba; (void)tdil; (void)kmean; (void)XB; (void)PROJ; (void)QM; (void)OB; (void)UB
#define LAYER_LOCALS PHASE_LOCALS; const int lz_ = l + z_; unsigned char* wl = ws + WS_W + (size_t)lz_ * W_STRIDE; float* ssq_x = ssq_all; float* ssq_c = ssq_all + (size_t)M * 16; float* ssq_mlp = ssq_all + (size_t)M * 32; \
    (void)wl; (void)ssq_x; (void)ssq_c; (void)ssq_mlp
    unsigned* ctl0 = (unsigned*)(args.ws + WS_CTL);
    for (int u = wave0 * 64 + lane_id(); u < (LDS_BYTES - LDSCTL_OFF) / 4; u += NWAVES * 64) ((LAS unsigned*)(lds0 + LDSCTL_OFF))[u] = 0u;
    __syncthreads();
    XcdBarrier bar; bar.bar = ctl0 + CW_BAR + args.li * XCD_BAR_WORDS; bar.x = 0; bar.st = nullptr;
    if (!MK_PER_PHASE) bar = xcd_barrier_post(ctl0 + CW_BAR + args.li * XCD_BAR_WORDS, MISC + 8, wave0 == 0 && lane_id() == 0);
    const int lo = MK_PER_PHASE ? args.ph_lo : 0, hi = MK_PER_PHASE ? args.ph_hi : N_PHASES;
#define IN(k) (lo <= (k) && (k) < hi)
#define SEAM(k) do { if (IN(k) && IN((k) + 1)) xcd_barrier(bar, wave0 == 0 && lane_id() == 0); } while (0)

    if (IN(0)) {
        PHASE_LOCALS; const float* x_in = args.in[0];
        const int lane = lane_id(), gt = bid * (NWAVES * 64) + wave * 64 + lane;
        LAS float* scr = (LAS float*)(lds + wave * 16384);
        constexpr int I_IN = 16 * 77, I_UQ = 6 * 18, I_UKV = 2 * 24, I_O = 16 * 32, I_UP = 16 * 128, I_DN = 64 * 32, I_L = I_IN + I_UQ + I_UKV + I_O + I_UP + I_DN;
        for (int it = gw; it < DEPTH * I_L; it += NGW) {
            const int l = it / I_L; int r = it % I_L;
            unsigned char* wl = ws + WS_W + (size_t)l * W_STRIDE;
            if (r < I_IN) { const int kb = r / 77, nb = r % 77, n0 = 32 * nb;
                int drow = n0; bool il = false; float sc = 1.0f;
                if (n0 < 384) sc = QS_64;
                else if (n0 == 1664) il = true;
                else if (n0 >= 1696) { drow = n0 + 32; if (n0 < 1952) sc = QS_64; }
                tr_item(args.in[2] + (size_t)l * DM * DIN, DIN, args.in[1] + l * DM, sc, (bf16*)(wl + W_IN), DM, 0, drow, il, scr, 64 * kb, n0, lane); continue; }
            r -= I_IN;
            if (r < I_UQ) { const int kb = r / 18, nb = r % 18, n0 = 32 * nb, h = n0 / 96, rr = n0 % 96;
                const int drow = (rr < 64) ? (Q_NOPE + 64 * h + rr) : (Q_ROPE + 32 * h);
                tr_item(args.in[5] + (size_t)l * 384 * 576, 576, args.in[3] + l * 384, QS_96, (bf16*)(wl + W_MLA), 512, 0, drow, rr == 64, scr, 64 * kb, n0, lane); continue; }
            r -= I_UQ;
            if (r < I_UKV) { const int kb = r / 24, nb = r % 24, n0 = 32 * nb;
                tr_item(args.in[6] + (size_t)l * 128 * 768, 768, args.in[4] + l * 128, 1.0f, (bf16*)(wl + W_MLA), 512, 384, Q_KV + n0, false, scr, 64 * kb, n0, lane); continue; }
            r -= I_UKV;
            if (r < I_O) { const int kb = r / 32, nb = r % 32;
                tr_item(args.in[9] + (size_t)l * DM * DM, DM, args.in[8] + l * DM, 1.0f, (bf16*)(wl + W_O), DM, 0, 32 * nb, false, scr, 64 * kb, 32 * nb, lane); continue; }
            r -= I_O;
            if (r < I_UP) { const int kb = r / 128, nb = r % 128;
                tr_item(args.in[11] + (size_t)l * DM * DFF, DFF, args.in[10] + l * DM, 1.0f, (bf16*)(wl + W_UP), DM, 0, 32 * nb, false, scr, 64 * kb, 32 * nb, lane); continue; }
            r -= I_UP;
            { const int kb = r % 64, nb = r / 64;
#if FP8_DOWN
                tr_item8(args.in[12] + (size_t)l * DFF * DM, DM, 64.0f, (unsigned char*)(wl + W_DOWN), DFF, 32 * nb, scr, 64 * kb, 32 * nb, lane); }
#else
                tr_item(args.in[12] + (size_t)l * DFF * DM, DM, nullptr, 1.0f, (bf16*)(wl + W_DOWN), DFF, 0, 32 * nb, false, scr, 64 * kb, 32 * nb, lane); }
#endif
        }
        for (int it = gt; it < DEPTH * (96 * 128 + 1536 * 64); it += NGT) {
            const int l = it / (96 * 128 + 1536 * 64); int r = it % (96 * 128 + 1536 * 64);
            unsigned char* wl = ws + WS_W + (size_t)l * W_STRIDE;
            if (r < 96 * 128) { const int rr = r / 128, ch = r % 128; const int row = rr < 32 ? 1696 + rr : 2496 + (rr - 32);
                *(u32x4*)((bf16*)(wl + W_IN) + (size_t)row * DM + ch * 8) = (u32x4){0u, 0u, 0u, 0u}; }
            else { r -= 96 * 128; const int row = r / 64, ch = r % 64; const int col = ch * 8;
                const bool data = (row < 576 && col < 384) || (row >= 768 && col >= 384);
                if (!data) *(u32x4*)((bf16*)(wl + W_MLA) + (size_t)row * 512 + col) = (u32x4){0u, 0u, 0u, 0u}; }
        }
        for (int it = gt; it < SEQ * 16; it += NGT) { const int t = it >> 4, i = it & 15;
            const float inv_freq = exp2f(-(float)i * (13.287712379549449f / 16.0f));
            const float ang = (float)t * inv_freq;
            double rev = (double)ang * 0.15915494309189535; rev -= floor(rev); const float rv = (float)rev;
            ((f32x2*)(ws + WS_ROPE))[it] = (f32x2){__builtin_amdgcn_cosf(rv), __builtin_amdgcn_sinf(rv)}; }
        const float* rel_bias = args.in[7];
        for (int it = gt; it < 4 * 4096; it += NGT) { const int h = it >> 12, d = it & 4095; tmoba[it] = rel_bias[t5_bucket(d) * 10 + 6 + h] * LOG2E; }
        for (int it = gt; it < 3 * 6 * 192; it += NGT) { const int p = it / (6 * 192), h = (it / 192) % 6, d = it % 192 - 32; const int dil = p == 0 ? 1 : (p == 1 ? 4 : 16);
            tdil[it] = (d >= 0 && d <= 128) ? rel_bias[t5_bucket(d * dil) * 10 + h] * LOG2E : 0.f; }
        for (int g32 = bid; g32 < M / 32; g32 += G) { const int m0 = g32 * 32 + 4 * wave;
            f32x4 v[4][4]; float s[4];
#pragma unroll
            for (int q = 0; q < 4; ++q) { const f32x4* xr = (const f32x4*)(x_in + (size_t)(m0 + q) * DM) + 2 * lane;
#pragma unroll
                for (int j = 0; j < 2; ++j) { v[q][2 * j] = xr[128 * j]; v[q][2 * j + 1] = xr[128 * j + 1]; } }
#pragma unroll
            for (int q = 0; q < 4; ++q) { const int m = m0 + q;
                s[q] = 0.f;
#pragma unroll
                for (int j = 0; j < 4; ++j) s[q] += (v[q][j][0] * v[q][j][0] + v[q][j][1] * v[q][j][1]) + (v[q][j][2] * v[q][j][2] + v[q][j][3] * v[q][j][3]);
                s[q] = wave_sum(s[q]);
                u32x4* o16 = (u32x4*)(XB + (size_t)m * DM) + lane;
#pragma unroll
                for (int j = 0; j < 2; ++j) { u32x4 w; w.x = cvt_pk_bf16(v[q][2 * j][0], v[q][2 * j][1]); w.y = cvt_pk_bf16(v[q][2 * j][2], v[q][2 * j][3]);
                    w.z = cvt_pk_bf16(v[q][2 * j + 1][0], v[q][2 * j + 1][1]); w.w = cvt_pk_bf16(v[q][2 * j + 1][2], v[q][2 * j + 1][3]); o16[64 * j] = w; } }
            { const int q_ = lane & 3, sl = lane >> 2; const float sv = q_ == 0 ? s[0] : (q_ == 1 ? s[1] : (q_ == 2 ? s[2] : s[3]));
              ssq_all[(size_t)sl * M + m0 + q_] = sl == 0 ? sv : 0.f; }
        }
    }
    SEAM(0);

    for (int l = 0; l < DEPTH; ++l) {
        const int pb = 1 + 7 * l;
        if (pb + 7 <= lo || pb >= hi) continue;

        if (IN(pb + 0)) {
            LAYER_LOCALS;
            pg8::Gemm g{XB, (const bf16*)(wl + W_IN), M, PP, DM, DM}; pg8::StaticOrder S; S.init(M, PP, G, bid);
            pg8::stage_rs<0>((LAS float*)(lds + RS_OFF), ssq_x, S, wave);
            pg8::EpiProj E{PROJ, ssq_x, ssq_c, rope_cs};
            pg8::gemm_phase<pg8::EpiProj>(lds, g, S, E, wave);
        }
        SEAM(pb + 0);
        if (IN(pb + 1)) {
            LAYER_LOCALS;
            pg8::Gemm g{PROJ + C_CQ, (const bf16*)(wl + W_MLA), M, QP, 512, PP}; pg8::MlaOrder S{G == 256 ? bid : (bid == 0 ? 0 : 256)};
            pg8::stage_rs<1>((LAS float*)(lds + RS_OFF), ssq_c, S, wave);
            pg8::EpiMla E{QM, ssq_c, rope_cs};
            pg8::gemm_phase<pg8::EpiMla, false, pg8::MlaOrder>(lds, g, S, E, wave);
            { const int ln = lane_id();
              for (int it = gw; it < NB * 16 * H_MOBA; it += NGW) { const int blk = it >> 2, h = it & 3;
                  const bf16* p = PROJ + ((size_t)blk * 256 + (ln >> 3)) * PP + C_KC + h * 64 + (ln & 7) * 8; float a[8];
#pragma unroll
                  for (int e = 0; e < 8; ++e) a[e] = 0.f;
#pragma unroll 8
                  for (int i = 0; i < 32; ++i) { const u32x4 v = *(const u32x4*)(p + (size_t)i * 8 * PP);
                      a[0] += bf_lo(v.x); a[1] += bf_hi(v.x); a[2] += bf_lo(v.y); a[3] += bf_hi(v.y); a[4] += bf_lo(v.z); a[5] += bf_hi(v.z); a[6] += bf_lo(v.w); a[7] += bf_hi(v.w); }
#pragma unroll
                  for (int e = 0; e < 8; ++e) { a[e] += swz_xor<8>(a[e]); a[e] += swz_xor<16>(a[e]); a[e] = xsum32(a[e]); }
                  if (ln < 8) { float* o = kmean + (size_t)it * 64 + ln * 8;
                      *(f32x4*)o = (f32x4){a[0], a[1], a[2], a[3]} * (1.0f / 256.0f); *(f32x4*)(o + 4) = (f32x4){a[4], a[5], a[6], a[7]} * (1.0f / 256.0f); } } }
        }
        SEAM(pb + 1);
        if (IN(pb + 2)) {
            LAYER_LOCALS;
            const int myx = (int)(xb_xcc_id() & 7u);
            { unsigned* qctr8 = ctl + CW_Q + 64 * (16 + (2 * l + 0) * 8);
              for (;;) { const int r = att::wg_next8(qctr8, (NB * H_MLA / 8) * 16, myx, lds, att::L_Q, wave); if (r < 0) break;
                  const int x = r >> 16, i = r & 0xffff, qb = 15 - i / (NB * H_MLA / 8), bh = (i % (NB * H_MLA / 8)) * 8 + x; att::mla_unit2(bh / H_MLA, bh % H_MLA, qb, QM, PROJ, OB, ssq_c, lds, wave); } }
            { unsigned* qctr8 = ctl + CW_Q + 64 * (16 + (2 * l + 1) * 8);
              for (;;) { const int r = att::wg_next8(qctr8, (NB * H_MOBA / 8) * 16, myx, lds, att::L_Q, wave); if (r < 0) break;
                  const int x = r >> 16, i = r & 0xffff, j = 15 - i / (NB * H_MOBA / 8), bh = (i % (NB * H_MOBA / 8)) * 8 + x; att::moba_unit(bh / H_MOBA, bh % H_MOBA, j, PROJ, kmean, tmoba, OB, ssq_c, lds, wave); } }
            { unsigned* qctr = ctl + CW_Q + 64 * (3 * l + 2);
              asm volatile("s_nop 15\n\ts_waitcnt vmcnt(0) lgkmcnt(0)\n\ts_barrier" ::: "memory");
              { const int t2 = wave * 64 + lane_id(); for (int i = t2; i < 3 * 6 * 192; i += NWAVES * 64) ((LAS float*)(lds + att::D_TB))[i] = tdil[i]; }
              asm volatile("s_nop 15\n\ts_waitcnt vmcnt(0) lgkmcnt(0)\n\ts_barrier" ::: "memory");
              const int ln = lane_id();
              (void)ln; att::dil_units(qctr, PROJ, (bf16*)out, (float*)((unsigned char*)out + 72 * MiB), lds, wave); }
        }
        SEAM(pb + 2);
        if (IN(pb + 3)) {
            LAYER_LOCALS;
            const int lane = lane_id();
            float* rowsc = (float*)(ws + WS_ROWSC);
            for (int m = gw; m < M; m += NGW) {
                float f0[8]; float s0 = 0.f;
                if (lane < 48) {
                    const bf16* op = (const bf16*)out + (size_t)m * 384 + 8 * lane; const float* lp = (const float*)((const unsigned char*)out + 72 * MiB); const int hh_ = lane >> 3, bb_ = m >> 12, tt_ = m & (SEQ - 1);
                    const u32x4 a0 = *(const u32x4*)op, a1 = *(const u32x4*)(op + (size_t)M * 384), a2 = *(const u32x4*)(op + (size_t)2 * M * 384);
                    const float l0 = lp[((size_t)(0 * NB + bb_) * 6 + hh_) * SEQ + tt_],
                                l1 = lp[((size_t)(1 * NB + bb_) * 6 + hh_) * SEQ + (size_t)(tt_ & 3) * (SEQ >> 2) + (tt_ >> 2)],
                                l2 = lp[((size_t)(2 * NB + bb_) * 6 + hh_) * SEQ + (size_t)(tt_ & 15) * (SEQ >> 4) + (tt_ >> 4)]; const float mx = fmaxf(l0, fmaxf(l1, l2));
                    float w0 = exp2f(l0 - mx), w1 = exp2f(l1 - mx), w2 = exp2f(l2 - mx); const float iw = 1.0f / (w0 + w1 + w2); w0 *= iw; w1 *= iw; w2 *= iw;
                    f0[0] = w0 * bf_lo(a0.x) + w1 * bf_lo(a1.x) + w2 * bf_lo(a2.x); f0[1] = w0 * bf_hi(a0.x) + w1 * bf_hi(a1.x) + w2 * bf_hi(a2.x);
                    f0[2] = w0 * bf_lo(a0.y) + w1 * bf_lo(a1.y) + w2 * bf_lo(a2.y); f0[3] = w0 * bf_hi(a0.y) + w1 * bf_hi(a1.y) + w2 * bf_hi(a2.y);
                    f0[4] = w0 * bf_lo(a0.z) + w1 * bf_lo(a1.z) + w2 * bf_lo(a2.z); f0[5] = w0 * bf_hi(a0.z) + w1 * bf_hi(a1.z) + w2 * bf_hi(a2.z);
                    f0[6] = w0 * bf_lo(a0.w) + w1 * bf_lo(a1.w) + w2 * bf_lo(a2.w); f0[7] = w0 * bf_hi(a0.w) + w1 * bf_hi(a1.w) + w2 * bf_hi(a2.w);
                    u32x4 w; w.x = cvt_pk_bf16(f0[0], f0[1]); w.y = cvt_pk_bf16(f0[2], f0[3]); w.z = cvt_pk_bf16(f0[4], f0[5]); w.w = cvt_pk_bf16(f0[6], f0[7]);
                    *((u32x4*)(OB + (size_t)m * DM) + lane) = w;
                    s0 = bf_lo(w.x) * bf_lo(w.x) + bf_hi(w.x) * bf_hi(w.x) + bf_lo(w.y) * bf_lo(w.y) + bf_hi(w.y) * bf_hi(w.y) + bf_lo(w.z) * bf_lo(w.z) + bf_hi(w.z) * bf_hi(w.z) + bf_lo(w.w) * bf_lo(w.w) + bf_hi(w.w) * bf_hi(w.w);
                }
                const float sa = wave_sum(s0);
                if (lane == 0) { float qs[10];
#pragma unroll
                    for (int i = 0; i < 10; ++i) qs[i] = ssq_c[(size_t)i * M + m];
                    const float sb = ((qs[0] + qs[1]) + (qs[2] + qs[3])) + (qs[4] + qs[5]), sc = (qs[6] + qs[7]) + (qs[8] + qs[9]);
                    const float ra = rsqrtf(sa * (1.0f / 384.0f) + EPS), rb_ = rsqrtf(sb * (1.0f / 384.0f) + EPS), rc = rsqrtf(sc * (1.0f / 256.0f) + EPS);
                    *(f32x4*)(rowsc + (size_t)m * 4) = (f32x4){ra / rb_, rb_ / rc, rc, 0.f}; }
            }
        }
        SEAM(pb + 3);
        if (IN(pb + 4)) {
            LAYER_LOCALS;
            pg8::Gemm g{OB, (const bf16*)(wl + W_O), M, DM, DM, DM}; pg8::StaticOrder S; S.init(M, DM, G, bid);
            { const float* rowsc = (const float*)(ws + WS_ROWSC); LAS float* rst = (LAS float*)(lds + RS_OFF); const int t = wave * 64 + lane_id(); pg8::Unit uu;
              for (int i = 0; i < 2 && S.next(i, uu); ++i) if (t < 256) *(LAS f32x4*)(rst + (i * 256 + t) * 4) = *(const f32x4*)(rowsc + (size_t)(uu.pm * 256 + t) * 4);
              asm volatile("s_nop 15\n\ts_waitcnt vmcnt(0) lgkmcnt(0)\n\ts_barrier" ::: "memory"); }
            pg8::EpiRes<true> E{XB, ssq_mlp, 1.0f};
            pg8::gemm_phase<pg8::EpiRes<true>, false, pg8::StaticOrder, true>(lds, g, S, E, wave);
        }
        SEAM(pb + 4);
        if (IN(pb + 5)) {
            LAYER_LOCALS;
            pg8::Gemm g{XB, (const bf16*)(wl + W_UP), M, DFF, DM, DM}; pg8::StaticOrder S; S.init(M, DFF, G, bid);
            pg8::stage_rs<0>((LAS float*)(lds + RS_OFF), ssq_mlp, S, wave);
#if FP8_DOWN
            pg8::EpiUp8 E{(unsigned char*)UB, ssq_mlp};
            pg8::gemm_phase<pg8::EpiUp8>(lds, g, S, E, wave);
#else
            pg8::EpiUp E{UB, ssq_mlp};
            pg8::gemm_phase<pg8::EpiUp>(lds, g, S, E, wave);
#endif
        }
        SEAM(pb + 5);
        if (IN(pb + 6)) {
            LAYER_LOCALS;
            pg8::Gemm g{UB, (const bf16*)(wl + W_DOWN), M, DM, DFF, DFF}; pg8::StaticOrder S; S.init(M, DM, G, bid);
#if FP8_DOWN
            pg8::EpiRes<false> E{XB, ssq_x, 1.0f / 512.0f};
            pg8::gemm_phase<pg8::EpiRes<false>, true>(lds, g, S, E, wave);
#else
            pg8::EpiRes<false> E{XB, ssq_x, 1.0f};
            pg8::gemm_phase<pg8::EpiRes<false>>(lds, g, S, E, wave);
#endif
        }
        SEAM(pb + 6);
    }
    if (IN(29)) {
        PHASE_LOCALS;
        const float* ssq_f = ssq_all; const float* gf = args.in[13];
        const int lane = lane_id();
        for (int m = gw; m < M; m += NGW) {
            const float rs = rsqrtf(ssq16(ssq_f + m, (size_t)M) * (1.0f / DM) + EPS);
#pragma unroll
            for (int j = 0; j < 2; ++j) { const int c = 8 * (lane + 64 * j); const u32x4 v = *(const u32x4*)(XB + (size_t)m * DM + c);
                const f32x4 ga = *(const f32x4*)(gf + c), gb = *(const f32x4*)(gf + c + 4);
                f32x4 oa = (f32x4){bf_lo(v.x), bf_hi(v.x), bf_lo(v.y), bf_hi(v.y)} * rs * ga, ob = (f32x4){bf_lo(v.z), bf_hi(v.z), bf_lo(v.w), bf_hi(v.w)} * rs * gb;
                *(f32x4*)(out + (size_t)m * DM + c) = oa; *(f32x4*)(out + (size_t)m * DM + c + 4) = ob; }
        }
    }
#undef IN
#undef SEAM
}

extern "C" void kernel_launch(void* const* d_in, const int* in_sizes, int n_in, void* d_out, int out_size, void* d_ws, size_t ws_size, hipStream_t stream) {
    static int grid = 0;
    if (grid == 0) {
        if (n_in != 14 || in_sizes[0] != M * DM || out_size != M * DM || ws_size < WS_END) { fprintf(stderr, "kernel_launch: unexpected shapes (n_in %d, in0 %d, out %d, ws %zu); nothing launched\n", n_in, n_in > 0 ? in_sizes[0] : -1, out_size, ws_size); grid = -1; return; }
        int dev = 0, cus = 0, per_cu = 0;
        if (hipGetDevice(&dev) != hipSuccess || hipDeviceGetAttribute(&cus, hipDeviceAttributeMultiprocessorCount, dev) != hipSuccess) { grid = -1; return; }
        if (hipFuncSetAttribute((const void*)mk_fwd, hipFuncAttributeMaxDynamicSharedMemorySize, LDS_BYTES) != hipSuccess) { fprintf(stderr, "kernel_launch: hipFuncSetAttribute failed\n"); grid = -1; return; }
        if (hipOccupancyMaxActiveBlocksPerMultiprocessor(&per_cu, (const void*)mk_fwd, NWAVES * 64, LDS_BYTES) != hipSuccess || per_cu < 1)
            fprintf(stderr, "kernel_launch: note: occupancy query reports %d workgroups per CU\n", per_cu);
        (void)hipGetLastError();
        grid = cus;
    }
    if (grid < 0) return;
    if (hipMemsetAsync((char*)d_ws + WS_CTL, 0, CTL_ZERO_BYTES, stream) != hipSuccess) { fprintf(stderr, "kernel_launch: memset failed\n"); return; }
    Args a{};
    for (int i = 0; i < 14; ++i) a.in[i] = (const float*)d_in[i];
    a.out = (float*)d_out; a.ws = (unsigned char*)d_ws; a.pad = 0;
#if MK_PER_PHASE
    for (int p = 0; p < N_PHASES; ++p) { a.ph_lo = p; a.ph_hi = p + 1; a.li = 0;
        hipLaunchKernelGGL(mk_fwd, dim3(grid), dim3(NWAVES * 64), LDS_BYTES, stream, a); }
#else
    a.ph_lo = 0; a.ph_hi = N_PHASES; a.li = 0;
    hipLaunchKernelGGL(mk_fwd, dim3(grid), dim3(NWAVES * 64), LDS_BYTES, stream, a);
#endif
    const hipError_t le = hipPeekAtLastError();
    if (le != hipSuccess) fprintf(stderr, "kernel_launch: launch failed: %s\n", hipGetErrorName(le));
}
```

```cpp
#include <hip/hip_runtime.h>
#include <cstdio>
#include <cstdint>

#define LAS __attribute__((address_space(3)))
#define GAS __attribute__((address_space(1)))
typedef unsigned short bf16;
typedef short bf16x8 __attribute__((ext_vector_type(8)));
typedef float f32x4 __attribute__((ext_vector_type(4)));
typedef float f32x2 __attribute__((ext_vector_type(2)));
typedef unsigned u32x4 __attribute__((ext_vector_type(4)));
typedef unsigned u32x2 __attribute__((ext_vector_type(2)));
typedef int i32x4 __attribute__((ext_vector_type(4)));
typedef int i32x8 __attribute__((ext_vector_type(8)));

#ifndef FP8_DOWN
#define FP8_DOWN 1
#endif
#ifndef MK_PER_PHASE
#define MK_PER_PHASE 0
#endif

constexpr int NB = 8, SEQ = 4096, DM = 1024, DEPTH = 4, M = NB * SEQ, DFF = 4096;
constexpr int DIN = 2464, PP = 2560  , QP = 1536  ;
constexpr int H_DIL = 6, H_MLA = 6, H_MOBA = 4;
constexpr int C_QA = 0, C_KA = 384, C_VA = 768, C_CQ = 1152, C_CKV = 1536, C_KR = 1664, C_QC = 1728, C_KC = 1984, C_VC = 2240;
constexpr int Q_NOPE = 0, Q_ROPE = 384, Q_KV = 768;
constexpr int O_A = 0, O_B = 384, O_C = 768;
constexpr float EPS = 1e-6f;
constexpr float LOG2E = 1.4426950408889634f;
constexpr float QS_64 = 0.125f * LOG2E;
constexpr float QS_96 = 0.10206207261596575f * LOG2E;

constexpr size_t MiB = 1u << 20;
constexpr size_t WS_CTL = 0, CTL_ZERO_BYTES = 1 * MiB;
constexpr size_t WS_SSQ = 1 * MiB;
constexpr size_t WS_ROPE = 7 * MiB;
constexpr size_t WS_TMOBA = 7 * MiB + 512 * 1024;
constexpr size_t WS_TDIL = WS_TMOBA + 64 * 1024;
constexpr size_t WS_KMEAN = 7 * MiB + 768 * 1024;
constexpr size_t WS_W = 8 * MiB, W_STRIDE = 25 * MiB;
constexpr size_t W_IN = 0, W_MLA = 5 * MiB, W_O = 6 * MiB + 512 * 1024, W_UP = 8 * MiB + 512 * 1024, W_DOWN = 16 * MiB + 512 * 1024;
constexpr size_t WS_ROWSC = 108 * MiB;
constexpr size_t WS_XB = 112 * MiB;
constexpr size_t WS_PROJ = 176 * MiB;
constexpr size_t WS_QM = 336 * MiB;
constexpr size_t WS_O = 432 * MiB;
constexpr size_t WS_U = WS_PROJ;
constexpr size_t WS_END = 496 * MiB;
static_assert(WS_PROJ + (size_t)M * PP * 2 == WS_QM && WS_QM + (size_t)M * QP * 2 == WS_O && WS_U + (size_t)M * DFF * 2 <= WS_O && WS_O + (size_t)M * DM * 2 == WS_END, "ws map");
static_assert(WS_W + DEPTH * W_STRIDE <= WS_XB && WS_XB + (size_t)M * DM * 2 == WS_PROJ, "ws map 2");
constexpr int CW_Q = 1024;
constexpr int CW_BAR = 16384;
constexpr int N_PHASES = 30;

constexpr int RING_BYTES = 131072;
constexpr int LDSCTL_OFF = RING_BYTES, MISC_OFF = LDSCTL_OFF + 320;
constexpr int RS_OFF = 132096;
constexpr int LDS_BYTES = 147456;
constexpr int NWAVES = 8;

#define LDS_WAIT() asm volatile("s_waitcnt lgkmcnt(0)" ::: "memory")
#define VM_WAIT() asm volatile("s_waitcnt vmcnt(0)" ::: "memory")
typedef __bf16 bf16x2_t __attribute__((ext_vector_type(2)));
__device__ __forceinline__ unsigned cvt_pk_bf16(float lo, float hi) { const f32x2 v = {lo, hi}; const bf16x2_t b = __builtin_convertvector(v, bf16x2_t); return __builtin_bit_cast(unsigned, b); }
__device__ __forceinline__ float bf_lo(unsigned u) { return __uint_as_float(u << 16); }
__device__ __forceinline__ float bf_hi(unsigned u) { return __uint_as_float(u & 0xffff0000u); }
__device__ __forceinline__ float dot8(u32x4 a, u32x4 b, float s) {
    s = fmaf(bf_lo(a.x), bf_lo(b.x), s); s = fmaf(bf_hi(a.x), bf_hi(b.x), s);
    s = fmaf(bf_lo(a.y), bf_lo(b.y), s); s = fmaf(bf_hi(a.y), bf_hi(b.y), s);
    s = fmaf(bf_lo(a.z), bf_lo(b.z), s); s = fmaf(bf_hi(a.z), bf_hi(b.z), s);
    s = fmaf(bf_lo(a.w), bf_lo(b.w), s); s = fmaf(bf_hi(a.w), bf_hi(b.w), s);
    return s;
}
__device__ __forceinline__ int lane_id() { int l; asm volatile("v_mbcnt_lo_u32_b32 %0, -1, 0\n\tv_mbcnt_hi_u32_b32 %0, -1, %0" : "=v"(l)); return l; }
template <int X> __device__ __forceinline__ float swz_xor(float v) { return __int_as_float(__builtin_amdgcn_ds_swizzle(__float_as_int(v), (X << 10) | 0x1f)); }
__device__ __forceinline__ float xsum32(float v) { auto rr = __builtin_amdgcn_permlane32_swap(__float_as_uint(v), __float_as_uint(v), false, false); return __uint_as_float(rr[0]) + __uint_as_float(rr[1]); }
__device__ __forceinline__ float wave_sum(float v) { v += swz_xor<1>(v); v += swz_xor<2>(v); v += swz_xor<4>(v); v += swz_xor<8>(v); v += swz_xor<16>(v); return xsum32(v); }
__device__ __forceinline__ float sum4(const f32x4& a) { return (a[0] + a[1]) + (a[2] + a[3]); }
__device__ __forceinline__ float ssq16(const float* p, size_t st) { float a[16];
#pragma unroll
    for (int i = 0; i < 16; ++i) a[i] = p[(size_t)i * st];
    return ((((a[0] + a[1]) + (a[2] + a[3])) + ((a[4] + a[5]) + (a[6] + a[7]))) + (((a[8] + a[9]) + (a[10] + a[11])) + ((a[12] + a[13]) + (a[14] + a[15])))); }

namespace pg8 {
constexpr int BM = 256, BK = 64, HALF = 128, HTB = HALF * BK * 2, STAGE_BYTES = 8 * HTB, NXCD = 8, WGM = 8;
__host__ __device__ __forceinline__ int lds_byte(int r, int c) { const int st = (r >> 4) * 2 + (c >> 5), rr = r & 15, cc = c & 31, ob = rr * 64 + cc * 2; return st * 1024 + (ob ^ (((ob >> 9) & 1) << 5)); }
__host__ __device__ __forceinline__ void stage_rc(int b, int& R, int& C) { const int st = b / 1024, sb = b % 1024, swz = sb ^ (((sb >> 9) & 1) << 5); R = (st >> 1) * 16 + swz / 64; C = (st & 1) * 32 + (swz % 64) / 2; }
__host__ __device__ __forceinline__ int perm32(int rho) { const int n = rho >> 4, i = rho & 15; return 8 * (i >> 2) + 4 * n + (i & 3); }

struct Unit { int pm, pn; };
struct Gemm { const bf16* A; const bf16* Bt; int M, N, K, lda; };

struct StaticOrder {
    int nM, nN, nwg, G, c;
    __host__ __device__ __forceinline__ void init(int M_, int N_, int G_, int c_) { nM = M_ / BM; nN = N_ / BM; nwg = nM * nN; G = G_; c = c_; }
    __host__ __device__ __forceinline__ bool next(int i, Unit& u) const {
        const long L = (long)i * G + c; if (L >= nwg) return false;
        int wgid = (int)L; { const int q = nwg / NXCD, r = nwg % NXCD, xcd = wgid % NXCD, off = wgid / NXCD; wgid = (xcd < r ? xcd * (q + 1) : r * (q + 1) + (xcd - r) * q) + off; }
        const int nig = WGM * nN, gid = wgid / nig, fm = gid * WGM, gsz = (nM - fm) < WGM ? (nM - fm) : WGM;
        u.pm = fm + ((wgid % nig) % gsz); u.pn = (wgid % nig) / gsz; return true;
    }
    __host__ __device__ __forceinline__ void krange(const Unit&, int& kt0, int& ntu, int ntfull) const { kt0 = 0; ntu = ntfull; }
};
struct MlaOrder {
    int c;
    __host__ __device__ __forceinline__ bool next(int i, Unit& u) const { if (i >= 3 || c >= 256) return false; u.pm = c >> 1; const int odd = c & 1; u.pn = odd ? (i == 0 ? 2 : 3 + i) : (i == 2 ? 3 : i); return true; }
    __host__ __device__ __forceinline__ void krange(const Unit& u, int& kt0, int& ntu, int) const { if (u.pn < 3) { kt0 = 0; ntu = 6; } else { kt0 = 6; ntu = 2; } }
};

template <class Epi, bool F8 = false, class Sched = StaticOrder, bool RSC = false>
__device__ __forceinline__ void gemm_phase(LAS unsigned char* lds, const Gemm g, const Sched& S, const Epi& E, const int wid  ) {
    const int lane = lane_id(), tid = wid * 64 + lane;
    const int wr = wid >> 2, wc = wid & 3, fr = lane & 15, fq = lane >> 4;
    constexpr int ESZ = F8 ? 1 : 2;
    const int K = g.K, ntfull = K * ESZ / (BK * 2), lda = g.lda;
    unsigned voffA[2], voffB[2];
#pragma unroll
    for (int i = 0; i < 2; ++i) { int R, C; stage_rc(tid * 16 + i * 8192, R, C); const int Rb = Epi::PERM ? ((R & ~31) + perm32(R & 31)) : R;
        voffA[i] = (unsigned)(R * lda * ESZ + C * 2); voffB[i] = (unsigned)(Rb * K * ESZ + C * 2); }
    const size_t kstep = (size_t)(BK * 2);
    const size_t hstepA = (size_t)HALF * lda * ESZ, hstepB = (size_t)HALF * K * ESZ;
    const size_t tstepA = 2 * hstepA, tstepB = 2 * hstepB;
    const unsigned ldsw = (unsigned)wid * 1024u;
    const int aoff = lds_byte(wr * 64 + fr, fq * 8), boff = lds_byte(wc * 32 + fr, fq * 8);
#define PG8_SA(b, h) (((b) * 2 + (h)) * HTB)
#define PG8_SB(b, h) ((4 + (b) * 2 + (h)) * HTB)
#define PG8_STAGE(bufoff, gbase, voff) do { _Pragma("unroll") for (int _i = 0; _i < 2; ++_i) { unsigned vo_ = (voff)[_i]; asm volatile("" : "+v"(vo_));   \
        __builtin_amdgcn_global_load_lds((const unsigned*)((const char*)(gbase) + vo_), (LAS unsigned*)(lds + (bufoff) + ldsw + _i * 8192), 16, 0, 0); } } while (0)
#define PG8_RD2(p) __builtin_shufflevector(*(const LAS i32x4*)(p), *(const LAS i32x4*)((p) + 1024), 0, 1, 2, 3, 4, 5, 6, 7)
#define PG8_LDA(dst, b, h) do { _Pragma("unroll") for (int m = 0; m < 4; ++m) dst[m] = PG8_RD2(lds + PG8_SA(b, h) + aoff + m * 2048); } while (0)
#define PG8_LDB(dst, b, h) do { _Pragma("unroll") for (int n = 0; n < 2; ++n) dst[n] = PG8_RD2(lds + PG8_SB(b, h) + boff + n * 2048); } while (0)
#define PG8_LO(x) __builtin_bit_cast(bf16x8, __builtin_shufflevector(x, x, 0, 1, 2, 3))
#define PG8_HI(x) __builtin_bit_cast(bf16x8, __builtin_shufflevector(x, x, 4, 5, 6, 7))
#define PG8_MMA(ai, bj, At, Bt) do { __builtin_amdgcn_s_setprio(1); _Pragma("unroll") for (int m = 0; m < 4; ++m) _Pragma("unroll") for (int n = 0; n < 2; ++n) { \
        if constexpr (F8) acc[ai][bj][m][n] = __builtin_amdgcn_mfma_scale_f32_16x16x128_f8f6f4(Bt[n], At[m], acc[ai][bj][m][n], 0, 0, 0, 0x7f7f7f7f, 0, 0x7f7f7f7f); \
        else { acc[ai][bj][m][n] = __builtin_amdgcn_mfma_f32_16x16x32_bf16(PG8_LO(Bt[n]), PG8_LO(At[m]), acc[ai][bj][m][n], 0, 0, 0); \
               acc[ai][bj][m][n] = __builtin_amdgcn_mfma_f32_16x16x32_bf16(PG8_HI(Bt[n]), PG8_HI(At[m]), acc[ai][bj][m][n], 0, 0, 0); } } \
        __builtin_amdgcn_s_setprio(0); } while (0)
#define PG8_WAIT_V(n) asm volatile("s_waitcnt vmcnt(" #n ")" ::: "memory")
#define PG8_WAIT_L(n) asm volatile("s_waitcnt lgkmcnt(" #n ")" ::: "memory")
#define PG8_BAR __builtin_amdgcn_s_barrier()
#define PG8_SCHED __builtin_amdgcn_sched_barrier(0)
    Unit cur, nxt; int ui = 0;
    if (!S.next(0, cur)) return;
    f32x4 acc[2][2][4][2];
#pragma unroll
    for (int a = 0; a < 2; ++a)
#pragma unroll
        for (int b = 0; b < 2; ++b)
#pragma unroll
            for (int m = 0; m < 4; ++m)
#pragma unroll
                for (int n = 0; n < 2; ++n) acc[a][b][m][n] = (f32x4){0.f, 0.f, 0.f, 0.f};
    i32x8 At[4], B0[2], B1[2];
    int kt0, nt; S.krange(cur, kt0, nt, ntfull);
    const char* cA = (const char*)g.A + (size_t)cur.pm * tstepA + (size_t)kt0 * kstep; const char* cB = (const char*)g.Bt + (size_t)cur.pn * tstepB + (size_t)kt0 * kstep;
    PG8_STAGE(PG8_SB(0, 0), cB, voffB); PG8_STAGE(PG8_SB(0, 1), cB + hstepB, voffB); PG8_STAGE(PG8_SA(0, 0), cA, voffA); PG8_STAGE(PG8_SA(0, 1), cA + hstepA, voffA);
    if (wr == 1) PG8_BAR;
    PG8_WAIT_V(2); PG8_BAR;
    PG8_STAGE(PG8_SB(1, 0), cB + kstep, voffB); PG8_STAGE(PG8_SA(1, 0), cA + kstep, voffA); PG8_STAGE(PG8_SB(1, 1), cB + hstepB + kstep, voffB);
    PG8_WAIT_V(6); PG8_BAR;
    for (;;) {
        const bool has_next = S.next(ui + 1, nxt);
        int nkt0 = kt0, nnt = nt; if (has_next) S.krange(nxt, nkt0, nnt, ntfull);
        const char* nA = has_next ? (const char*)g.A + (size_t)nxt.pm * tstepA + (size_t)nkt0 * kstep : cA; const char* nB = has_next ? (const char*)g.Bt + (size_t)nxt.pn * tstepB + (size_t)nkt0 * kstep : cB;
        for (int t = 0; t < nt; t += 2) {
            if constexpr (RSC) { if (t == 6 || t == 12) { const LAS float* rr_ = (const LAS float*)(lds + RS_OFF) + (ui * 256 + wr * 64 + fr) * 4 + (t == 6 ? 0 : 1);
#pragma unroll
                for (int ai = 0; ai < 2; ++ai)
#pragma unroll
                    for (int m = 0; m < 4; ++m) { const float f_ = rr_[(ai * HALF + m * 16) * 4];
#pragma unroll
                        for (int bj = 0; bj < 2; ++bj)
#pragma unroll
                            for (int n = 0; n < 2; ++n) acc[ai][bj][m][n] *= f_; } } }
            const bool last = (t == nt - 2);
            const char* a1 = cA + (size_t)(t + 1) * kstep;
            const char* a2 = last ? nA : cA + (size_t)(t + 2) * kstep; const char* b2 = last ? nB : cB + (size_t)(t + 2) * kstep;
            const char* a3 = a2 + kstep; const char* b3 = b2 + kstep;
            PG8_LDB(B0, 0, 0); PG8_LDB(B1, 0, 1); PG8_SCHED; PG8_LDA(At, 0, 0); PG8_STAGE(PG8_SA(1, 1), a1 + hstepA, voffA);
            PG8_WAIT_V(8); PG8_WAIT_L(0); PG8_BAR; PG8_MMA(0, 0, At, B0); PG8_MMA(0, 1, At, B1); PG8_BAR; PG8_SCHED;
            PG8_LDA(At, 0, 1); PG8_STAGE(PG8_SB(0, 0), b2, voffB); PG8_STAGE(PG8_SB(0, 1), b2 + hstepB, voffB); PG8_STAGE(PG8_SA(0, 0), a2, voffA);
            PG8_WAIT_V(8); PG8_WAIT_L(0); PG8_BAR; PG8_MMA(1, 0, At, B0); PG8_MMA(1, 1, At, B1); PG8_BAR; PG8_SCHED;
            PG8_LDB(B0, 1, 0); PG8_LDB(B1, 1, 1); PG8_SCHED; PG8_LDA(At, 1, 0); PG8_STAGE(PG8_SA(0, 1), a2 + hstepA, voffA);
            PG8_WAIT_V(8); PG8_WAIT_L(0); PG8_BAR; PG8_MMA(0, 0, At, B0); PG8_MMA(0, 1, At, B1); PG8_BAR; PG8_SCHED;
            PG8_LDA(At, 1, 1); PG8_STAGE(PG8_SB(1, 0), b3, voffB); PG8_STAGE(PG8_SB(1, 1), b3 + hstepB, voffB); PG8_STAGE(PG8_SA(1, 0), a3, voffA);
            PG8_WAIT_V(8); PG8_WAIT_L(0); PG8_BAR; PG8_MMA(1, 0, At, B0); PG8_MMA(1, 1, At, B1); PG8_BAR; PG8_SCHED;
        }
        if (wr == 0) PG8_BAR;
        { const int le = lane_id(); E(acc, cur, ui, (const LAS float*)(lds + RS_OFF - 0), wr, wc, le & 15, le >> 4); }
        if (!has_next) break;
#pragma unroll
        for (int a = 0; a < 2; ++a)
#pragma unroll
            for (int b = 0; b < 2; ++b)
#pragma unroll
                for (int m = 0; m < 4; ++m)
#pragma unroll
                    for (int n = 0; n < 2; ++n) acc[a][b][m][n] = (f32x4){0.f, 0.f, 0.f, 0.f};
        cur = nxt; cA = nA; cB = nB; nt = nnt; kt0 = nkt0; ++ui;
        if (wr == 1) PG8_BAR;
    }
    PG8_WAIT_V(0);
    PG8_BAR;
#undef PG8_SA
#undef PG8_SB
#undef PG8_STAGE
#undef PG8_LDA
#undef PG8_LDB
#undef PG8_MMA
#undef PG8_LO
#undef PG8_HI
#undef PG8_RD2
#undef PG8_WAIT_V
#undef PG8_WAIT_L
#undef PG8_BAR
#undef PG8_SCHED
}

template <int MODE, class Sched> __device__ __forceinline__ void stage_rs(LAS float* rst, const float* ssq, const Sched& S, int wave) {
    const int t = wave * 64 + lane_id(), half = t >> 8, row = t & 255;
    f32x4 q[4][4]; int pn_[4]; bool ok[4];
#pragma unroll
    for (int k = 0; k < 4; ++k) { Unit u; ok[k] = S.next(2 * k + half, u); pn_[k] = ok[k] ? u.pn : 0; const int pm = ok[k] ? u.pm : 0;
        const float* p = ssq + (size_t)(pm * BM + row);
#pragma unroll
        for (int j = 0; j < 4; ++j) q[k][j] = (f32x4){p[(size_t)(4 * j) * M], p[(size_t)(4 * j + 1) * M], p[(size_t)(4 * j + 2) * M], p[(size_t)(4 * j + 3) * M]}; }
#pragma unroll
    for (int k = 0; k < 4; ++k) if (ok[k]) { float r;
        if (MODE == 0) r = rsqrtf(((sum4(q[k][0]) + sum4(q[k][1])) + (sum4(q[k][2]) + sum4(q[k][3]))) * (1.0f / DM) + EPS);
        else r = pn_[k] < 3 ? rsqrtf(((sum4(q[k][0]) + sum4(q[k][1])) + sum4(q[k][2])) * (1.0f / 384.0f) + EPS) : rsqrtf(sum4(q[k][3]) * (1.0f / 128.0f) + EPS);
        rst[(2 * k + half) * 256 + row] = r; }
    asm volatile("s_nop 15\n\ts_waitcnt vmcnt(0) lgkmcnt(0)\n\ts_barrier" ::: "memory");
}

__device__ __forceinline__ void rope_consts(float (&crev)[4], int i0) {
#pragma unroll
    for (int p = 0; p < 4; ++p) crev[p] = __builtin_amdgcn_exp2f(-(float)(i0 + p) * (13.287712379549449f / 16.0f)) * 0.15915494309189535f;
}
__device__ __forceinline__ void rope8(f32x4& v0, f32x4& v1, int pos, const float (&crev)[4]) {
    float c[4], sn[4];
#pragma unroll
    for (int p = 0; p < 4; ++p) { float rev = (float)pos * crev[p]; rev = __builtin_amdgcn_fractf(rev); c[p] = __builtin_amdgcn_cosf(rev); sn[p] = __builtin_amdgcn_sinf(rev); }
    f32x4 a, b;
    a[0] = v0[0] * c[0] - v0[1] * sn[0]; a[1] = v0[1] * c[0] + v0[0] * sn[0];
    a[2] = v0[2] * c[1] - v0[3] * sn[1]; a[3] = v0[3] * c[1] + v0[2] * sn[1];
    b[0] = v1[0] * c[2] - v1[1] * sn[2]; b[1] = v1[1] * c[2] + v1[0] * sn[2];
    b[2] = v1[2] * c[3] - v1[3] * sn[3]; b[3] = v1[3] * c[3] + v1[2] * sn[3];
    v0 = a; v1 = b;
}
__device__ __forceinline__ float sumsq8(const f32x4& a, const f32x4& b) { return (a[0] * a[0] + a[1] * a[1]) + (a[2] * a[2] + a[3] * a[3]) + (b[0] * b[0] + b[1] * b[1]) + (b[2] * b[2] + b[3] * b[3]); }
__device__ __forceinline__ u32x4 pack8(const f32x4& a, const f32x4& b) { u32x4 w; w.x = cvt_pk_bf16(a[0], a[1]); w.y = cvt_pk_bf16(a[2], a[3]); w.z = cvt_pk_bf16(b[0], b[1]); w.w = cvt_pk_bf16(b[2], b[3]); return w; }

struct EpiProj {
    static constexpr bool PERM = true;
    bf16* O; const float* ssq_x; float* ssq_c; const f32x2* cs;
    __device__ __forceinline__ void operator()(const f32x4 (&acc)[2][2][4][2], const Unit& u, int ui, const LAS float* rst, int wr, int wc, int fr, int fq) const {
        const int row0 = u.pm * BM + wr * 64 + fr, colb = u.pn * BM + wc * 32 + 8 * fq;
        const bool sp = (u.pn >= 4 && u.pn <= 6);
        float crev[4]; rope_consts(crev, 4 * fq);
#pragma unroll
        for (int ai = 0; ai < 2; ++ai)
#pragma unroll
            for (int m = 0; m < 4; ++m) { const int row = row0 + ai * HALF + m * 16; const float rs = rst[ui * 256 + row - u.pm * BM];
                bf16* rowp = O + (size_t)row * PP + colb;
#pragma unroll
                for (int bj = 0; bj < 2; ++bj) { f32x4 v0 = acc[ai][bj][m][0] * rs, v1 = acc[ai][bj][m][1] * rs;
                    if (sp) {
                        if (u.pn == 6 && bj == 1 && wc == 0) rope8(v0, v1, row & (SEQ - 1), crev);
                        const bool is_cq = (u.pn == 4 && bj == 1) || (u.pn == 5), is_ckv = (u.pn == 6 && bj == 0);
                        if (is_cq || is_ckv) { float s = sumsq8(v0, v1); s += swz_xor<16>(s); s = xsum32(s);
                            const int slot = (is_ckv ? 12 : (u.pn == 4 ? 0 : 4 + 4 * bj)) + wc;
                            if (fq == 0) ssq_c[(size_t)slot * M + row] = s; }
                    }
                    *(u32x4*)(rowp + bj * HALF) = pack8(v0, v1); } }
    }
};
struct EpiMla {
    static constexpr bool PERM = true;
    bf16* O; const float* ssq_c; const f32x2* cs;
    __device__ __forceinline__ void operator()(const f32x4 (&acc)[2][2][4][2], const Unit& u, int ui, const LAS float* rst, int wr, int wc, int fr, int fq) const {
        const int row0 = u.pm * BM + wr * 64 + fr, colb = u.pn * BM + wc * 32 + 8 * fq;
        const bool isq = u.pn < 3;
        float crev[4]; rope_consts(crev, 4 * fq);
#pragma unroll
        for (int ai = 0; ai < 2; ++ai)
#pragma unroll
            for (int m = 0; m < 4; ++m) { const int row = row0 + ai * HALF + m * 16;
                const float rs = rst[ui * 256 + row - u.pm * BM];
                bf16* rowp = O + (size_t)row * QP + colb;
#pragma unroll
                for (int bj = 0; bj < 2; ++bj) { f32x4 v0 = acc[ai][bj][m][0] * rs, v1 = acc[ai][bj][m][1] * rs;
                    if ((u.pn == 1 && bj == 1) || (u.pn == 2 && bj == 0)) rope8(v0, v1, row & (SEQ - 1), crev);
                    *(u32x4*)(rowp + bj * HALF) = pack8(v0, v1); } }
    }
};
template <bool RS> struct EpiRes {
    static constexpr bool PERM = true;
    bf16* xb; float* ssq; float ascale;
    __device__ __forceinline__ void operator()(const f32x4 (&acc)[2][2][4][2], const Unit& u, int ui, const LAS float* rst, int wr, int wc, int fr, int fq) const {
        const int row0 = u.pm * BM + wr * 64 + fr, colb = u.pn * BM + wc * 32 + 8 * fq;
        u32x4 old[2][4][2];
#pragma unroll
        for (int ai = 0; ai < 2; ++ai)
#pragma unroll
            for (int m = 0; m < 4; ++m)
#pragma unroll
                for (int bj = 0; bj < 2; ++bj) old[ai][m][bj] = *(const u32x4*)(xb + (size_t)(row0 + ai * HALF + m * 16) * DM + colb + bj * HALF);
#pragma unroll
        for (int ai = 0; ai < 2; ++ai)
#pragma unroll
            for (int m = 0; m < 4; ++m) { const int row = row0 + ai * HALF + m * 16; bf16* rowp = xb + (size_t)row * DM + colb; float s = 0.f;
                const float asc = RS ? ascale * rst[(ui * 256 + row - u.pm * BM) * 4 + 2] : ascale;
#pragma unroll
                for (int bj = 0; bj < 2; ++bj) { const u32x4 o4 = old[ai][m][bj];
                    const f32x4 v0 = acc[ai][bj][m][0] * asc + (f32x4){bf_lo(o4.x), bf_hi(o4.x), bf_lo(o4.y), bf_hi(o4.y)}, v1 = acc[ai][bj][m][1] * asc + (f32x4){bf_lo(o4.z), bf_hi(o4.z), bf_lo(o4.w), bf_hi(o4.w)};
                    s += sumsq8(v0, v1); *(u32x4*)(rowp + bj * HALF) = pack8(v0, v1); }
                s += swz_xor<16>(s); s = xsum32(s);
                if (fq == 0) ssq[(size_t)(u.pn * 4 + wc) * M + row] = s; }
    }
};
struct EpiUp {
    static constexpr bool PERM = true;
    bf16* O; const float* ssq;
    __device__ __forceinline__ void operator()(const f32x4 (&acc)[2][2][4][2], const Unit& u, int ui, const LAS float* rst, int wr, int wc, int fr, int fq) const {
        const int row0 = u.pm * BM + wr * 64 + fr, colb = u.pn * BM + wc * 32 + 8 * fq;
#pragma unroll
        for (int ai = 0; ai < 2; ++ai)
#pragma unroll
            for (int m = 0; m < 4; ++m) { const int row = row0 + ai * HALF + m * 16; const float rs = rst[ui * 256 + row - u.pm * BM];
                bf16* rowp = O + (size_t)row * DFF + colb;
#pragma unroll
                for (int bj = 0; bj < 2; ++bj) { f32x4 v0 = acc[ai][bj][m][0] * rs, v1 = acc[ai][bj][m][1] * rs;
#pragma unroll
                    for (int e = 0; e < 4; ++e) { const float a = fmaxf(v0[e], 0.f), b = fmaxf(v1[e], 0.f); v0[e] = a * a; v1[e] = b * b; }
                    *(u32x4*)(rowp + bj * HALF) = pack8(v0, v1); } }
    }
};
__device__ __forceinline__ unsigned pk4_fp8(const f32x4& v) { unsigned w = 0u; w = __builtin_amdgcn_cvt_pk_fp8_f32(v[0], v[1], w, false); w = __builtin_amdgcn_cvt_pk_fp8_f32(v[2], v[3], w, true); return w; }
struct EpiUp8 {
    static constexpr bool PERM = true;
    unsigned char* O; const float* ssq;
    __device__ __forceinline__ void operator()(const f32x4 (&acc)[2][2][4][2], const Unit& u, int ui, const LAS float* rst, int wr, int wc, int fr, int fq) const {
        const int row0 = u.pm * BM + wr * 64 + fr, colb = u.pn * BM + wc * 32 + 8 * fq;
#pragma unroll
        for (int ai = 0; ai < 2; ++ai)
#pragma unroll
            for (int m = 0; m < 4; ++m) { const int row = row0 + ai * HALF + m * 16; const float rs = rst[ui * 256 + row - u.pm * BM];
                unsigned char* rowp = O + (size_t)row * DFF + colb;
                u32x2 w[2];
#pragma unroll
                for (int bj = 0; bj < 2; ++bj) { f32x4 v0 = acc[ai][bj][m][0] * rs, v1 = acc[ai][bj][m][1] * rs;
#pragma unroll
                    for (int e = 0; e < 4; ++e) { const float a = fmaxf(v0[e], 0.f), b = fmaxf(v1[e], 0.f); v0[e] = fminf(a * a * 8.0f, 448.0f); v1[e] = fminf(b * b * 8.0f, 448.0f); }
                    w[bj].x = pk4_fp8(v0); w[bj].y = pk4_fp8(v1); }
                { auto sx = __builtin_amdgcn_permlane16_swap(w[0].x, w[1].x, false, false); auto sy = __builtin_amdgcn_permlane16_swap(w[0].y, w[1].y, false, false);
                  const u32x4 o = {sx[0], sy[0], sx[1], sy[1]};
                  *(u32x4*)(rowp + ((fq & 1) ? HALF - 8 : 0)) = o; } }
    }
};
}

#define XB_TMO      128
#define XB_XCNT(j)  (256  + 64 * (j))
#define XB_XSUB(j)  (1280 + 64 * (j))
#define XB_XGEN(j)  (2304 + 64 * (j))
#define XB_TOP      3328
#define XB_TOPGEN   3392
#define XCD_BAR_WORDS 3456
#define XB_SPIN_CAP (1u << 18)
__device__ __forceinline__ unsigned xb_ld(unsigned* p)              { return __hip_atomic_load(p, __ATOMIC_RELAXED, __HIP_MEMORY_SCOPE_AGENT); }
__device__ __forceinline__ unsigned xb_add(unsigned* p, unsigned v) { return __hip_atomic_fetch_add(p, v, __ATOMIC_RELAXED, __HIP_MEMORY_SCOPE_AGENT); }
__device__ __forceinline__ unsigned xb_xcc_id() { return (unsigned)__builtin_amdgcn_s_getreg((3 << 11) | 20) & 0xFu; }
#define XB_SPIN(cond, bar) do { unsigned _sp = 0; while (cond) { __builtin_amdgcn_s_sleep(1); \
    if ((++_sp & 255u) == 0u) { if (xb_ld(&(bar)[XB_TMO])) break; if (_sp > XB_SPIN_CAP) { atomicAdd(&(bar)[XB_TMO], 1u); break; } } } } while (0)
struct XcdBarrier { unsigned* bar; unsigned x; volatile LAS unsigned* st; };
__device__ __forceinline__ XcdBarrier xcd_barrier_post(unsigned* bar, volatile LAS unsigned* st, bool t0  ) {
    XcdBarrier b; b.bar = bar; b.x = xb_xcc_id(); b.st = st;
    if (t0) (void)xb_add(&bar[XB_XCNT(b.x)], 1u);
    return b;
}
__device__ __forceinline__ void xcd_barrier_complete(unsigned* bar, unsigned x, unsigned& nloc, unsigned& nx) {
    const unsigned G = gridDim.x * gridDim.y * gridDim.z;
    unsigned sum, cnt, mine, sp = 0u;
    for (;;) {
        sum = 0u; cnt = 0u; mine = 0u;
#pragma unroll
        for (unsigned j = 0; j < 16; ++j) { const unsigned c = xb_ld(&bar[XB_XCNT(j)]); sum += c; cnt += (c > 0u) ? 1u : 0u; mine = (j == x) ? c : mine; }
        if (sum == G) break;
        __builtin_amdgcn_s_sleep(1);
        if ((++sp & 255u) == 0u) { if (xb_ld(&bar[XB_TMO])) break; if (sp > XB_SPIN_CAP) { atomicAdd(&bar[XB_TMO], 1u); break; } }
    }
    nloc = mine > 0u ? mine : 1u; nx = cnt > 0u ? cnt : 1u;
}
__device__ __forceinline__ void xcd_barrier(const XcdBarrier& b, bool t0  ) {
    asm volatile("s_waitcnt vmcnt(0)" ::: "memory");
    __syncthreads();
    if (t0) {
        GAS unsigned* barg_ = (GAS unsigned*)b.bar; unsigned bx = b.x;
        asm volatile("" : "+s"(barg_), "+s"(bx)); unsigned* bar = (unsigned*)barg_;
        __builtin_amdgcn_s_waitcnt(0);
        unsigned nloc = b.st[0], nx = b.st[1];
        if (nloc == 0u) { xcd_barrier_complete(bar, bx, nloc, nx); b.st[0] = nloc; b.st[1] = nx; }
        const unsigned old = xb_add(&bar[XB_XSUB(bx)], 1u);
        const unsigned gen = old / nloc;
        if (old + 1u == (gen + 1u) * nloc) {
            __builtin_amdgcn_fence(__ATOMIC_RELEASE, "agent");
            asm volatile("s_waitcnt vmcnt(0)" ::: "memory");
            const unsigned og = xb_add(&bar[XB_TOP], 1u);
            const unsigned tg = og / nx;
            if (og + 1u == (tg + 1u) * nx) xb_add(&bar[XB_TOPGEN], 1u);
            else XB_SPIN(xb_ld(&bar[XB_TOPGEN]) == tg, bar);
            __builtin_amdgcn_fence(__ATOMIC_ACQUIRE, "agent");
            xb_add(&bar[XB_XGEN(bx)], 1u);
            asm volatile("s_waitcnt vmcnt(0)" ::: "memory");
        } else {
            XB_SPIN(xb_ld(&bar[XB_XGEN(bx)]) == gen, bar);
            __builtin_amdgcn_fence(__ATOMIC_ACQUIRE, "agent");
            asm volatile("s_waitcnt vmcnt(0)" ::: "memory");
        }
    }
    __syncthreads();
}

namespace att {
typedef float f32x16 __attribute__((ext_vector_type(16)));
typedef short s16x4 __attribute__((ext_vector_type(4)));
typedef LAS const char* lds_cptr;
constexpr int THRL = 8;
constexpr int NEXP1 = 8;
__device__ __forceinline__ int crow(int r, int hi) { return (r & 3) + 8 * (r >> 2) + 4 * hi; }
__device__ __forceinline__ void glds16s(const void* sbase  , unsigned voff  , unsigned lds_dst) { unsigned keep;
    asm volatile("s_mov_b32 %0, m0\n\ts_mov_b32 m0, %3\n\ts_nop 0\n\tglobal_load_lds_dwordx4 %1, %2\n\ts_mov_b32 m0, %0" : "=&s"(keep) : "v"(voff), "s"(sbase), "s"(lds_dst) : "memory"); }
__device__ __forceinline__ void glds16(const void* gsrc, unsigned lds_dst) { unsigned keep;
    asm volatile("s_mov_b32 %0, m0\n\ts_mov_b32 m0, %2\n\ts_nop 0\n\tglobal_load_lds_dwordx4 %1, off\n\ts_mov_b32 m0, %0" : "=&s"(keep) : "v"(gsrc), "s"(lds_dst) : "memory"); }
__device__ __forceinline__ float max3f(float a, float b, float c) { return __builtin_fmaxf(__builtin_fmaxf(a, b), c); }
#define ATT_WAIT_BAR(N) asm volatile("s_nop 15\n\ts_waitcnt vmcnt(" #N ") lgkmcnt(0)\n\ts_barrier" ::: "memory")
#define ATT_SBAR() __builtin_amdgcn_sched_barrier(0)
__device__ __forceinline__ float swap_add(float v) { auto rr = __builtin_amdgcn_permlane32_swap(__float_as_uint(v), __float_as_uint(v), false, false); return __uint_as_float(rr[0]) + __uint_as_float(rr[1]); }
__device__ __forceinline__ float swap_max(float v) { auto rr = __builtin_amdgcn_permlane32_swap(__float_as_uint(v), __float_as_uint(v), false, false); return fmaxf(__uint_as_float(rr[0]), __uint_as_float(rr[1])); }

#define MFMA_FENCE1(a) asm volatile("s_nop 15\n\ts_nop 1" : "+v"(a))
#define MFMA_FENCE2(a, b) asm volatile("s_nop 15\n\ts_nop 1" : "+v"(a), "+v"(b))
template <int ND0> __device__ __forceinline__ void qkt_lds(f32x16& p0, f32x16& p1, lds_cptr kslot, const bf16x8* qr, const f32x16& c0, int r32, int hi) {
    lds_cptr kb = kslot + hi * 1024 + r32 * 16;
    bf16x8 kf[2 * ND0];
#pragma unroll
    for (int d0 = 0; d0 < ND0; ++d0) { kf[2 * d0] = *(const LAS bf16x8*)(kb + d0 * 2048); kf[2 * d0 + 1] = *(const LAS bf16x8*)(kb + d0 * 2048 + 512); }
    ATT_SBAR();
#pragma unroll
    for (int d0 = 0; d0 < ND0; ++d0) {
        if (d0 == 0) { p0 = __builtin_amdgcn_mfma_f32_32x32x16_bf16(kf[0], qr[0], c0, 0, 0, 0); p1 = __builtin_amdgcn_mfma_f32_32x32x16_bf16(kf[1], qr[0], c0, 0, 0, 0); }
        else { p0 = __builtin_amdgcn_mfma_f32_32x32x16_bf16(kf[2 * d0], qr[d0], p0, 0, 0, 0); p1 = __builtin_amdgcn_mfma_f32_32x32x16_bf16(kf[2 * d0 + 1], qr[d0], p1, 0, 0, 0); } }
}
struct VFrag { s16x4 lo[8], hi[8]; };
__device__ __forceinline__ void pv64_read(VFrag& v, int vb) {
#pragma unroll
    for (int d0 = 0; d0 < 2; ++d0)
#pragma unroll
        for (int ks = 0; ks < 4; ++ks) {
            asm volatile("ds_read_b64_tr_b16 %0,%1 offset:%c2" : "=&v"(v.lo[d0 * 4 + ks]) : "v"(vb), "i"(d0 * 4096 + ks * 1024) : "memory");
            asm volatile("ds_read_b64_tr_b16 %0,%1 offset:%c2" : "=&v"(v.hi[d0 * 4 + ks]) : "v"(vb), "i"(d0 * 4096 + ks * 1024 + 512) : "memory"); }
}
#define ATT_PK(k) (bf16x8){lo[k][0], lo[k][1], lo[k][2], lo[k][3], hi[k][0], hi[k][1], hi[k][2], hi[k][3]}
__device__ __forceinline__ void pv64_mma(f32x16* o, VFrag& v, bf16x8 pa0, bf16x8 pa1, bf16x8 pa2, bf16x8 pa3) {
    asm volatile("s_waitcnt lgkmcnt(0)" : "+v"(v.lo[0]), "+v"(v.lo[1]), "+v"(v.lo[2]), "+v"(v.lo[3]), "+v"(v.lo[4]), "+v"(v.lo[5]), "+v"(v.lo[6]), "+v"(v.lo[7]),
                 "+v"(v.hi[0]), "+v"(v.hi[1]), "+v"(v.hi[2]), "+v"(v.hi[3]), "+v"(v.hi[4]), "+v"(v.hi[5]), "+v"(v.hi[6]), "+v"(v.hi[7]) :: "memory");
#pragma unroll
    for (int d0 = 0; d0 < 2; ++d0) { const s16x4* lo = v.lo + 4 * d0; const s16x4* hi = v.hi + 4 * d0;
        o[d0] = __builtin_amdgcn_mfma_f32_32x32x16_bf16(pa0, ATT_PK(0), o[d0], 0, 0, 0);
        o[d0] = __builtin_amdgcn_mfma_f32_32x32x16_bf16(pa1, ATT_PK(1), o[d0], 0, 0, 0);
        o[d0] = __builtin_amdgcn_mfma_f32_32x32x16_bf16(pa2, ATT_PK(2), o[d0], 0, 0, 0);
        o[d0] = __builtin_amdgcn_mfma_f32_32x32x16_bf16(pa3, ATT_PK(3), o[d0], 0, 0, 0); }
}
struct V32 { s16x4 lo[4], hi[4]; };
__device__ __forceinline__ void pv32_read(V32& v, int vb) {
#pragma unroll
    for (int d0 = 0; d0 < 2; ++d0)
#pragma unroll
        for (int ks = 0; ks < 2; ++ks) {
            asm volatile("ds_read_b64_tr_b16 %0,%1 offset:%c2" : "=&v"(v.lo[d0 * 2 + ks]) : "v"(vb), "i"(d0 * 4096 + ks * 1024) : "memory");
            asm volatile("ds_read_b64_tr_b16 %0,%1 offset:%c2" : "=&v"(v.hi[d0 * 2 + ks]) : "v"(vb), "i"(d0 * 4096 + ks * 1024 + 512) : "memory"); }
}
__device__ __forceinline__ void pv32_mma(f32x16* o, V32& v, bf16x8 pa0, bf16x8 pa1) {
    asm volatile("s_waitcnt lgkmcnt(0)" : "+v"(v.lo[0]), "+v"(v.lo[1]), "+v"(v.lo[2]), "+v"(v.lo[3]), "+v"(v.hi[0]), "+v"(v.hi[1]), "+v"(v.hi[2]), "+v"(v.hi[3]) :: "memory");
#pragma unroll
    for (int d0 = 0; d0 < 2; ++d0) {
        o[d0] = __builtin_amdgcn_mfma_f32_32x32x16_bf16(pa0, ((bf16x8){v.lo[2 * d0][0], v.lo[2 * d0][1], v.lo[2 * d0][2], v.lo[2 * d0][3], v.hi[2 * d0][0], v.hi[2 * d0][1], v.hi[2 * d0][2], v.hi[2 * d0][3]}), o[d0], 0, 0, 0);
        o[d0] = __builtin_amdgcn_mfma_f32_32x32x16_bf16(pa1, ((bf16x8){v.lo[2 * d0 + 1][0], v.lo[2 * d0 + 1][1], v.lo[2 * d0 + 1][2], v.lo[2 * d0 + 1][3], v.hi[2 * d0 + 1][0], v.hi[2 * d0 + 1][1], v.hi[2 * d0 + 1][2], v.hi[2 * d0 + 1][3]}), o[d0], 0, 0, 0); }
}
__device__ __forceinline__ void pv32(f32x16* o, int vb, bf16x8 pa0, bf16x8 pa1) {
#pragma unroll
    for (int d0 = 0; d0 < 2; ++d0) { s16x4 lo[2], hi[2];
#pragma unroll
        for (int ks = 0; ks < 2; ++ks) {
            asm volatile("ds_read_b64_tr_b16 %0,%1 offset:%c2" : "=&v"(lo[ks]) : "v"(vb), "i"(d0 * 4096 + ks * 1024) : "memory");
            asm volatile("ds_read_b64_tr_b16 %0,%1 offset:%c2" : "=&v"(hi[ks]) : "v"(vb), "i"(d0 * 4096 + ks * 1024 + 512) : "memory"); }
        asm volatile("s_waitcnt lgkmcnt(0)" ::: "memory"); ATT_SBAR();
        o[d0] = __builtin_amdgcn_mfma_f32_32x32x16_bf16(pa0, ATT_PK(0), o[d0], 0, 0, 0);
        o[d0] = __builtin_amdgcn_mfma_f32_32x32x16_bf16(pa1, ATT_PK(1), o[d0], 0, 0, 0);
#undef ATT_PK
    }
}
__device__ __forceinline__ void cmask(f32x16& p0, f32x16& p1, int jb, int qrel, int hi) {
    const int kb = 64 * jb + 4 * hi;
#pragma unroll
    for (int r = 0; r < 16; ++r) { const int kv = kb + (r & 3) + 8 * (r >> 2); if (kv > qrel) p0[r] = -INFINITY; if (kv + 32 > qrel) p1[r] = -INFINITY; }
}
struct SmState { float mhat, l; f32x16 negm; f32x16 o[2]; };
__device__ __forceinline__ void sm_init(SmState& s) { s.mhat = 0.f; s.l = 0.f; s.negm = f32x16{}; s.o[0] = f32x16{}; s.o[1] = f32x16{}; }
__device__ __forceinline__ bool sm_decide64(SmState& s, f32x16& p0, f32x16& p1, LAS float* wsf, int r32, int hi) {
    float a = max3f(p0[0], p0[1], p1[0]), b = max3f(p0[2], p0[3], p1[1]); a = max3f(a, p1[2], p1[3]);
#pragma unroll
    for (int r = 4; r < 16; r += 4) { a = max3f(a, p0[r], p0[r + 1]); b = max3f(b, p0[r + 2], p0[r + 3]); a = max3f(a, p1[r], p1[r + 1]); b = max3f(b, p1[r + 2], p1[r + 3]); }
    const float rm = swap_max(fmaxf(a, b)); bool resc_ = false;
    if (__any(rm > (float)THRL)) { const float dl = fmaxf(rm, 0.f); s.mhat += dl;
#pragma unroll
        for (int r = 0; r < 16; ++r) { p0[r] -= dl; p1[r] -= dl; s.negm[r] = -s.mhat; }
        const float f = __builtin_amdgcn_exp2f(-dl); s.l *= f; if (hi == 0) wsf[r32] = f;
        resc_ = true; }
#pragma unroll
    for (int r = 0; r < NEXP1; ++r) p0[r] = __builtin_amdgcn_exp2f(p0[r]);
    asm volatile("" : "+v"(p0));
    return resc_;
}
__device__ __forceinline__ void sm_exp64(SmState& s, bool resc, f32x16& p0, f32x16& p1, LAS float* wsf, int hi, u32x4& pw0, u32x4& pw1, u32x4& pw2, u32x4& pw3) {
    if (resc) { asm volatile("s_waitcnt lgkmcnt(0)" ::: "memory"); MFMA_FENCE2(s.o[0], s.o[1]);
#pragma unroll
        for (int d = 0; d < 2; ++d)
#pragma unroll
            for (int r = 0; r < 16; ++r) s.o[d][r] *= wsf[crow(r, hi)];
        asm volatile("s_waitcnt lgkmcnt(0)" ::: "memory"); }
    float sa0 = 0.f, sa1 = 0.f, sb0 = 0.f, sb1 = 0.f;
#pragma unroll
    for (int r = 0; r < 16; r += 2) { if (r >= NEXP1) { p0[r] = __builtin_amdgcn_exp2f(p0[r]); p0[r + 1] = __builtin_amdgcn_exp2f(p0[r + 1]); }
        p1[r] = __builtin_amdgcn_exp2f(p1[r]); p1[r + 1] = __builtin_amdgcn_exp2f(p1[r + 1]);
        sa0 += p0[r]; sa1 += p0[r + 1]; sb0 += p1[r]; sb1 += p1[r + 1]; }
    asm volatile("" : "+v"(sa0), "+v"(sa1), "+v"(sb0), "+v"(sb1));
    s.l += (sa0 + sa1) + (sb0 + sb1);
    pw0 = (u32x4){cvt_pk_bf16(p0[0], p0[1]), cvt_pk_bf16(p0[2], p0[3]), cvt_pk_bf16(p0[4], p0[5]), cvt_pk_bf16(p0[6], p0[7])};
    pw1 = (u32x4){cvt_pk_bf16(p0[8], p0[9]), cvt_pk_bf16(p0[10], p0[11]), cvt_pk_bf16(p0[12], p0[13]), cvt_pk_bf16(p0[14], p0[15])};
    pw2 = (u32x4){cvt_pk_bf16(p1[0], p1[1]), cvt_pk_bf16(p1[2], p1[3]), cvt_pk_bf16(p1[4], p1[5]), cvt_pk_bf16(p1[6], p1[7])};
    pw3 = (u32x4){cvt_pk_bf16(p1[8], p1[9]), cvt_pk_bf16(p1[10], p1[11]), cvt_pk_bf16(p1[12], p1[13]), cvt_pk_bf16(p1[14], p1[15])};
}
__device__ __forceinline__ void sm_step32(SmState& s, f32x16& p0, LAS float* wsf, int r32, int hi, u32x4& pw0, u32x4& pw1) {
    float a = max3f(p0[0], p0[1], p0[2]), b = max3f(p0[3], p0[4], p0[5]);
    a = max3f(a, p0[6], p0[7]); b = max3f(b, p0[8], p0[9]); a = max3f(a, p0[10], p0[11]); b = max3f(b, p0[12], p0[13]); a = max3f(a, p0[14], p0[15]);
    const float rm = swap_max(fmaxf(a, b));
    if (__any(rm > (float)THRL)) { const float dl = fmaxf(rm, 0.f); s.mhat += dl;
#pragma unroll
        for (int r = 0; r < 16; ++r) { p0[r] -= dl; s.negm[r] = -s.mhat; }
        const float f = __builtin_amdgcn_exp2f(-dl); s.l *= f; if (hi == 0) wsf[r32] = f;
        asm volatile("s_waitcnt lgkmcnt(0)" ::: "memory"); MFMA_FENCE2(s.o[0], s.o[1]);
#pragma unroll
        for (int d = 0; d < 2; ++d)
#pragma unroll
            for (int r = 0; r < 16; ++r) s.o[d][r] *= wsf[crow(r, hi)];
        asm volatile("s_waitcnt lgkmcnt(0)" ::: "memory"); }
    float sum = 0.f;
#pragma unroll
    for (int r = 0; r < 16; ++r) { p0[r] = __builtin_amdgcn_exp2f(p0[r]); sum += p0[r]; }
    s.l += sum;
    pw0 = (u32x4){cvt_pk_bf16(p0[0], p0[1]), cvt_pk_bf16(p0[2], p0[3]), cvt_pk_bf16(p0[4], p0[5]), cvt_pk_bf16(p0[6], p0[7])};
    pw1 = (u32x4){cvt_pk_bf16(p0[8], p0[9]), cvt_pk_bf16(p0[10], p0[11]), cvt_pk_bf16(p0[12], p0[13]), cvt_pk_bf16(p0[14], p0[15])};
}
__device__ __forceinline__ float sm_finish(SmState& s, LAS float* wsf, LAS bf16* stg, bf16* orow0, long rstride, int lane, int r32, int hi, float* ssq_row0 = nullptr) {
    MFMA_FENCE2(s.o[0], s.o[1]);
    const float lt = swap_add(s.l);
    if (hi == 0) wsf[32 + r32] = lt;
    asm volatile("s_waitcnt lgkmcnt(0)" ::: "memory");
    float rl[16];
#pragma unroll
    for (int r = 0; r < 16; ++r) rl[r] = wsf[32 + crow(r, hi)];
    asm volatile("s_waitcnt lgkmcnt(0)" : "+v"(rl[0]), "+v"(rl[1]), "+v"(rl[2]), "+v"(rl[3]), "+v"(rl[4]), "+v"(rl[5]), "+v"(rl[6]), "+v"(rl[7]), "+v"(rl[8]), "+v"(rl[9]), "+v"(rl[10]), "+v"(rl[11]), "+v"(rl[12]), "+v"(rl[13]), "+v"(rl[14]), "+v"(rl[15]) :: "memory");
#pragma unroll
    for (int r = 0; r < 16; ++r) { const int orow = crow(r, hi); const float ri = __builtin_amdgcn_rcpf(rl[r]);
#pragma unroll
        for (int d0 = 0; d0 < 2; ++d0) stg[orow * 64 + d0 * 32 + r32] = (bf16)(cvt_pk_bf16(s.o[d0][r] * ri, 0.f) & 0xffffu); }
    asm volatile("s_waitcnt lgkmcnt(0)" ::: "memory");
#pragma unroll
    for (int i = 0; i < 4; ++i) { const int row = i * 8 + (lane >> 3), ch = lane & 7; const u32x4 v = *(const LAS u32x4*)(stg + row * 64 + ch * 8); *(u32x4*)(orow0 + (long)row * rstride + ch * 8) = v;
        if (ssq_row0) { float q = bf_lo(v.x) * bf_lo(v.x) + bf_hi(v.x) * bf_hi(v.x) + bf_lo(v.y) * bf_lo(v.y) + bf_hi(v.y) * bf_hi(v.y) + bf_lo(v.z) * bf_lo(v.z) + bf_hi(v.z) * bf_hi(v.z) + bf_lo(v.w) * bf_lo(v.w) + bf_hi(v.w) * bf_hi(v.w);
            q += swz_xor<1>(q); q += swz_xor<2>(q); q += swz_xor<4>(q); if (ch == 0) ssq_row0[row] = q; } }
    asm volatile("s_waitcnt lgkmcnt(0)" ::: "memory");
    return s.mhat + __builtin_amdgcn_logf(lt);
}

constexpr int L_K = 0, KSLOT = 12288, L_V = 3 * KSLOT, VSLOT = 8192, L_WS = L_V + 3 * VSLOT, L_OST = L_WS + 8 * 256, L_TB = L_OST + 8 * 4096, L_Q = L_TB + (256 + 4096) * 4, L_KM = L_Q + 16, L_END = L_KM + 16 * 64 * 4;
static_assert(L_END <= RING_BYTES, "attention LDS map");

__device__ __forceinline__ int wg_next(unsigned* ctr, LAS unsigned char* shm, int slot_off, int wave) {
    volatile LAS unsigned* slot = (volatile LAS unsigned*)(shm + slot_off);
    asm volatile("s_nop 15\n\ts_waitcnt vmcnt(0) lgkmcnt(0)\n\ts_barrier" ::: "memory");
    if (wave == 0 && lane_id() == 0) slot[0] = __hip_atomic_fetch_add(ctr, 1u, __ATOMIC_RELAXED, __HIP_MEMORY_SCOPE_AGENT);
    asm volatile("s_nop 15\n\ts_waitcnt vmcnt(0) lgkmcnt(0)\n\ts_barrier" ::: "memory");
    const unsigned v = slot[0];
    return (int)__builtin_amdgcn_readfirstlane(v);
}

__device__ __forceinline__ unsigned q8_take(unsigned* ctr8, int nloc, int myx) { unsigned r = 0xffffffffu;
    for (int xx = 0; xx < 8; ++xx) { const int x = (myx + xx) & 7; unsigned* c = ctr8 + 64 * x;
        if (__hip_atomic_load(c, __ATOMIC_RELAXED, __HIP_MEMORY_SCOPE_AGENT) >= (unsigned)nloc) continue;
        const unsigned v = __hip_atomic_fetch_add(c, 1u, __ATOMIC_RELAXED, __HIP_MEMORY_SCOPE_AGENT);
        if (v < (unsigned)nloc) { r = ((unsigned)x << 16) | v; break; } }
    return r; }
__device__ __forceinline__ int wg_next8(unsigned* ctr8  , int nloc, int myx, LAS unsigned char* shm, int slot_off, int wave) {
    volatile LAS unsigned* slot = (volatile LAS unsigned*)(shm + slot_off);
    asm volatile("s_nop 15\n\ts_waitcnt vmcnt(0) lgkmcnt(0)\n\ts_barrier" ::: "memory");
    if (wave == 0 && lane_id() == 0) { unsigned r = 0xffffffffu;
        for (int xx = 0; xx < 8; ++xx) { const int x = (myx + xx) & 7; unsigned* c = ctr8 + 64 * x;
            if (__hip_atomic_load(c, __ATOMIC_RELAXED, __HIP_MEMORY_SCOPE_AGENT) >= (unsigned)nloc) continue;
            const unsigned v = __hip_atomic_fetch_add(c, 1u, __ATOMIC_RELAXED, __HIP_MEMORY_SCOPE_AGENT);
            if (v < (unsigned)nloc) { r = ((unsigned)x << 16) | v; break; } }
        slot[0] = r; }
    asm volatile("s_nop 15\n\ts_waitcnt vmcnt(0) lgkmcnt(0)\n\ts_barrier" ::: "memory");
    const unsigned v = slot[0];
    return (int)__builtin_amdgcn_readfirstlane(v);
}

__device__ __forceinline__ void mla_unit(int b, int h, int qb, const bf16* QM, const bf16* PROJ, bf16* OB, float* ssq_mix, LAS unsigned char* shm, const int wid) {
    const int lane = lane_id(), tid = wid * 64 + lane, r32 = lane & 31, hi = lane >> 5; (void)tid;
    const long rowbase = (long)b * SEQ; const int q0 = qb * 256;
    const unsigned lds0 = (unsigned)(uintptr_t)shm;
    LAS float* wsf = (LAS float*)(shm + L_WS) + wid * 64;
    const bf16* Qw = QM + (rowbase + q0 + wid * 32 + r32) * QP;
    bf16x8 qr[6];
#pragma unroll
    for (int d0 = 0; d0 < 4; ++d0) qr[d0] = *(const bf16x8*)(Qw + Q_NOPE + h * 64 + d0 * 16 + hi * 8);
#pragma unroll
    for (int d0 = 0; d0 < 2; ++d0) qr[4 + d0] = *(const bf16x8*)(Qw + Q_ROPE + h * 32 + d0 * 16 + hi * 8);
    asm volatile("" : "+v"(qr[0]), "+v"(qr[1]), "+v"(qr[2]), "+v"(qr[3]), "+v"(qr[4]), "+v"(qr[5]));
    const bf16* ksrc = QM + (rowbase + lane) * QP + Q_KV + h * 128 + wid * 8;
    const bf16* rsrc = PROJ + (rowbase + lane) * PP + C_KR + (wid & 3) * 8;
    const bf16* vsrc = QM + (rowbase + 16 * (wid & 3) + (lane >> 2)) * QP + Q_KV + h * 128 + 64 + (wid >> 2) * 32 + (lane & 3) * 8;
    const unsigned kdst = lds0 + L_K + wid * 1024, rdst = lds0 + L_K + (8 + (wid & 3)) * 1024, vdst = lds0 + L_V + wid * 1024;
    const int vb0 = (int)(lds0 + L_V) + ((lane >> 4) & 1) * 32 + (lane & 3) * 8 + (4 * hi + ((lane & 15) >> 2)) * 64;
    const lds_cptr kbase = (lds_cptr)(shm + L_K);
    const int NT = 4 * qb + 4, qrel = wid * 32 + r32;
    SmState st; sm_init(st);
    const bool halfB = wid >= 4;
#define MLA_K(t, s) do { glds16(ksrc + (long)(t) * 64 * QP, (unsigned)__builtin_amdgcn_readfirstlane(kdst + (s) * KSLOT)); \
        if (wid < 4) glds16(rsrc + (long)(t) * 64 * PP, (unsigned)__builtin_amdgcn_readfirstlane(rdst + (s) * KSLOT)); } while (0)
#define MLA_V(t, s) glds16(vsrc + (long)(t) * 64 * QP, (unsigned)__builtin_amdgcn_readfirstlane(vdst + (s) * VSLOT))
#define MLA_WODD(t) ATT_WAIT_BAR(0)
#define MLA_WEVEN(t) ATT_WAIT_BAR(0)
    f32x16 p0, p1; bool resc = false; u32x4 pw0, pw1, pw2, pw3;
#define ATT_SKIP(t) ((t) >= NT - 4 && 64 * ((t) - (NT - 4)) > 32 * wid + 31)
#define MLA_PART1(t, sl) do { if (ATT_SKIP(t)) resc = false; else { qkt_lds<6>(p0, p1, kbase + (sl) * KSLOT, qr, st.negm, r32, hi); if ((t) >= NT - 4) cmask(p0, p1, (t) - (NT - 4), qrel, hi); resc = sm_decide64(st, p0, p1, wsf, r32, hi); } } while (0)
#define MLA_PART2(t, sl) do { if (!ATT_SKIP(t)) { VFrag vf_; pv64_read(vf_, vb0 + (sl) * VSLOT); sm_exp64(st, resc, p0, p1, wsf, hi, pw0, pw1, pw2, pw3); \
        pv64_mma(st.o, vf_, __builtin_bit_cast(bf16x8, pw0), __builtin_bit_cast(bf16x8, pw1), __builtin_bit_cast(bf16x8, pw2), __builtin_bit_cast(bf16x8, pw3)); } } while (0)
    MLA_K(0, 0); MLA_V(0, 0);
    ATT_WAIT_BAR(0);
    if (!halfB) { int sc = 0;
        for (int t = 0; t < NT; ++t) { const int sn = sc == 2 ? 0 : sc + 1;
            if (t + 1 < NT) { MLA_K(t + 1, sn); MLA_V(t + 1, sn); }
            MLA_PART1(t, sc); MLA_PART2(t, sc); ATT_WAIT_BAR(0);
            sc = sn; }
        ATT_WAIT_BAR(0);
    } else { int sp = 0, sc = 1;
        if (1 < NT) { MLA_K(1, 1); MLA_V(1, 1); }
        MLA_PART1(0, 0); ATT_WAIT_BAR(0);
        for (int t = 1; t < NT; ++t) { const int sn = sc == 2 ? 0 : sc + 1;
            if (t + 1 < NT) { MLA_K(t + 1, sn); MLA_V(t + 1, sn); }
            MLA_PART2(t - 1, sp); MLA_PART1(t, sc); ATT_WAIT_BAR(0);
            sp = sc; sc = sn; }
        MLA_PART2(NT - 1, sp); ATT_WAIT_BAR(0);
    }
#undef MLA_K
#undef MLA_V
#undef MLA_WODD
#undef MLA_WEVEN
#undef MLA_PART1
#undef MLA_PART2
    (void)sm_finish(st, wsf, (LAS bf16*)(shm + L_OST) + wid * 2048, OB + (rowbase + q0 + wid * 32) * DM + O_B + h * 64, DM, lane, r32, hi, ssq_mix + (size_t)h * M + (rowbase + q0 + wid * 32));
}


typedef short v4i16_t __attribute__((ext_vector_type(4)));
__device__ __forceinline__ s16x4 vtr16(lds_cptr p) { return __builtin_bit_cast(s16x4, __builtin_amdgcn_ds_read_tr16_b64_v4i16((LAS v4i16_t*)p)); }
__device__ __forceinline__ float rowmax64(const f32x16& p0, const f32x16& p1) {
    float a = max3f(p0[0], p0[1], p1[0]), b = max3f(p0[2], p0[3], p1[1]); a = max3f(a, p1[2], p1[3]);
#pragma unroll
    for (int r = 4; r < 16; r += 4) { a = max3f(a, p0[r], p0[r + 1]); b = max3f(b, p0[r + 2], p0[r + 3]); a = max3f(a, p1[r], p1[r + 1]); b = max3f(b, p1[r + 2], p1[r + 3]); }
    return swap_max(fmaxf(a, b));
}
#define PINV(x) asm volatile("" : "+v"(x))
#define MF32(a, b, c) __builtin_amdgcn_mfma_f32_32x32x16_bf16(a, b, c, 0, 0, 0)
__device__ __forceinline__ void mla_unit2(int b, int h, int qb, const bf16* QM, const bf16* PROJ, bf16* OB, float* ssq_mix, LAS unsigned char* shm, const int wid) {
    const int lane = lane_id(), r32 = lane & 31, hi = lane >> 5;
    const long rowbase = (long)b * SEQ; const int q0 = qb * 256;
    const unsigned lds0 = (unsigned)(uintptr_t)shm;
    LAS float* wsf = (LAS float*)(shm + L_WS) + wid * 64;
    const bf16* Qw = QM + (rowbase + q0 + wid * 32 + r32) * QP;
    bf16x8 qr[6];
#pragma unroll
    for (int d0 = 0; d0 < 4; ++d0) qr[d0] = *(const bf16x8*)(Qw + Q_NOPE + h * 64 + d0 * 16 + hi * 8);
#pragma unroll
    for (int d0 = 0; d0 < 2; ++d0) qr[4 + d0] = *(const bf16x8*)(Qw + Q_ROPE + h * 32 + d0 * 16 + hi * 8);
    asm volatile("" : "+v"(qr[0]), "+v"(qr[1]), "+v"(qr[2]), "+v"(qr[3]), "+v"(qr[4]), "+v"(qr[5]));
    const bf16* kbase_g = QM + rowbase * QP + Q_KV + h * 128 + wid * 8; const unsigned koff = (unsigned)(lane * QP * 2);
    const bf16* rbase_g = PROJ + rowbase * PP + C_KR + (wid & 3) * 8; const unsigned roff = (unsigned)(lane * PP * 2);
    const bf16* vbase_g = QM + (rowbase + 16 * (wid & 3)) * QP + Q_KV + h * 128 + 64 + (wid >> 2) * 32; const unsigned voff_ = (unsigned)(((lane >> 2) * QP + (lane & 3) * 8) * 2);
    const unsigned kdst = lds0 + L_K + wid * 1024, rdst = lds0 + L_K + (8 + (wid & 3)) * 1024, vdst = lds0 + L_V + wid * 1024;
#define U2_K(t, s) do { glds16s(kbase_g + (long)(t) * 64 * QP, koff, (unsigned)__builtin_amdgcn_readfirstlane(kdst + (s) * KSLOT)); \
        if (wid < 4) glds16s(rbase_g + (long)(t) * 64 * PP, roff, (unsigned)__builtin_amdgcn_readfirstlane(rdst + (s) * KSLOT)); } while (0)
#define U2_V(t, s) glds16s(vbase_g + (long)(t) * 64 * QP, voff_, (unsigned)__builtin_amdgcn_readfirstlane(vdst + (s) * VSLOT))
    const lds_cptr vp0 = (lds_cptr)(shm + L_V) + ((lane >> 4) & 1) * 32 + (lane & 3) * 8 + (4 * hi + ((lane & 15) >> 2)) * 64;
    const lds_cptr kp0 = (lds_cptr)(shm + L_K) + hi * 1024 + r32 * 16;
    const int NT = 4 * qb + 4, qrel = wid * 32 + r32;
    SmState st; sm_init(st); PINV(st.negm);
    bool resc = false;
    f32x16 pA0, pA1, pB0, pB1; bf16x8 kf[8]; s16x4 vlo[8], vhi[8]; u32x4 pw0, pw1, pw2, pw3;
    int sl_prev = 0, sl_cur = 0, sl_next = 1;
#define U2_ROT() do { sl_prev = sl_cur; sl_cur = sl_next; sl_next = (sl_next == 2) ? 0 : sl_next + 1; } while (0)
#define U2_KLOAD2(kp, d0) do { kf[2 * (d0)] = *(const LAS bf16x8*)((kp) + (d0) * 2048); kf[2 * (d0) + 1] = *(const LAS bf16x8*)((kp) + (d0) * 2048 + 512); } while (0)
#define U2_RESC() do { if (resc) { _Pragma("unroll") for (int d_ = 0; d_ < 2; ++d_) _Pragma("unroll") for (int r = 0; r < 16; ++r) st.o[d_][r] *= wsf[crow(r, hi)]; } } while (0)
    U2_K(0, 0); U2_V(0, 0); U2_K(1, 1); U2_K(2, 2); U2_V(1, 1);
    ATT_WAIT_BAR(0);
    { bf16x8 k0[12];
#pragma unroll
      for (int d0 = 0; d0 < 6; ++d0) { k0[2 * d0] = *(const LAS bf16x8*)(kp0 + d0 * 2048); k0[2 * d0 + 1] = *(const LAS bf16x8*)(kp0 + d0 * 2048 + 512); }
      ATT_SBAR();
      pA0 = MF32(k0[0], qr[0], st.negm); pA1 = MF32(k0[1], qr[0], st.negm);
#pragma unroll
      for (int d0 = 1; d0 < 6; ++d0) { pA0 = MF32(k0[2 * d0], qr[d0], pA0); pA1 = MF32(k0[2 * d0 + 1], qr[d0], pA1); } }
    if (NT == 4) cmask(pA0, pA1, 0, qrel, hi);
    { const float rm = rowmax64(pA0, pA1); st.mhat = rm;
#pragma unroll
      for (int r = 0; r < 16; ++r) { pA0[r] = __builtin_amdgcn_exp2f(pA0[r] - rm); pA1[r] = __builtin_amdgcn_exp2f(pA1[r] - rm); st.negm[r] = -rm; } }
    PINV(pA0); PINV(pA1); PINV(st.negm); ATT_SBAR();
    ATT_WAIT_BAR(0);
    U2_ROT();
#pragma unroll
    for (int d0 = 0; d0 < 4; ++d0) U2_KLOAD2(kp0 + sl_cur * KSLOT, d0);
#define U2_PKW(P, i) cvt_pk_bf16(P[i], P[(i) + 1])
#define U2_PAF(k) __builtin_bit_cast(bf16x8, pw##k)
#define U2_VFR(i) (bf16x8){vlo[i][0], vlo[i][1], vlo[i][2], vlo[i][3], vhi[i][0], vhi[i][1], vhi[i][2], vhi[i][3]}
#define U2_VRD(i) do { vlo[i] = vtr16(vp_ + (((i) >> 2) * 4096 + ((i) & 3) * 1024)); vhi[i] = vtr16(vp_ + (((i) >> 2) * 4096 + ((i) & 3) * 1024 + 512)); } while (0)
#define U2_KRD(G, d0) do { if (G) { U2_KLOAD2(kp0 + sl_next * KSLOT, d0); ATT_SBAR(); } } while (0)
#define U2_GAPA(MF, a0, a1, a2, a3, W0, W1, PW) do { MF; sacc += a0; sacc += a1; sacc += a2; sacc += a3; W0; W1; PINV(PW); PINV(sacc); ATT_SBAR(); } while (0)
#define U2_GAPB(MF, X, i) do { MF; X[i] = __builtin_amdgcn_exp2f(X[i]); X[(i) + 1] = __builtin_amdgcn_exp2f(X[(i) + 1]); X[(i) + 2] = __builtin_amdgcn_exp2f(X[(i) + 2]); X[(i) + 3] = __builtin_amdgcn_exp2f(X[(i) + 3]); PINV(X); ATT_SBAR(); } while (0)
#define U2_STEP(C0, C1, P0, P1, t, MASK, GK, GV, GL) do { ATT_SBAR(); \
    if (GK) U2_K((t) + 2, sl_prev); if (GV) U2_V((t) + 1, sl_next); \
    const lds_cptr vp_ = vp0 + sl_prev * VSLOT; \
    float sacc = P0[0] + P0[1]; \
    U2_GAPA(C0 = MF32(kf[0], qr[0], st.negm), P0[2], P0[3], P0[4], P0[5],     pw0[0] = U2_PKW(P0, 0),  pw0[1] = U2_PKW(P0, 2),  pw0); \
    U2_GAPA(C1 = MF32(kf[1], qr[0], st.negm), P0[6], P0[7], P0[8], P0[9],     pw0[2] = U2_PKW(P0, 4),  pw0[3] = U2_PKW(P0, 6),  pw0); \
    U2_GAPA(C0 = MF32(kf[2], qr[1], C0),      P0[10], P0[11], P0[12], P0[13], pw1[0] = U2_PKW(P0, 8),  pw1[1] = U2_PKW(P0, 10), pw1); \
    U2_GAPA(C1 = MF32(kf[3], qr[1], C1),      P0[14], P0[15], P1[0], P1[1],   pw1[2] = U2_PKW(P0, 12), pw1[3] = U2_PKW(P0, 14), pw1); \
    bf16x8 kr_[4]; { const lds_cptr kq_ = kp0 + sl_cur * KSLOT; kr_[0] = *(const LAS bf16x8*)(kq_ + 4 * 2048); kr_[1] = *(const LAS bf16x8*)(kq_ + 4 * 2048 + 512); kr_[2] = *(const LAS bf16x8*)(kq_ + 5 * 2048); kr_[3] = *(const LAS bf16x8*)(kq_ + 5 * 2048 + 512); } ATT_SBAR();     \
    U2_GAPA(C0 = MF32(kf[4], qr[2], C0),      P1[2], P1[3], P1[4], P1[5],     pw2[0] = U2_PKW(P1, 0),  pw2[1] = U2_PKW(P1, 2),  pw2); \
    U2_GAPA(C1 = MF32(kf[5], qr[2], C1),      P1[6], P1[7], P1[8], P1[9],     pw2[2] = U2_PKW(P1, 4),  pw2[3] = U2_PKW(P1, 6),  pw2); \
    U2_GAPA(C0 = MF32(kf[6], qr[3], C0),      P1[10], P1[11], P1[12], P1[13], pw3[0] = U2_PKW(P1, 8),  pw3[1] = U2_PKW(P1, 10), pw3); \
    U2_GAPA(C1 = MF32(kf[7], qr[3], C1),      P1[14], P1[15], 0.f, 0.f,       pw3[2] = U2_PKW(P1, 12), pw3[3] = U2_PKW(P1, 14), pw3); \
    C0 = MF32(kr_[0], qr[4], C0); C1 = MF32(kr_[1], qr[4], C1); C0 = MF32(kr_[2], qr[5], C0); C1 = MF32(kr_[3], qr[5], C1); \
    U2_VRD(0); U2_VRD(4); U2_VRD(1); U2_VRD(5); U2_VRD(2); U2_VRD(6); U2_VRD(3); U2_VRD(7); ATT_SBAR();     \
    st.l += sacc; \
    if (MASK) cmask(C0, C1, (t) - (NT - 4), qrel, hi); \
    { const float rm = rowmax64(C0, C1); resc = false; \
      if (__builtin_expect(__any(rm > (float)THRL), 0)) { const float dl = fmaxf(rm, 0.f); st.mhat += dl; \
          _Pragma("unroll") for (int r = 0; r < 16; ++r) { C0[r] -= dl; C1[r] -= dl; st.negm[r] = -st.mhat; } \
          const float f = __builtin_amdgcn_exp2f(-dl); st.l *= f; if (hi == 0) wsf[r32] = f; resc = true; } } \
    ATT_SBAR(); \
    U2_GAPB(st.o[0] = MF32(U2_PAF(0), U2_VFR(0), st.o[0]), C0, 0); \
    U2_GAPB(st.o[1] = MF32(U2_PAF(0), U2_VFR(4), st.o[1]), C0, 4);  U2_KRD(GL, 0); \
    U2_GAPB(st.o[0] = MF32(U2_PAF(1), U2_VFR(1), st.o[0]), C0, 8); \
    U2_GAPB(st.o[1] = MF32(U2_PAF(1), U2_VFR(5), st.o[1]), C0, 12); U2_KRD(GL, 1); \
    U2_GAPB(st.o[0] = MF32(U2_PAF(2), U2_VFR(2), st.o[0]), C1, 0);  U2_KRD(GL, 2); \
    U2_GAPB(st.o[1] = MF32(U2_PAF(2), U2_VFR(6), st.o[1]), C1, 4);  U2_KRD(GL, 3); \
    U2_GAPB(st.o[0] = MF32(U2_PAF(3), U2_VFR(3), st.o[0]), C1, 8); \
    U2_GAPB(st.o[1] = MF32(U2_PAF(3), U2_VFR(7), st.o[1]), C1, 12); \
    } while (0)
    ATT_WAIT_BAR(0);
    int t = 1;
    for (; t + 1 < NT - 4; t += 2) {
        U2_STEP(pB0, pB1, pA0, pA1, t, false, true, true, true);     ATT_WAIT_BAR(0); U2_RESC(); U2_ROT();
        U2_STEP(pA0, pA1, pB0, pB1, t + 1, false, true, true, true); ATT_WAIT_BAR(0); U2_RESC(); U2_ROT();
    }
    for (; t + 1 < NT; t += 2) {
        U2_STEP(pB0, pB1, pA0, pA1, t, true, (t + 2 < NT), (t + 1 < NT), (t + 1 < NT));         ATT_WAIT_BAR(0); U2_RESC(); U2_ROT();
        U2_STEP(pA0, pA1, pB0, pB1, t + 1, true, (t + 3 < NT), (t + 2 < NT), (t + 2 < NT));     ATT_WAIT_BAR(0); U2_RESC(); U2_ROT();
    }
    U2_STEP(pB0, pB1, pA0, pA1, NT - 1, true, false, false, false); U2_RESC();
    { float sacc = pB0[0] + pB0[1];
#pragma unroll
      for (int r = 2; r < 16; ++r) sacc += pB0[r];
#pragma unroll
      for (int r = 0; r < 16; ++r) sacc += pB1[r];
      st.l += sacc;
      pw0 = (u32x4){U2_PKW(pB0, 0), U2_PKW(pB0, 2), U2_PKW(pB0, 4), U2_PKW(pB0, 6)}; pw1 = (u32x4){U2_PKW(pB0, 8), U2_PKW(pB0, 10), U2_PKW(pB0, 12), U2_PKW(pB0, 14)};
      pw2 = (u32x4){U2_PKW(pB1, 0), U2_PKW(pB1, 2), U2_PKW(pB1, 4), U2_PKW(pB1, 6)}; pw3 = (u32x4){U2_PKW(pB1, 8), U2_PKW(pB1, 10), U2_PKW(pB1, 12), U2_PKW(pB1, 14)};
      const lds_cptr vp_ = vp0 + sl_cur * VSLOT;
#pragma unroll
      for (int i = 0; i < 8; ++i) U2_VRD(i);
      st.o[0] = MF32(U2_PAF(0), U2_VFR(0), st.o[0]); st.o[1] = MF32(U2_PAF(0), U2_VFR(4), st.o[1]); st.o[0] = MF32(U2_PAF(1), U2_VFR(1), st.o[0]); st.o[1] = MF32(U2_PAF(1), U2_VFR(5), st.o[1]);
      st.o[0] = MF32(U2_PAF(2), U2_VFR(2), st.o[0]); st.o[1] = MF32(U2_PAF(2), U2_VFR(6), st.o[1]); st.o[0] = MF32(U2_PAF(3), U2_VFR(3), st.o[0]); st.o[1] = MF32(U2_PAF(3), U2_VFR(7), st.o[1]); }
    ATT_WAIT_BAR(0);
#undef U2_K
#undef U2_V
#undef U2_ROT
#undef U2_KLOAD2
#undef U2_RESC
#undef U2_PKW
#undef U2_PAF
#undef U2_VFR
#undef U2_VRD
#undef U2_KRD
#undef U2_GAPA
#undef U2_GAPB
#undef U2_STEP
    (void)sm_finish(st, wsf, (LAS bf16*)(shm + L_OST) + wid * 2048, OB + (rowbase + q0 + wid * 32) * DM + O_B + h * 64, DM, lane, r32, hi, ssq_mix + (size_t)h * M + (rowbase + q0 + wid * 32));
}

__device__ __forceinline__ void moba_unit(int b, int h, int j, const bf16* PROJ, const float* kmean, const float* tmoba, bf16* OB, float* ssq_mix, LAS unsigned char* shm, const int wid) {
    const int lane = lane_id(), tid = wid * 64 + lane, r32 = lane & 31, hi = lane >> 5;
    const long rowbase = (long)b * SEQ; const int q0 = j * 256;
    const unsigned lds0 = (unsigned)(uintptr_t)shm;
    LAS float* wsf = (LAS float*)(shm + L_WS) + wid * 64;
    LAS float* tb = (LAS float*)(shm + L_TB);
    { float tv[9];
#pragma unroll
      for (int k = 0; k < 9; ++k) { const int i = tid + k * (NWAVES * 64); tv[k] = (i >= 256 && i < 256 + 4096) ? tmoba[h * 4096 + i - 256] : 0.f; }
#pragma unroll
      for (int k = 0; k < 9; ++k) { const int i = tid + k * (NWAVES * 64); if (i < 256 + 4096) tb[i] = tv[k]; } }
    LAS float* kml = (LAS float*)(shm + L_KM);
    for (int i = tid; i < j * 64; i += NWAVES * 64) kml[i] = kmean[((size_t)(b * 16 + (i >> 6)) * 4 + h) * 64 + (i & 63)];
    asm volatile("s_nop 15\n\ts_waitcnt vmcnt(0) lgkmcnt(0)\n\ts_barrier" ::: "memory");
    const float c31 = tb[256 + 4095];
    const bf16* Qw = PROJ + (rowbase + q0 + wid * 32 + r32) * PP + C_QC + h * 64;
    bf16x8 qr[4];
#pragma unroll
    for (int d0 = 0; d0 < 4; ++d0) qr[d0] = *(const bf16x8*)(Qw + d0 * 16 + hi * 8);
    float g1 = -INFINITY, g2 = -INFINITY, g3 = -INFINITY; float gate[16];
#pragma unroll
    for (int blk = 0; blk < 16; ++blk) { float s = -INFINITY;
        if (blk < j) { const LAS float* km = kml + blk * 64 + hi * 8; float a = 0.f;
#pragma unroll
            for (int d0 = 0; d0 < 4; ++d0) { const f32x4 k0 = *(const LAS f32x4*)(km + d0 * 16), k1 = *(const LAS f32x4*)(km + d0 * 16 + 4); const u32x4 q = __builtin_bit_cast(u32x4, qr[d0]);
                a = fmaf(bf_lo(q.x), k0[0], a); a = fmaf(bf_hi(q.x), k0[1], a); a = fmaf(bf_lo(q.y), k0[2], a); a = fmaf(bf_hi(q.y), k0[3], a);
                a = fmaf(bf_lo(q.z), k1[0], a); a = fmaf(bf_hi(q.z), k1[1], a); a = fmaf(bf_lo(q.w), k1[2], a); a = fmaf(bf_hi(q.w), k1[3], a); }
            s = swap_add(a); }
        gate[blk] = s;
        if (s > g1) { g3 = g2; g2 = g1; g1 = s; } else if (s > g2) { g3 = g2; g2 = s; } else if (s > g3) { g3 = s; } }
    unsigned sel = 0u;
#pragma unroll
    for (int blk = 0; blk < 16; ++blk) if (blk < j && gate[blk] >= g3) sel |= 1u << blk;
    const bf16* ksrc = PROJ + (rowbase + lane) * PP + C_KC + h * 64 + wid * 8;
    const bf16* vsrc = PROJ + (rowbase + 16 * (wid & 3) + (lane >> 2)) * PP + C_VC + h * 64 + (wid >> 2) * 32 + (lane & 3) * 8;
    const unsigned kdst = lds0 + L_K + wid * 1024, vdst = lds0 + L_V + wid * 1024;
    const int vb0 = (int)(lds0 + L_V) + ((lane >> 4) & 1) * 32 + (lane & 3) * 8 + (4 * hi + ((lane & 15) >> 2)) * 64;
    const lds_cptr kbase = (lds_cptr)(shm + L_K);
    const int NT = 4 * j + 4, qrel = wid * 32 + r32;
    SmState st; sm_init(st);
    const bool halfB = wid >= 4;
#define MOBA_K(t, s) glds16(ksrc + (long)(t) * 64 * PP, (unsigned)__builtin_amdgcn_readfirstlane(kdst + (s) * KSLOT))
#define MOBA_V(t, s) glds16(vsrc + (long)(t) * 64 * PP, (unsigned)__builtin_amdgcn_readfirstlane(vdst + (s) * VSLOT))
#define MOBA_W(t) ATT_WAIT_BAR(0)
    f32x16 p0, p1; bool resc = false; u32x4 pw0, pw1, pw2, pw3;
#define MOBA_PART1(t, sl) do { if (ATT_SKIP(t)) resc = false; else { const int blk_ = (t) >> 2; const bool on_ = (blk_ == j) || ((sel >> blk_) & 1u); f32x16 c0_; \
        const bool far_ = (q0 - 64 * (t) - 63) >= 1536;     \
        const float cv_ = on_ ? st.negm[0] + (far_ ? c31 : 0.f) : -INFINITY;     \
        _Pragma("unroll") for (int r = 0; r < 16; ++r) c0_[r] = cv_; \
        if (far_) qkt_lds<4>(p0, p1, kbase + (sl) * KSLOT, qr, c0_, r32, hi); \
        else { float tbv_[32];     \
          const LAS float* lb_ = tb + (256 + q0 + qrel - 64 * (t) - 4 * hi - 27 - 32); \
          _Pragma("unroll") for (int r = 0; r < 16; ++r) { const int c_ = (r & 3) + 8 * (r >> 2); tbv_[r] = lb_[32 + 27 - c_]; tbv_[16 + r] = lb_[27 - c_]; } \
          qkt_lds<4>(p0, p1, kbase + (sl) * KSLOT, qr, c0_, r32, hi); \
          if (blk_ == j) cmask(p0, p1, (t) & 3, qrel, hi); \
          _Pragma("unroll") for (int r = 0; r < 16; ++r) { p0[r] += tbv_[r]; p1[r] += tbv_[16 + r]; } } \
        resc = sm_decide64(st, p0, p1, wsf, r32, hi); } } while (0)
#define MOBA_PART2(t, sl) do { if (!ATT_SKIP(t)) { VFrag vf_; pv64_read(vf_, vb0 + (sl) * VSLOT); sm_exp64(st, resc, p0, p1, wsf, hi, pw0, pw1, pw2, pw3); \
        pv64_mma(st.o, vf_, __builtin_bit_cast(bf16x8, pw0), __builtin_bit_cast(bf16x8, pw1), __builtin_bit_cast(bf16x8, pw2), __builtin_bit_cast(bf16x8, pw3)); } } while (0)
    MOBA_K(0, 0); MOBA_V(0, 0);
    ATT_WAIT_BAR(0);
    if (!halfB) { int sc = 0;
        for (int t = 0; t < NT; ++t) { const int sn = sc == 2 ? 0 : sc + 1;
            if (t + 1 < NT) { MOBA_K(t + 1, sn); MOBA_V(t + 1, sn); }
            MOBA_PART1(t, sc); MOBA_PART2(t, sc); ATT_WAIT_BAR(0);
            sc = sn; }
        ATT_WAIT_BAR(0);
    } else { int sp = 0, sc = 1;
        if (1 < NT) { MOBA_K(1, 1); MOBA_V(1, 1); }
        MOBA_PART1(0, 0); ATT_WAIT_BAR(0);
        for (int t = 1; t < NT; ++t) { const int sn = sc == 2 ? 0 : sc + 1;
            if (t + 1 < NT) { MOBA_K(t + 1, sn); MOBA_V(t + 1, sn); }
            MOBA_PART2(t - 1, sp); MOBA_PART1(t, sc); ATT_WAIT_BAR(0);
            sp = sc; sc = sn; }
        MOBA_PART2(NT - 1, sp); ATT_WAIT_BAR(0);
    }
#undef MOBA_K
#undef MOBA_V
#undef MOBA_W
#undef MOBA_PART1
#undef MOBA_PART2
    (void)sm_finish(st, wsf, (LAS bf16*)(shm + L_OST) + wid * 2048, OB + (rowbase + q0 + wid * 32) * DM + O_C + h * 64, DM, lane, r32, hi, ssq_mix + (size_t)(6 + h) * M + (rowbase + q0 + wid * 32));
}

constexpr int D_V = 0, D_WS = 65536, D_OST = D_WS + 8 * 256, D_TB = D_OST + 8 * 4096, D_Q = D_TB + 3 * 6 * 192 * 4, D_END = D_Q + 16;
static_assert(D_END <= RING_BYTES, "dilated LDS map");
__device__ __forceinline__ void dil_task(int p, int b, int h, int r, int m0, const bf16* PROJ, bf16* OPART, float* LSE, LAS unsigned char* shm, int wid, int lane) {
    const int r32 = lane & 31, hi = lane >> 5, sh = 2 * p;
    const long rowbase = (long)b * SEQ;
    const unsigned lds0 = (unsigned)(uintptr_t)shm;
    LAS float* wsf = (LAS float*)(shm + D_WS) + wid * 64;
    const LAS float* tbl = (const LAS float*)(shm + D_TB) + (p * 6 + h) * 192 + 32;
    const unsigned vslot0 = lds0 + D_V + wid * 8192;
    const int tq = r + ((m0 + r32) << sh);
    const bf16* Qw = PROJ + (rowbase + tq) * PP + C_QA + h * 64;
    bf16x8 qr[4];
#pragma unroll
    for (int d0 = 0; d0 < 4; ++d0) qr[d0] = *(const bf16x8*)(Qw + d0 * 16 + hi * 8);
    const int g0 = (4 - (m0 >> 5)) > 0 ? (4 - (m0 >> 5)) : 0;
    bf16x8 kc[4], kn[4];
#define DIL_LOADK(dst, g) do { const int ks_ = m0 - 128 + 32 * (g) + r32; const bf16* kp_ = PROJ + (rowbase + r + ((long)ks_ << sh)) * PP + C_KA + h * 64 + hi * 8; \
        _Pragma("unroll") for (int d0 = 0; d0 < 4; ++d0) dst[d0] = *(const bf16x8*)(kp_ + d0 * 16); } while (0)
#define DIL_LOADV(VD, g) do { _Pragma("unroll") for (int pc = 0; pc < 4; ++pc) { const int dh_ = pc >> 1, rg_ = pc & 1; const int ks_ = m0 - 128 + 32 * (g) + 16 * rg_ + (lane >> 2); \
            VD[pc] = *(const u32x4*)(PROJ + (rowbase + r + ((long)ks_ << sh)) * PP + C_VA + h * 64 + dh_ * 32 + (lane & 3) * 8); } } while (0)
#define DIL_STV(VS, g) do { _Pragma("unroll") for (int pc = 0; pc < 4; ++pc) *(LAS u32x4*)(shm + D_V + wid * 8192 + ((g) & 1) * 2048 + (pc >> 1) * 4096 + (pc & 1) * 1024 + lane * 16) = VS[pc]; } while (0)
    u32x4 vc[4], vn[4], vf[4]; bf16x8 kf[4];
    const int vb0 = (int)vslot0 + ((lane >> 4) & 1) * 32 + (lane & 3) * 8 + (4 * hi + ((lane & 15) >> 2)) * 64;
    SmState st; sm_init(st);
    DIL_LOADV(vc, g0); DIL_LOADK(kc, g0);
    if (g0 + 1 < 5) { DIL_LOADV(vn, g0 + 1); DIL_LOADK(kn, g0 + 1); } else { _Pragma("unroll") for (int d0 = 0; d0 < 4; ++d0) { kn[d0] = kc[d0]; vn[d0] = vc[d0]; } }
    for (int g = g0; g < 5; ++g) {
        if (g + 2 < 5) { DIL_LOADV(vf, g + 2); DIL_LOADK(kf, g + 2); } else { _Pragma("unroll") for (int d0 = 0; d0 < 4; ++d0) { kf[d0] = kn[d0]; vf[d0] = vn[d0]; } }
        DIL_STV(vc, g);
        float tb_[16];
        { const LAS float* lb = tbl + (128 - 32 * g) + r32 - 4 * hi - 27;
#pragma unroll
          for (int rr = 0; rr < 16; ++rr) tb_[rr] = lb[27 - ((rr & 3) + 8 * (rr >> 2))]; }
        ATT_SBAR();
        f32x16 p0;
#pragma unroll
        for (int d0 = 0; d0 < 4; ++d0) p0 = __builtin_amdgcn_mfma_f32_32x32x16_bf16(kc[d0], qr[d0], d0 == 0 ? st.negm : p0, 0, 0, 0);
        MFMA_FENCE1(p0);
        if (g == 0) {
#pragma unroll
            for (int rr = 0; rr < 16; ++rr) if (crow(rr, hi) < r32) p0[rr] = -INFINITY; }
        if (g == 4) {
#pragma unroll
            for (int rr = 0; rr < 16; ++rr) if (crow(rr, hi) > r32) p0[rr] = -INFINITY; }
#pragma unroll
        for (int rr = 0; rr < 16; ++rr) p0[rr] += tb_[rr];
        u32x4 pw0, pw1; sm_step32(st, p0, wsf, r32, hi, pw0, pw1);
        pv32(st.o, vb0 + (g & 1) * 2048, __builtin_bit_cast(bf16x8, pw0), __builtin_bit_cast(bf16x8, pw1));
#pragma unroll
        for (int d0 = 0; d0 < 4; ++d0) { kc[d0] = kn[d0]; kn[d0] = kf[d0]; vc[d0] = vn[d0]; vn[d0] = vf[d0]; }
    }
#undef DIL_LOADV
#undef DIL_LOADK
#undef DIL_STV
    bf16* orow0 = OPART + ((size_t)p * M + rowbase + r + ((long)m0 << sh)) * 384 + h * 64;
    const float lse = sm_finish(st, wsf, (LAS bf16*)(shm + D_OST) + wid * 2048, orow0, (long)384 << sh, lane, r32, hi);
    if (hi == 0) LSE[((size_t)(p * NB + b) * 6 + h) * SEQ + (size_t)r * (SEQ >> sh) + m0 + r32] = lse;
}

constexpr int DU_K = 0, DU_V = 49152, DU_WS = 98304, DU_OST = 0;
static_assert(DU_WS + 8 * 256 == D_TB && DU_V + 6 * 8192 == DU_WS, "dilated unit LDS map");
__device__ __forceinline__ int du_swz(int c) { return (c & 7) ^ ((c & 1) << 3); }
struct DuId { int p, b, h, r, m0u; };
__device__ __forceinline__ DuId du_decode(int id) { DuId d; const int x_ = id >> 16, i_ = id & 0xffff, bh_ = (i_ / 48) * 8 + x_, rem_ = i_ % 48; d.h = bh_ % H_DIL; d.b = bh_ / H_DIL; d.p = rem_ >> 4; const int uu = rem_ & 15, per = 16 >> (2 * d.p); d.r = uu / per; d.m0u = 256 * (uu % per); return d; }
constexpr int DU_NLOC = 3 * NB * 16 * H_DIL / 8;
struct DuRegs { u32x4 kv[6], vv[6]; bf16x8 qr[4]; };
__device__ __forceinline__ void du_load(DuRegs& R, const DuId& u, const bf16* PROJ, int wid, int lane) {
    const int r32 = lane & 31, hi = lane >> 5, sh = 2 * u.p; const long rowbase = (long)u.b * SEQ;
    const bf16* Qw = PROJ + (rowbase + u.r + ((long)(u.m0u + 32 * wid + r32) << sh)) * PP + C_QA + u.h * 64;
#pragma unroll
    for (int d0 = 0; d0 < 4; ++d0) R.qr[d0] = *(const bf16x8*)(Qw + d0 * 16 + hi * 8);
    const int t = wid * 64 + lane, row8 = t >> 3, c8 = t & 7;
#pragma unroll
    for (int n = 0; n < 6; ++n) { const int ks = u.m0u - 128 + n * 64 + row8;
        const bf16* src = PROJ + (rowbase + u.r + ((long)(ks < 0 ? 0 : ks) << sh)) * PP + u.h * 64 + c8 * 8;
        R.kv[n] = *(const u32x4*)(src + C_KA); R.vv[n] = *(const u32x4*)(src + C_VA); }
}
__device__ __forceinline__ void dil_units(unsigned* qctr, int myx, const bf16* PROJ, bf16* OPART, float* LSE, LAS unsigned char* shm, const int wid) {
    const int lane = lane_id(), r32 = lane & 31, hi = lane >> 5;
    const unsigned lds0 = (unsigned)(uintptr_t)shm;
    LAS float* wsf = (LAS float*)(shm + DU_WS) + wid * 64;
    volatile LAS unsigned* slot = (volatile LAS unsigned*)(shm + D_Q);
    int cur = wg_next8(qctr, DU_NLOC, myx, shm, D_Q, wid); if (cur < 0) return;
    int nxt = wg_next8(qctr, DU_NLOC, myx, shm, D_Q, wid);
    DuRegs R; du_load(R, du_decode(cur), PROJ, wid, lane);
    const bool t0 = wid == 0 && lane == 0;
    for (;;) {
        const DuId u = du_decode(cur); const int sh = 2 * u.p; const long rowbase = (long)u.b * SEQ;
        unsigned ahead = 0u; if (t0) ahead = q8_take(qctr, DU_NLOC, myx);
        { const int t = wid * 64 + lane, row8 = t >> 3, c8 = t & 7;
#pragma unroll
          for (int n = 0; n < 6; ++n) { const int i = n * 64 + row8, G = i >> 5, kk = i & 31;
              *(LAS u32x4*)(shm + DU_K + G * 4096 + c8 * 512 + ((kk ^ du_swz(c8)) * 16)) = R.kv[n];
              *(LAS u32x4*)(shm + DU_V + (G >> 1) * 8192 + (G & 1) * 2048 + (c8 >> 2) * 4096 + (kk >> 4) * 1024 + (kk & 15) * 64 + (c8 & 3) * 16) = R.vv[n]; } }
        bf16x8 qr[4];
#pragma unroll
        for (int d0 = 0; d0 < 4; ++d0) qr[d0] = R.qr[d0];
        asm volatile("s_nop 15\n\ts_waitcnt lgkmcnt(0)\n\ts_barrier" ::: "memory");
        if (nxt >= 0) du_load(R, du_decode(nxt), PROJ, wid, lane);
        const LAS float* tbl = (const LAS float*)(shm + D_TB) + (u.p * 6 + u.h) * 192 + 32;
        const int m0 = u.m0u + 32 * wid;
        const int g0 = (4 - (m0 >> 5)) > 0 ? (4 - (m0 >> 5)) : 0;
        const int vbl = (int)(lds0 + DU_V) + ((lane >> 4) & 1) * 32 + (lane & 3) * 8 + (4 * hi + ((lane & 15) >> 2)) * 64;
        SmState st; sm_init(st);
        for (int g = g0; g < 5; ++g) { const int G = wid + g;
            float tb_[16]; bf16x8 kf[4];
            { const LAS float* lb = tbl + (128 - 32 * g) + r32 - 4 * hi - 27;
#pragma unroll
              for (int rr = 0; rr < 16; ++rr) tb_[rr] = lb[27 - ((rr & 3) + 8 * (rr >> 2))]; }
#pragma unroll
            for (int d0 = 0; d0 < 4; ++d0) kf[d0] = *(const LAS bf16x8*)(shm + DU_K + G * 4096 + (2 * d0 + hi) * 512 + ((r32 ^ du_swz(2 * d0 + hi)) * 16));
            ATT_SBAR();
            f32x16 p0;
#pragma unroll
            for (int d0 = 0; d0 < 4; ++d0) p0 = __builtin_amdgcn_mfma_f32_32x32x16_bf16(kf[d0], qr[d0], d0 == 0 ? st.negm : p0, 0, 0, 0);
            V32 vf_; pv32_read(vf_, vbl + (G >> 1) * 8192 + (G & 1) * 2048);
            MFMA_FENCE1(p0);
            if (g == 0) {
#pragma unroll
                for (int rr = 0; rr < 16; ++rr) if (crow(rr, hi) < r32) p0[rr] = -INFINITY; }
            if (g == 4) {
#pragma unroll
                for (int rr = 0; rr < 16; ++rr) if (crow(rr, hi) > r32) p0[rr] = -INFINITY; }
#pragma unroll
            for (int rr = 0; rr < 16; ++rr) p0[rr] += tb_[rr];
            u32x4 pw0, pw1; sm_step32(st, p0, wsf, r32, hi, pw0, pw1);
            pv32_mma(st.o, vf_, __builtin_bit_cast(bf16x8, pw0), __builtin_bit_cast(bf16x8, pw1));
        }
        if (t0) slot[0] = ahead;
        asm volatile("s_nop 15\n\ts_waitcnt lgkmcnt(0)\n\ts_barrier" ::: "memory");
        const int nn = (int)__builtin_amdgcn_readfirstlane(slot[0]);
        bf16* orow0 = OPART + ((size_t)u.p * M + rowbase + u.r + ((long)m0 << sh)) * 384 + u.h * 64;
        const float lse = sm_finish(st, wsf, (LAS bf16*)(shm + DU_OST) + wid * 2048, orow0, (long)384 << sh, lane, r32, hi);
        if (hi == 0) LSE[((size_t)(u.p * NB + u.b) * 6 + u.h) * SEQ + (size_t)u.r * (SEQ >> sh) + m0 + r32] = lse;
        asm volatile("s_nop 15\n\ts_waitcnt lgkmcnt(0)\n\ts_barrier" ::: "memory");
        if (nxt < 0) break;
        cur = nxt; nxt = nn;
    }
}
}

__device__ __forceinline__ int ilv32(int n) { return n < 16 ? 2 * n : 2 * (n - 16) + 1; }
__device__ __forceinline__ void tr_item(const float* W, int N, const float* gain, float cscale, bf16* WT, int ldt, int dcol, int drow, bool il, LAS float* scr, int k0, int n0, int lane) {
    { f32x4 v[8]; float gsc[8];
#pragma unroll
      for (int i = 0; i < 8; ++i) { const int kk = 8 * i + (lane >> 3); v[i] = *(const f32x4*)(W + (size_t)(k0 + kk) * N + n0 + 4 * (lane & 7)); gsc[i] = (gain ? gain[k0 + kk] : 1.0f) * cscale; }
#pragma unroll
      for (int i = 0; i < 8; ++i) { const int kk = 8 * i + (lane >> 3); LAS float* d = scr + kk * 33 + 4 * (lane & 7); d[0] = v[i][0] * gsc[i]; d[1] = v[i][1] * gsc[i]; d[2] = v[i][2] * gsc[i]; d[3] = v[i][3] * gsc[i]; } }
    LDS_WAIT(); asm volatile("" ::: "memory");
    const int c = lane & 7;
#pragma unroll
    for (int j = 0; j < 4; ++j) { const int n = (lane >> 3) + 8 * j; const LAS float* s = scr + (8 * c) * 33 + n;
        u32x4 o; o.x = cvt_pk_bf16(s[0 * 33], s[1 * 33]); o.y = cvt_pk_bf16(s[2 * 33], s[3 * 33]); o.z = cvt_pk_bf16(s[4 * 33], s[5 * 33]); o.w = cvt_pk_bf16(s[6 * 33], s[7 * 33]);
        const int dr = drow + (il ? ilv32(n) : n);
        *(u32x4*)(WT + (size_t)dr * ldt + dcol + k0 + 8 * c) = o; }
    LDS_WAIT(); asm volatile("" ::: "memory");
}
__device__ __forceinline__ void tr_item8(const float* W, int N, float cscale, unsigned char* WT, int ldt, int drow, LAS float* scr, int k0, int n0, int lane) {
    { f32x4 v[8];
#pragma unroll
      for (int i = 0; i < 8; ++i) { const int kk = 8 * i + (lane >> 3); v[i] = *(const f32x4*)(W + (size_t)(k0 + kk) * N + n0 + 4 * (lane & 7)); }
#pragma unroll
      for (int i = 0; i < 8; ++i) { const int kk = 8 * i + (lane >> 3); LAS float* d = scr + kk * 33 + 4 * (lane & 7); d[0] = v[i][0] * cscale; d[1] = v[i][1] * cscale; d[2] = v[i][2] * cscale; d[3] = v[i][3] * cscale; } }
    LDS_WAIT(); asm volatile("" ::: "memory");
    const int c = lane & 7;
#pragma unroll
    for (int j = 0; j < 4; ++j) { const int n = (lane >> 3) + 8 * j; const LAS float* sp = scr + (8 * c) * 33 + n;
        u32x2 o; o.x = pg8::pk4_fp8((f32x4){sp[0 * 33], sp[1 * 33], sp[2 * 33], sp[3 * 33]}); o.y = pg8::pk4_fp8((f32x4){sp[4 * 33], sp[5 * 33], sp[6 * 33], sp[7 * 33]});
        *(u32x2*)(WT + (size_t)(drow + n) * ldt + k0 + 8 * c) = o; }
    LDS_WAIT(); asm volatile("" ::: "memory");
}
__device__ __forceinline__ int t5_bucket(int n) {
    if (n < 16) return n;
    int large = 16 + (int)(log2f((float)n * (1.0f / 16.0f)) * (16.0f / 7.0f));
    return large < 31 ? large : 31;
}

struct Args { const float* in[14]; float* out; unsigned char* ws; int ph_lo, ph_hi, li, pad; };

__global__ void __launch_bounds__(NWAVES * 64, 2) mk_fwd(Args args) {
    extern __shared__ __attribute__((aligned(16))) unsigned char lds_raw[];
    LAS unsigned char* lds0 = (LAS unsigned char*)lds_raw;
    volatile LAS unsigned* MISC = (volatile LAS unsigned*)(lds0 + MISC_OFF);
    const int wave0 = __builtin_amdgcn_readfirstlane((int)threadIdx.x >> 6);
#define PHASE_LOCALS \
    int z_; asm volatile("s_mov_b32 %0, 0" : "=s"(z_)); const int wave = wave0 + z_; \
    GAS unsigned char* wsg_ = (GAS unsigned char*)args.ws; GAS float* outg_ = (GAS float*)args.out; asm volatile("" : "+s"(wsg_), "+s"(outg_));     \
    unsigned char* ws = (unsigned char*)wsg_; const int G = (int)gridDim.x + z_; float* out = (float*)outg_; LAS unsigned char* lds = lds0 + z_; (void)lds; \
    const int bid = (int)blockIdx.x + z_; const int gw = bid * NWAVES + wave, NGW = G * NWAVES, NGT = NGW * 64; (void)bid; \
    unsigned* ctl = (unsigned*)(ws + WS_CTL); float* ssq_all = (float*)(ws + WS_SSQ); const f32x2* rope_cs = (const f32x2*)(ws + WS_ROPE); \
    float* tmoba = (float*)(ws + WS_TMOBA); float* tdil = (float*)(ws + WS_TDIL); float* kmean = (float*)(ws + WS_KMEAN); \
    bf16* XB = (bf16*)(ws + WS_XB); bf16* PROJ = (bf16*)(ws + WS_PROJ); bf16* QM = (bf16*)(ws + WS_QM); bf16* OB = (bf16*)(ws + WS_O); bf16* UB = (bf16*)(ws + WS_U); \
    (void)out; (void)gw; (void)NGW; (void)NGT; (void)ctl; (void)ssq_all; (void)rope_cs; (void)tmoba; (void)tdil; (void)kmean; (void)XB; (void)PROJ; (void)QM; (void)OB; (void)UB
#define LAYER_LOCALS PHASE_LOCALS; const int lz_ = l + z_; unsigned char* wl = ws + WS_W + (size_t)lz_ * W_STRIDE; float* ssq_x = ssq_all; float* ssq_c = ssq_all + (size_t)M * 16; float* ssq_mlp = ssq_all + (size_t)M * 32; \
    (void)wl; (void)ssq_x; (void)ssq_c; (void)ssq_mlp
    unsigned* ctl0 = (unsigned*)(args.ws + WS_CTL);
    for (int u = wave0 * 64 + lane_id(); u < (LDS_BYTES - LDSCTL_OFF) / 4; u += NWAVES * 64) ((LAS unsigned*)(lds0 + LDSCTL_OFF))[u] = 0u;
    __syncthreads();
    XcdBarrier bar; bar.bar = ctl0 + CW_BAR + args.li * XCD_BAR_WORDS; bar.x = 0; bar.st = nullptr;
    if (!MK_PER_PHASE) bar = xcd_barrier_post(ctl0 + CW_BAR + args.li * XCD_BAR_WORDS, MISC + 8, wave0 == 0 && lane_id() == 0);
    const int lo = MK_PER_PHASE ? args.ph_lo : 0, hi = MK_PER_PHASE ? args.ph_hi : N_PHASES;
#define IN(k) (lo <= (k) && (k) < hi)
#define SEAM(k) do { if (IN(k) && IN((k) + 1)) xcd_barrier(bar, wave0 == 0 && lane_id() == 0); } while (0)

    if (IN(0)) {
        PHASE_LOCALS; const float* x_in = args.in[0];
        const int lane = lane_id(), gt = bid * (NWAVES * 64) + wave * 64 + lane;
        LAS float* scr = (LAS float*)(lds + wave * 16384);
        constexpr int I_IN = 16 * 77, I_UQ = 6 * 18, I_UKV = 2 * 24, I_O = 16 * 32, I_UP = 16 * 128, I_DN = 64 * 32, I_L = I_IN + I_UQ + I_UKV + I_O + I_UP + I_DN;
        for (int it = gw; it < DEPTH * I_L; it += NGW) {
            const int l = it / I_L; int r = it % I_L;
            unsigned char* wl = ws + WS_W + (size_t)l * W_STRIDE;
            if (r < I_IN) { const int kb = r / 77, nb = r % 77, n0 = 32 * nb;
                int drow = n0; bool il = false; float sc = 1.0f;
                if (n0 < 384) sc = QS_64;
                else if (n0 == 1664) il = true;
                else if (n0 >= 1696) { drow = n0 + 32; if (n0 < 1952) sc = QS_64; }
                tr_item(args.in[2] + (size_t)l * DM * DIN, DIN, args.in[1] + l * DM, sc, (bf16*)(wl + W_IN), DM, 0, drow, il, scr, 64 * kb, n0, lane); continue; }
            r -= I_IN;
            if (r < I_UQ) { const int kb = r / 18, nb = r % 18, n0 = 32 * nb, h = n0 / 96, rr = n0 % 96;
                const int drow = (rr < 64) ? (Q_NOPE + 64 * h + rr) : (Q_ROPE + 32 * h);
                tr_item(args.in[5] + (size_t)l * 384 * 576, 576, args.in[3] + l * 384, QS_96, (bf16*)(wl + W_MLA), 512, 0, drow, rr == 64, scr, 64 * kb, n0, lane); continue; }
            r -= I_UQ;
            if (r < I_UKV) { const int kb = r / 24, nb = r % 24, n0 = 32 * nb;
                tr_item(args.in[6] + (size_t)l * 128 * 768, 768, args.in[4] + l * 128, 1.0f, (bf16*)(wl + W_MLA), 512, 384, Q_KV + n0, false, scr, 64 * kb, n0, lane); continue; }
            r -= I_UKV;
            if (r < I_O) { const int kb = r / 32, nb = r % 32;
                tr_item(args.in[9] + (size_t)l * DM * DM, DM, args.in[8] + l * DM, 1.0f, (bf16*)(wl + W_O), DM, 0, 32 * nb, false, scr, 64 * kb, 32 * nb, lane); continue; }
            r -= I_O;
            if (r < I_UP) { const int kb = r / 128, nb = r % 128;
                tr_item(args.in[11] + (size_t)l * DM * DFF, DFF, args.in[10] + l * DM, 1.0f, (bf16*)(wl + W_UP), DM, 0, 32 * nb, false, scr, 64 * kb, 32 * nb, lane); continue; }
            r -= I_UP;
            { const int kb = r % 64, nb = r / 64;
#if FP8_DOWN
                tr_item8(args.in[12] + (size_t)l * DFF * DM, DM, 64.0f, (unsigned char*)(wl + W_DOWN), DFF, 32 * nb, scr, 64 * kb, 32 * nb, lane); }
#else
                tr_item(args.in[12] + (size_t)l * DFF * DM, DM, nullptr, 1.0f, (bf16*)(wl + W_DOWN), DFF, 0, 32 * nb, false, scr, 64 * kb, 32 * nb, lane); }
#endif
        }
        for (int it = gt; it < DEPTH * (96 * 128 + 1536 * 64); it += NGT) {
            const int l = it / (96 * 128 + 1536 * 64); int r = it % (96 * 128 + 1536 * 64);
            unsigned char* wl = ws + WS_W + (size_t)l * W_STRIDE;
            if (r < 96 * 128) { const int rr = r / 128, ch = r % 128; const int row = rr < 32 ? 1696 + rr : 2496 + (rr - 32);
                *(u32x4*)((bf16*)(wl + W_IN) + (size_t)row * DM + ch * 8) = (u32x4){0u, 0u, 0u, 0u}; }
            else { r -= 96 * 128; const int row = r / 64, ch = r % 64; const int col = ch * 8;
                const bool data = (row < 576 && col < 384) || (row >= 768 && col >= 384);
                if (!data) *(u32x4*)((bf16*)(wl + W_MLA) + (size_t)row * 512 + col) = (u32x4){0u, 0u, 0u, 0u}; }
        }
        for (int it = gt; it < SEQ * 16; it += NGT) { const int t = it >> 4, i = it & 15;
            const float inv_freq = exp2f(-(float)i * (13.287712379549449f / 16.0f));
            const float ang = (float)t * inv_freq;
            double rev = (double)ang * 0.15915494309189535; rev -= floor(rev); const float rv = (float)rev;
            ((f32x2*)(ws + WS_ROPE))[it] = (f32x2){__builtin_amdgcn_cosf(rv), __builtin_amdgcn_sinf(rv)}; }
        const float* rel_bias = args.in[7];
        for (int it = gt; it < 4 * 4096; it += NGT) { const int h = it >> 12, d = it & 4095; tmoba[it] = rel_bias[t5_bucket(d) * 10 + 6 + h] * LOG2E; }
        for (int it = gt; it < 3 * 6 * 192; it += NGT) { const int p = it / (6 * 192), h = (it / 192) % 6, d = it % 192 - 32; const int dil = p == 0 ? 1 : (p == 1 ? 4 : 16);
            tdil[it] = (d >= 0 && d <= 128) ? rel_bias[t5_bucket(d * dil) * 10 + h] * LOG2E : 0.f; }
        for (int g32 = bid; g32 < M / 32; g32 += G) { const int m0 = g32 * 32 + 4 * wave;
            f32x4 v[4][4]; float s[4];
#pragma unroll
            for (int q = 0; q < 4; ++q) { const f32x4* xr = (const f32x4*)(x_in + (size_t)(m0 + q) * DM) + 2 * lane;
#pragma unroll
                for (int j = 0; j < 2; ++j) { v[q][2 * j] = xr[128 * j]; v[q][2 * j + 1] = xr[128 * j + 1]; } }
#pragma unroll
            for (int q = 0; q < 4; ++q) { const int m = m0 + q;
                s[q] = 0.f;
#pragma unroll
                for (int j = 0; j < 4; ++j) s[q] += (v[q][j][0] * v[q][j][0] + v[q][j][1] * v[q][j][1]) + (v[q][j][2] * v[q][j][2] + v[q][j][3] * v[q][j][3]);
                s[q] = wave_sum(s[q]);
                u32x4* o16 = (u32x4*)(XB + (size_t)m * DM) + lane;
#pragma unroll
                for (int j = 0; j < 2; ++j) { u32x4 w; w.x = cvt_pk_bf16(v[q][2 * j][0], v[q][2 * j][1]); w.y = cvt_pk_bf16(v[q][2 * j][2], v[q][2 * j][3]);
                    w.z = cvt_pk_bf16(v[q][2 * j + 1][0], v[q][2 * j + 1][1]); w.w = cvt_pk_bf16(v[q][2 * j + 1][2], v[q][2 * j + 1][3]); o16[64 * j] = w; } }
            { const int q_ = lane & 3, sl = lane >> 2; const float sv = q_ == 0 ? s[0] : (q_ == 1 ? s[1] : (q_ == 2 ? s[2] : s[3]));
              ssq_all[(size_t)sl * M + m0 + q_] = sl == 0 ? sv : 0.f; }
        }
    }
    SEAM(0);

    for (int l = 0; l < DEPTH; ++l) {
        const int pb = 1 + 7 * l;
        if (pb + 7 <= lo || pb >= hi) continue;

        if (IN(pb + 0)) {
            LAYER_LOCALS;
            pg8::Gemm g{XB, (const bf16*)(wl + W_IN), M, PP, DM, DM}; pg8::StaticOrder S; S.init(M, PP, G, bid);
            pg8::stage_rs<0>((LAS float*)(lds + RS_OFF), ssq_x, S, wave);
            pg8::EpiProj E{PROJ, ssq_x, ssq_c, rope_cs};
            pg8::gemm_phase<pg8::EpiProj>(lds, g, S, E, wave);
        }
        SEAM(pb + 0);
        if (IN(pb + 1)) {
            LAYER_LOCALS;
            pg8::Gemm g{PROJ + C_CQ, (const bf16*)(wl + W_MLA), M, QP, 512, PP}; pg8::MlaOrder S{G == 256 ? bid : (bid == 0 ? 0 : 256)};
            pg8::stage_rs<1>((LAS float*)(lds + RS_OFF), ssq_c, S, wave);
            pg8::EpiMla E{QM, ssq_c, rope_cs};
            pg8::gemm_phase<pg8::EpiMla, false, pg8::MlaOrder>(lds, g, S, E, wave);
            { const int ln = lane_id();
              for (int it = gw; it < NB * 16 * H_MOBA; it += NGW) { const int blk = it >> 2, h = it & 3;
                  const bf16* p = PROJ + ((size_t)blk * 256 + (ln >> 3)) * PP + C_KC + h * 64 + (ln & 7) * 8; float a[8];
#pragma unroll
                  for (int e = 0; e < 8; ++e) a[e] = 0.f;
#pragma unroll 8
                  for (int i = 0; i < 32; ++i) { const u32x4 v = *(const u32x4*)(p + (size_t)i * 8 * PP);
                      a[0] += bf_lo(v.x); a[1] += bf_hi(v.x); a[2] += bf_lo(v.y); a[3] += bf_hi(v.y); a[4] += bf_lo(v.z); a[5] += bf_hi(v.z); a[6] += bf_lo(v.w); a[7] += bf_hi(v.w); }
#pragma unroll
                  for (int e = 0; e < 8; ++e) { a[e] += swz_xor<8>(a[e]); a[e] += swz_xor<16>(a[e]); a[e] = xsum32(a[e]); }
                  if (ln < 8) { float* o = kmean + (size_t)it * 64 + ln * 8;
                      *(f32x4*)o = (f32x4){a[0], a[1], a[2], a[3]} * (1.0f / 256.0f); *(f32x4*)(o + 4) = (f32x4){a[4], a[5], a[6], a[7]} * (1.0f / 256.0f); } } }
        }
        SEAM(pb + 1);
        if (IN(pb + 2)) {
            LAYER_LOCALS;
            const int myx = (int)(xb_xcc_id() & 7u);
            { unsigned* qctr8 = ctl + CW_Q + 64 * (16 + (2 * l + 0) * 8);
              for (;;) { const int r = att::wg_next8(qctr8, (NB * H_MLA / 8) * 16, myx, lds, att::L_Q, wave); if (r < 0) break;
                  const int x = r >> 16, i = r & 0xffff, qb = 15 - i / (NB * H_MLA / 8), bh = (i % (NB * H_MLA / 8)) * 8 + x; att::mla_unit2(bh / H_MLA, bh % H_MLA, qb, QM, PROJ, OB, ssq_c, lds, wave); } }
            { unsigned* qctr8 = ctl + CW_Q + 64 * (16 + (2 * l + 1) * 8);
              for (;;) { const int r = att::wg_next8(qctr8, (NB * H_MOBA / 8) * 16, myx, lds, att::L_Q, wave); if (r < 0) break;
                  const int x = r >> 16, i = r & 0xffff, j = 15 - i / (NB * H_MOBA / 8), bh = (i % (NB * H_MOBA / 8)) * 8 + x; att::moba_unit(bh / H_MOBA, bh % H_MOBA, j, PROJ, kmean, tmoba, OB, ssq_c, lds, wave); } }
            { unsigned* qctr = ctl + CW_Q + 64 * (3 * l + 2);
              asm volatile("s_nop 15\n\ts_waitcnt vmcnt(0) lgkmcnt(0)\n\ts_barrier" ::: "memory");
              { const int t2 = wave * 64 + lane_id(); for (int i = t2; i < 3 * 6 * 192; i += NWAVES * 64) ((LAS float*)(lds + att::D_TB))[i] = tdil[i]; }
              asm volatile("s_nop 15\n\ts_waitcnt vmcnt(0) lgkmcnt(0)\n\ts_barrier" ::: "memory");
              const int ln = lane_id();
              (void)ln; (void)qctr; att::dil_units(ctl + CW_Q + 64 * (80 + 8 * l), myx, PROJ, (bf16*)out, (float*)((unsigned char*)out + 72 * MiB), lds, wave); }
        }
        SEAM(pb + 2);
        if (IN(pb + 3)) {
            LAYER_LOCALS;
            const int lane = lane_id();
            float* rowsc = (float*)(ws + WS_ROWSC);
            for (int m = gw; m < M; m += NGW) {
                float f0[8]; float s0 = 0.f;
                if (lane < 48) {
                    const bf16* op = (const bf16*)out + (size_t)m * 384 + 8 * lane; const float* lp = (const float*)((const unsigned char*)out + 72 * MiB); const int hh_ = lane >> 3, bb_ = m >> 12, tt_ = m & (SEQ - 1);
                    const u32x4 a0 = *(const u32x4*)op, a1 = *(const u32x4*)(op + (size_t)M * 384), a2 = *(const u32x4*)(op + (size_t)2 * M * 384);
                    const float l0 = lp[((size_t)(0 * NB + bb_) * 6 + hh_) * SEQ + tt_],
                                l1 = lp[((size_t)(1 * NB + bb_) * 6 + hh_) * SEQ + (size_t)(tt_ & 3) * (SEQ >> 2) + (tt_ >> 2)],
                                l2 = lp[((size_t)(2 * NB + bb_) * 6 + hh_) * SEQ + (size_t)(tt_ & 15) * (SEQ >> 4) + (tt_ >> 4)]; const float mx = fmaxf(l0, fmaxf(l1, l2));
                    float w0 = exp2f(l0 - mx), w1 = exp2f(l1 - mx), w2 = exp2f(l2 - mx); const float iw = 1.0f / (w0 + w1 + w2); w0 *= iw; w1 *= iw; w2 *= iw;
                    f0[0] = w0 * bf_lo(a0.x) + w1 * bf_lo(a1.x) + w2 * bf_lo(a2.x); f0[1] = w0 * bf_hi(a0.x) + w1 * bf_hi(a1.x) + w2 * bf_hi(a2.x);
                    f0[2] = w0 * bf_lo(a0.y) + w1 * bf_lo(a1.y) + w2 * bf_lo(a2.y); f0[3] = w0 * bf_hi(a0.y) + w1 * bf_hi(a1.y) + w2 * bf_hi(a2.y);
                    f0[4] = w0 * bf_lo(a0.z) + w1 * bf_lo(a1.z) + w2 * bf_lo(a2.z); f0[5] = w0 * bf_hi(a0.z) + w1 * bf_hi(a1.z) + w2 * bf_hi(a2.z);
                    f0[6] = w0 * bf_lo(a0.w) + w1 * bf_lo(a1.w) + w2 * bf_lo(a2.w); f0[7] = w0 * bf_hi(a0.w) + w1 * bf_hi(a1.w) + w2 * bf_hi(a2.w);
                    u32x4 w; w.x = cvt_pk_bf16(f0[0], f0[1]); w.y = cvt_pk_bf16(f0[2], f0[3]); w.z = cvt_pk_bf16(f0[4], f0[5]); w.w = cvt_pk_bf16(f0[6], f0[7]);
                    *((u32x4*)(OB + (size_t)m * DM) + lane) = w;
                    s0 = bf_lo(w.x) * bf_lo(w.x) + bf_hi(w.x) * bf_hi(w.x) + bf_lo(w.y) * bf_lo(w.y) + bf_hi(w.y) * bf_hi(w.y) + bf_lo(w.z) * bf_lo(w.z) + bf_hi(w.z) * bf_hi(w.z) + bf_lo(w.w) * bf_lo(w.w) + bf_hi(w.w) * bf_hi(w.w);
                }
                const float sa = wave_sum(s0);
                if (lane == 0) { float qs[10];
#pragma unroll
                    for (int i = 0; i < 10; ++i) qs[i] = ssq_c[(size_t)i * M + m];
                    const float sb = ((qs[0] + qs[1]) + (qs[2] + qs[3])) + (qs[4] + qs[5]), sc = (qs[6] + qs[7]) + (qs[8] + qs[9]);
                    const float ra = rsqrtf(sa * (1.0f / 384.0f) + EPS), rb_ = rsqrtf(sb * (1.0f / 384.0f) + EPS), rc = rsqrtf(sc * (1.0f / 256.0f) + EPS);
                    *(f32x4*)(rowsc + (size_t)m * 4) = (f32x4){ra / rb_, rb_ / rc, rc, 0.f}; }
            }
        }
        SEAM(pb + 3);
        if (IN(pb + 4)) {
            LAYER_LOCALS;
            pg8::Gemm g{OB, (const bf16*)(wl + W_O), M, DM, DM, DM}; pg8::StaticOrder S; S.init(M, DM, G, bid);
            { const float* rowsc = (const float*)(ws + WS_ROWSC); LAS float* rst = (LAS float*)(lds + RS_OFF); const int t = wave * 64 + lane_id(); pg8::Unit uu;
              for (int i = 0; i < 2 && S.next(i, uu); ++i) if (t < 256) *(LAS f32x4*)(rst + (i * 256 + t) * 4) = *(const f32x4*)(rowsc + (size_t)(uu.pm * 256 + t) * 4);
              asm volatile("s_nop 15\n\ts_waitcnt vmcnt(0) lgkmcnt(0)\n\ts_barrier" ::: "memory"); }
            pg8::EpiRes<true> E{XB, ssq_mlp, 1.0f};
            pg8::gemm_phase<pg8::EpiRes<true>, false, pg8::StaticOrder, true>(lds, g, S, E, wave);
        }
        SEAM(pb + 4);
        if (IN(pb + 5)) {
            LAYER_LOCALS;
            pg8::Gemm g{XB, (const bf16*)(wl + W_UP), M, DFF, DM, DM}; pg8::StaticOrder S; S.init(M, DFF, G, bid);
            pg8::stage_rs<0>((LAS float*)(lds + RS_OFF), ssq_mlp, S, wave);
#if FP8_DOWN
            pg8::EpiUp8 E{(unsigned char*)UB, ssq_mlp};
            pg8::gemm_phase<pg8::EpiUp8>(lds, g, S, E, wave);
#else
            pg8::EpiUp E{UB, ssq_mlp};
            pg8::gemm_phase<pg8::EpiUp>(lds, g, S, E, wave);
#endif
        }
        SEAM(pb + 5);
        if (IN(pb + 6)) {
            LAYER_LOCALS;
            pg8::Gemm g{UB, (const bf16*)(wl + W_DOWN), M, DM, DFF, DFF}; pg8::StaticOrder S; S.init(M, DM, G, bid);
#if FP8_DOWN
            pg8::EpiRes<false> E{XB, ssq_x, 1.0f / 512.0f};
            pg8::gemm_phase<pg8::EpiRes<false>, true>(lds, g, S, E, wave);
#else
            pg8::EpiRes<false> E{XB, ssq_x, 1.0f};
            pg8::gemm_phase<pg8::EpiRes<false>>(lds, g, S, E, wave);
#endif
        }
        SEAM(pb + 6);
    }
    if (IN(29)) {
        PHASE_LOCALS;
        const float* ssq_f = ssq_all; const float* gf = args.in[13];
        const int lane = lane_id();
        for (int m = gw; m < M; m += NGW) {
            const float rs = rsqrtf(ssq16(ssq_f + m, (size_t)M) * (1.0f / DM) + EPS);
#pragma unroll
            for (int j = 0; j < 2; ++j) { const int c = 8 * (lane + 64 * j); const u32x4 v = *(const u32x4*)(XB + (size_t)m * DM + c);
                const f32x4 ga = *(const f32x4*)(gf + c), gb = *(const f32x4*)(gf + c + 4);
                f32x4 oa = (f32x4){bf_lo(v.x), bf_hi(v.x), bf_lo(v.y), bf_hi(v.y)} * rs * ga, ob = (f32x4){bf_lo(v.z), bf_hi(v.z), bf_lo(v.w), bf_hi(v.w)} * rs * gb;
                *(f32x4*)(out + (size_t)m * DM + c) = oa; *(f32x4*)(out + (size_t)m * DM + c + 4) = ob; }
        }
    }
#undef IN
#undef SEAM
}

extern "C" void kernel_launch(void* const* d_in, const int* in_sizes, int n_in, void* d_out, int out_size, void* d_ws, size_t ws_size, hipStream_t stream) {
    static int grid = 0;
    if (grid == 0) {
        if (n_in != 14 || in_sizes[0] != M * DM || out_size != M * DM || ws_size < WS_END) { fprintf(stderr, "kernel_launch: unexpected shapes (n_in %d, in0 %d, out %d, ws %zu); nothing launched\n", n_in, n_in > 0 ? in_sizes[0] : -1, out_size, ws_size); grid = -1; return; }
        int dev = 0, cus = 0, per_cu = 0;
        if (hipGetDevice(&dev) != hipSuccess || hipDeviceGetAttribute(&cus, hipDeviceAttributeMultiprocessorCount, dev) != hipSuccess) { grid = -1; return; }
        if (hipFuncSetAttribute((const void*)mk_fwd, hipFuncAttributeMaxDynamicSharedMemorySize, LDS_BYTES) != hipSuccess) { fprintf(stderr, "kernel_launch: hipFuncSetAttribute failed\n"); grid = -1; return; }
        if (hipOccupancyMaxActiveBlocksPerMultiprocessor(&per_cu, (const void*)mk_fwd, NWAVES * 64, LDS_BYTES) != hipSuccess || per_cu < 1)
            fprintf(stderr, "kernel_launch: note: occupancy query reports %d workgroups per CU\n", per_cu);
        (void)hipGetLastError();
        grid = cus;
    }
    if (grid < 0) return;
    if (hipMemsetAsync((char*)d_ws + WS_CTL, 0, CTL_ZERO_BYTES, stream) != hipSuccess) { fprintf(stderr, "kernel_launch: memset failed\n"); return; }
    Args a{};
    for (int i = 0; i < 14; ++i) a.in[i] = (const float*)d_in[i];
    a.out = (float*)d_out; a.ws = (unsigned char*)d_ws; a.pad = 0;
#if MK_PER_PHASE
    for (int p = 0; p < N_PHASES; ++p) { a.ph_lo = p; a.ph_hi = p + 1; a.li = 0;
        hipLaunchKernelGGL(mk_fwd, dim3(grid), dim3(NWAVES * 64), LDS_BYTES, stream, a); }
#else
    a.ph_lo = 0; a.ph_hi = N_PHASES; a.li = 0;
    hipLaunchKernelGGL(mk_fwd, dim3(grid), dim3(NWAVES * 64), LDS_BYTES, stream, a);
#endif
    const hipError_t le = hipPeekAtLastError();
    if (le != hipSuccess) fprintf(stderr, "kernel_launch: launch failed: %s\n", hipGetErrorName(le));
}
```

```cpp
#include <hip/hip_runtime.h>
#include <cstdio>
#include <cstdint>

#define LAS __attribute__((address_space(3)))
#define GAS __attribute__((address_space(1)))
typedef unsigned short bf16;
typedef short bf16x8 __attribute__((ext_vector_type(8)));
typedef float f32x4 __attribute__((ext_vector_type(4)));
typedef float f32x2 __attribute__((ext_vector_type(2)));
typedef unsigned u32x4 __attribute__((ext_vector_type(4)));
typedef unsigned u32x2 __attribute__((ext_vector_type(2)));
typedef int i32x4 __attribute__((ext_vector_type(4)));
typedef int i32x8 __attribute__((ext_vector_type(8)));

#ifndef FP8_DOWN
#define FP8_DOWN 1
#endif
#ifndef MK_PER_PHASE
#define MK_PER_PHASE 0
#endif

constexpr int NB = 8, SEQ = 4096, DM = 1024, DEPTH = 4, M = NB * SEQ, DFF = 4096;
constexpr int DIN = 2464, PP = 2560  , QP = 1536  ;
constexpr int H_DIL = 6, H_MLA = 6, H_MOBA = 4;
constexpr int C_QA = 0, C_KA = 384, C_VA = 768, C_CQ = 1152, C_CKV = 1536, C_KR = 1664, C_QC = 1728, C_KC = 1984, C_VC = 2240;
constexpr int Q_NOPE = 0, Q_ROPE = 384, Q_KV = 768;
constexpr int O_A = 0, O_B = 384, O_C = 768;
constexpr float EPS = 1e-6f;
constexpr float LOG2E = 1.4426950408889634f;
constexpr float QS_64 = 0.125f * LOG2E;
constexpr float QS_96 = 0.10206207261596575f * LOG2E;

constexpr size_t MiB = 1u << 20;
constexpr size_t WS_CTL = 0, CTL_ZERO_BYTES = 1 * MiB;
constexpr size_t WS_SSQ = 1 * MiB;
constexpr size_t WS_ROPE = 7 * MiB;
constexpr size_t WS_TMOBA = 7 * MiB + 512 * 1024;
constexpr size_t WS_TDIL = WS_TMOBA + 64 * 1024;
constexpr size_t WS_KMEAN = 7 * MiB + 768 * 1024;
constexpr size_t WS_W = 8 * MiB, W_STRIDE = 25 * MiB;
constexpr size_t W_IN = 0, W_MLA = 5 * MiB, W_O = 6 * MiB + 512 * 1024, W_UP = 8 * MiB + 512 * 1024, W_DOWN = 16 * MiB + 512 * 1024;
constexpr size_t WS_ROWSC = 108 * MiB;
constexpr size_t WS_XB = 112 * MiB;
constexpr size_t WS_PROJ = 176 * MiB;
constexpr size_t WS_QM = 336 * MiB;
constexpr size_t WS_O = 432 * MiB;
constexpr size_t WS_U = WS_PROJ;
constexpr size_t WS_END = 496 * MiB;
static_assert(WS_PROJ + (size_t)M * PP * 2 == WS_QM && WS_QM + (size_t)M * QP * 2 == WS_O && WS_U + (size_t)M * DFF * 2 <= WS_O && WS_O + (size_t)M * DM * 2 == WS_END, "ws map");
static_assert(WS_W + DEPTH * W_STRIDE <= WS_XB && WS_XB + (size_t)M * DM * 2 == WS_PROJ, "ws map 2");
constexpr int CW_Q = 1024;
constexpr int CW_BAR = 16384;
constexpr int N_PHASES = 30;

constexpr int RING_BYTES = 131072;
constexpr int LDSCTL_OFF = RING_BYTES, MISC_OFF = LDSCTL_OFF + 320;
constexpr int RS_OFF = 132096;
constexpr int LDS_BYTES = 147456;
constexpr int NWAVES = 8;

#define LDS_WAIT() asm volatile("s_waitcnt lgkmcnt(0)" ::: "memory")
#define VM_WAIT() asm volatile("s_waitcnt vmcnt(0)" ::: "memory")
typedef __bf16 bf16x2_t __attribute__((ext_vector_type(2)));
__device__ __forceinline__ unsigned cvt_pk_bf16(float lo, float hi) { const f32x2 v = {lo, hi}; const bf16x2_t b = __builtin_convertvector(v, bf16x2_t); return __builtin_bit_cast(unsigned, b); }
__device__ __forceinline__ float bf_lo(unsigned u) { return __uint_as_float(u << 16); }
__device__ __forceinline__ float bf_hi(unsigned u) { return __uint_as_float(u & 0xffff0000u); }
__device__ __forceinline__ float dot8(u32x4 a, u32x4 b, float s) {
    s = fmaf(bf_lo(a.x), bf_lo(b.x), s); s = fmaf(bf_hi(a.x), bf_hi(b.x), s);
    s = fmaf(bf_lo(a.y), bf_lo(b.y), s); s = fmaf(bf_hi(a.y), bf_hi(b.y), s);
    s = fmaf(bf_lo(a.z), bf_lo(b.z), s); s = fmaf(bf_hi(a.z), bf_hi(b.z), s);
    s = fmaf(bf_lo(a.w), bf_lo(b.w), s); s = fmaf(bf_hi(a.w), bf_hi(b.w), s);
    return s;
}
__device__ __forceinline__ int lane_id() { int l; asm volatile("v_mbcnt_lo_u32_b32 %0, -1, 0\n\tv_mbcnt_hi_u32_b32 %0, -1, %0" : "=v"(l)); return l; }
template <int X> __device__ __forceinline__ float swz_xor(float v) { return __int_as_float(__builtin_amdgcn_ds_swizzle(__float_as_int(v), (X << 10) | 0x1f)); }
__device__ __forceinline__ float xsum32(float v) { auto rr = __builtin_amdgcn_permlane32_swap(__float_as_uint(v), __float_as_uint(v), false, false); return __uint_as_float(rr[0]) + __uint_as_float(rr[1]); }
__device__ __forceinline__ float wave_sum(float v) { v += swz_xor<1>(v); v += swz_xor<2>(v); v += swz_xor<4>(v); v += swz_xor<8>(v); v += swz_xor<16>(v); return xsum32(v); }
__device__ __forceinline__ float sum4(const f32x4& a) { return (a[0] + a[1]) + (a[2] + a[3]); }
__device__ __forceinline__ float ssq16(const float* p, size_t st) { float a[16];
#pragma unroll
    for (int i = 0; i < 16; ++i) a[i] = p[(size_t)i * st];
    return ((((a[0] + a[1]) + (a[2] + a[3])) + ((a[4] + a[5]) + (a[6] + a[7]))) + (((a[8] + a[9]) + (a[10] + a[11])) + ((a[12] + a[13]) + (a[14] + a[15])))); }

namespace pg8 {
constexpr int BM = 256, BK = 64, HALF = 128, HTB = HALF * BK * 2, STAGE_BYTES = 8 * HTB, NXCD = 8, WGM = 8;
__host__ __device__ __forceinline__ int lds_byte(int r, int c) { const int st = (r >> 4) * 2 + (c >> 5), rr = r & 15, cc = c & 31, ob = rr * 64 + cc * 2; return st * 1024 + (ob ^ (((ob >> 9) & 1) << 5)); }
__host__ __device__ __forceinline__ void stage_rc(int b, int& R, int& C) { const int st = b / 1024, sb = b % 1024, swz = sb ^ (((sb >> 9) & 1) << 5); R = (st >> 1) * 16 + swz / 64; C = (st & 1) * 32 + (swz % 64) / 2; }
__host__ __device__ __forceinline__ int perm32(int rho) { const int n = rho >> 4, i = rho & 15; return 8 * (i >> 2) + 4 * n + (i & 3); }

struct Unit { int pm, pn; };
struct Gemm { const bf16* A; const bf16* Bt; int M, N, K, lda; };

struct StaticOrder {
    int nM, nN, nwg, G, c;
    __host__ __device__ __forceinline__ void init(int M_, int N_, int G_, int c_) { nM = M_ / BM; nN = N_ / BM; nwg = nM * nN; G = G_; c = c_; }
    __host__ __device__ __forceinline__ bool next(int i, Unit& u) const {
        const long L = (long)i * G + c; if (L >= nwg) return false;
        int wgid = (int)L; { const int q = nwg / NXCD, r = nwg % NXCD, xcd = wgid % NXCD, off = wgid / NXCD; wgid = (xcd < r ? xcd * (q + 1) : r * (q + 1) + (xcd - r) * q) + off; }
        const int nig = WGM * nN, gid = wgid / nig, fm = gid * WGM, gsz = (nM - fm) < WGM ? (nM - fm) : WGM;
        u.pm = fm + ((wgid % nig) % gsz); u.pn = (wgid % nig) / gsz; return true;
    }
    __host__ __device__ __forceinline__ void krange(const Unit&, int& kt0, int& ntu, int ntfull) const { kt0 = 0; ntu = ntfull; }
};
struct MlaOrder {
    int c;
    __host__ __device__ __forceinline__ bool next(int i, Unit& u) const { if (i >= 3 || c >= 256) return false; u.pm = c >> 1; const int odd = c & 1; u.pn = odd ? (i == 0 ? 2 : 3 + i) : (i == 2 ? 3 : i); return true; }
    __host__ __device__ __forceinline__ void krange(const Unit& u, int& kt0, int& ntu, int) const { if (u.pn < 3) { kt0 = 0; ntu = 6; } else { kt0 = 6; ntu = 2; } }
};

template <class Epi, bool F8 = false, class Sched = StaticOrder, bool RSC = false>
__device__ __forceinline__ void gemm_phase(LAS unsigned char* lds, const Gemm g, const Sched& S, const Epi& E, const int wid  ) {
    const int lane = lane_id(), tid = wid * 64 + lane;
    const int wr = wid >> 2, wc = wid & 3, fr = lane & 15, fq = lane >> 4;
    constexpr int ESZ = F8 ? 1 : 2;
    const int K = g.K, ntfull = K * ESZ / (BK * 2), lda = g.lda;
    unsigned voffA[2], voffB[2];
#pragma unroll
    for (int i = 0; i < 2; ++i) { int R, C; stage_rc(tid * 16 + i * 8192, R, C); const int Rb = Epi::PERM ? ((R & ~31) + perm32(R & 31)) : R;
        voffA[i] = (unsigned)(R * lda * ESZ + C * 2); voffB[i] = (unsigned)(Rb * K * ESZ + C * 2); }
    const size_t kstep = (size_t)(BK * 2);
    const size_t hstepA = (size_t)HALF * lda * ESZ, hstepB = (size_t)HALF * K * ESZ;
    const size_t tstepA = 2 * hstepA, tstepB = 2 * hstepB;
    const unsigned ldsw = (unsigned)wid * 1024u;
    const int aoff = lds_byte(wr * 64 + fr, fq * 8), boff = lds_byte(wc * 32 + fr, fq * 8);
#define PG8_SA(b, h) (((b) * 2 + (h)) * HTB)
#define PG8_SB(b, h) ((4 + (b) * 2 + (h)) * HTB)
#define PG8_STAGE(bufoff, gbase, voff) do { _Pragma("unroll") for (int _i = 0; _i < 2; ++_i) { unsigned vo_ = (voff)[_i]; asm volatile("" : "+v"(vo_));   \
        __builtin_amdgcn_global_load_lds((const unsigned*)((const char*)(gbase) + vo_), (LAS unsigned*)(lds + (bufoff) + ldsw + _i * 8192), 16, 0, 0); } } while (0)
#define PG8_RD2(p) __builtin_shufflevector(*(const LAS i32x4*)(p), *(const LAS i32x4*)((p) + 1024), 0, 1, 2, 3, 4, 5, 6, 7)
#define PG8_LDA(dst, b, h) do { _Pragma("unroll") for (int m = 0; m < 4; ++m) dst[m] = PG8_RD2(lds + PG8_SA(b, h) + aoff + m * 2048); } while (0)
#define PG8_LDB(dst, b, h) do { _Pragma("unroll") for (int n = 0; n < 2; ++n) dst[n] = PG8_RD2(lds + PG8_SB(b, h) + boff + n * 2048); } while (0)
#define PG8_LO(x) __builtin_bit_cast(bf16x8, __builtin_shufflevector(x, x, 0, 1, 2, 3))
#define PG8_HI(x) __builtin_bit_cast(bf16x8, __builtin_shufflevector(x, x, 4, 5, 6, 7))
#define PG8_MMA(ai, bj, At, Bt) do { __builtin_amdgcn_s_setprio(1); _Pragma("unroll") for (int m = 0; m < 4; ++m) _Pragma("unroll") for (int n = 0; n < 2; ++n) { \
        if constexpr (F8) acc[ai][bj][m][n] = __builtin_amdgcn_mfma_scale_f32_16x16x128_f8f6f4(Bt[n], At[m], acc[ai][bj][m][n], 0, 0, 0, 0x7f7f7f7f, 0, 0x7f7f7f7f); \
        else { acc[ai][bj][m][n] = __builtin_amdgcn_mfma_f32_16x16x32_bf16(PG8_LO(Bt[n]), PG8_LO(At[m]), acc[ai][bj][m][n], 0, 0, 0); \
               acc[ai][bj][m][n] = __builtin_amdgcn_mfma_f32_16x16x32_bf16(PG8_HI(Bt[n]), PG8_HI(At[m]), acc[ai][bj][m][n], 0, 0, 0); } } \
        __builtin_amdgcn_s_setprio(0); } while (0)
#define PG8_MMAZ(ai, bj, At, Bt)     do { __builtin_amdgcn_s_setprio(1); _Pragma("unroll") for (int m = 0; m < 4; ++m) _Pragma("unroll") for (int n = 0; n < 2; ++n) { \
        if constexpr (F8) acc[ai][bj][m][n] = __builtin_amdgcn_mfma_scale_f32_16x16x128_f8f6f4(Bt[n], At[m], (f32x4){0.f, 0.f, 0.f, 0.f}, 0, 0, 0, 0x7f7f7f7f, 0, 0x7f7f7f7f); \
        else { acc[ai][bj][m][n] = __builtin_amdgcn_mfma_f32_16x16x32_bf16(PG8_LO(Bt[n]), PG8_LO(At[m]), (f32x4){0.f, 0.f, 0.f, 0.f}, 0, 0, 0); \
               acc[ai][bj][m][n] = __builtin_amdgcn_mfma_f32_16x16x32_bf16(PG8_HI(Bt[n]), PG8_HI(At[m]), acc[ai][bj][m][n], 0, 0, 0); } } \
        __builtin_amdgcn_s_setprio(0); } while (0)
#define PG8_WAIT_V(n) asm volatile("s_waitcnt vmcnt(" #n ")" ::: "memory")
#define PG8_WAIT_L(n) asm volatile("s_waitcnt lgkmcnt(" #n ")" ::: "memory")
#define PG8_BAR __builtin_amdgcn_s_barrier()
#define PG8_SCHED __builtin_amdgcn_sched_barrier(0)
    Unit cur, nxt; int ui = 0;
    if (!S.next(0, cur)) return;
    f32x4 acc[2][2][4][2];
    i32x8 At[4], B0[2], B1[2];
    int kt0, nt; S.krange(cur, kt0, nt, ntfull);
    const char* cA = (const char*)g.A + (size_t)cur.pm * tstepA + (size_t)kt0 * kstep; const char* cB = (const char*)g.Bt + (size_t)cur.pn * tstepB + (size_t)kt0 * kstep;
    PG8_STAGE(PG8_SB(0, 0), cB, voffB); PG8_STAGE(PG8_SB(0, 1), cB + hstepB, voffB); PG8_STAGE(PG8_SA(0, 0), cA, voffA); PG8_STAGE(PG8_SA(0, 1), cA + hstepA, voffA);
    if (wr == 1) PG8_BAR;
    PG8_WAIT_V(2); PG8_BAR;
    PG8_STAGE(PG8_SB(1, 0), cB + kstep, voffB); PG8_STAGE(PG8_SA(1, 0), cA + kstep, voffA); PG8_STAGE(PG8_SB(1, 1), cB + hstepB + kstep, voffB);
    PG8_WAIT_V(6); PG8_BAR;
    for (;;) {
        const bool has_next = S.next(ui + 1, nxt);
        int nkt0 = kt0, nnt = nt; if (has_next) S.krange(nxt, nkt0, nnt, ntfull);
        const char* nA = has_next ? (const char*)g.A + (size_t)nxt.pm * tstepA + (size_t)nkt0 * kstep : cA; const char* nB = has_next ? (const char*)g.Bt + (size_t)nxt.pn * tstepB + (size_t)nkt0 * kstep : cB;
#define PG8_BODY(t, MM_) do { \
            const bool last = (t == nt - 2); \
            const char* a1 = cA + (size_t)(t + 1) * kstep; \
            const char* a2 = last ? nA : cA + (size_t)(t + 2) * kstep; const char* b2 = last ? nB : cB + (size_t)(t + 2) * kstep; \
            const char* a3 = a2 + kstep; const char* b3 = b2 + kstep; \
            PG8_LDB(B0, 0, 0); PG8_LDB(B1, 0, 1); PG8_SCHED; PG8_LDA(At, 0, 0); PG8_STAGE(PG8_SA(1, 1), a1 + hstepA, voffA); \
            PG8_WAIT_V(8); PG8_WAIT_L(0); PG8_BAR; MM_(0, 0, At, B0); MM_(0, 1, At, B1); PG8_BAR; PG8_SCHED; \
            PG8_LDA(At, 0, 1); PG8_STAGE(PG8_SB(0, 0), b2, voffB); PG8_STAGE(PG8_SB(0, 1), b2 + hstepB, voffB); PG8_STAGE(PG8_SA(0, 0), a2, voffA); \
            PG8_WAIT_V(8); PG8_WAIT_L(0); PG8_BAR; MM_(1, 0, At, B0); MM_(1, 1, At, B1); PG8_BAR; PG8_SCHED; \
            PG8_LDB(B0, 1, 0); PG8_LDB(B1, 1, 1); PG8_SCHED; PG8_LDA(At, 1, 0); PG8_STAGE(PG8_SA(0, 1), a2 + hstepA, voffA); \
            PG8_WAIT_V(8); PG8_WAIT_L(0); PG8_BAR; PG8_MMA(0, 0, At, B0); PG8_MMA(0, 1, At, B1); PG8_BAR; PG8_SCHED; \
            PG8_LDA(At, 1, 1); PG8_STAGE(PG8_SB(1, 0), b3, voffB); PG8_STAGE(PG8_SB(1, 1), b3 + hstepB, voffB); PG8_STAGE(PG8_SA(1, 0), a3, voffA); \
            PG8_WAIT_V(8); PG8_WAIT_L(0); PG8_BAR; PG8_MMA(1, 0, At, B0); PG8_MMA(1, 1, At, B1); PG8_BAR; PG8_SCHED; \
        } while (0)
        if constexpr (F8) {
#pragma unroll
            for (int a = 0; a < 2; ++a)
#pragma unroll
                for (int b = 0; b < 2; ++b)
#pragma unroll
                    for (int m = 0; m < 4; ++m)
#pragma unroll
                        for (int n = 0; n < 2; ++n) acc[a][b][m][n] = (f32x4){0.f, 0.f, 0.f, 0.f};
        } else PG8_BODY(0, PG8_MMAZ);
        for (int t = F8 ? 0 : 2; t < nt; t += 2) {
            if constexpr (RSC) { if (t == 6 || t == 12) { const LAS float* rr_ = (const LAS float*)(lds + RS_OFF) + (ui * 256 + wr * 64 + fr) * 4 + (t == 6 ? 0 : 1);
#pragma unroll
                for (int ai = 0; ai < 2; ++ai)
#pragma unroll
                    for (int m = 0; m < 4; ++m) { const float f_ = rr_[(ai * HALF + m * 16) * 4];
#pragma unroll
                        for (int bj = 0; bj < 2; ++bj)
#pragma unroll
                            for (int n = 0; n < 2; ++n) acc[ai][bj][m][n] *= f_; } } }
            PG8_BODY(t, PG8_MMA);
        }
#undef PG8_BODY
        if (wr == 0) PG8_BAR;
        { const int le = lane_id(); E(acc, cur, ui, (const LAS float*)(lds + RS_OFF - 0), wr, wc, le & 15, le >> 4); }
        if (!has_next) break;
        cur = nxt; cA = nA; cB = nB; nt = nnt; kt0 = nkt0; ++ui;
        if (wr == 1) PG8_BAR;
    }
    PG8_WAIT_V(0);
    PG8_BAR;
#undef PG8_SA
#undef PG8_SB
#undef PG8_STAGE
#undef PG8_LDA
#undef PG8_LDB
#undef PG8_MMA
#undef PG8_MMAZ
#undef PG8_LO
#undef PG8_HI
#undef PG8_RD2
#undef PG8_WAIT_V
#undef PG8_WAIT_L
#undef PG8_BAR
#undef PG8_SCHED
}

template <int MODE, class Sched> __device__ __forceinline__ void stage_rs(LAS float* rst, const float* ssq, const Sched& S, int wave) {
    const int t = wave * 64 + lane_id(), half = t >> 8, row = t & 255;
    f32x4 q[4][4]; int pn_[4]; bool ok[4];
#pragma unroll
    for (int k = 0; k < 4; ++k) { Unit u; ok[k] = S.next(2 * k + half, u); pn_[k] = ok[k] ? u.pn : 0; const int pm = ok[k] ? u.pm : 0;
        const float* p = ssq + (size_t)(pm * BM + row);
#pragma unroll
        for (int j = 0; j < 4; ++j) q[k][j] = (f32x4){p[(size_t)(4 * j) * M], p[(size_t)(4 * j + 1) * M], p[(size_t)(4 * j + 2) * M], p[(size_t)(4 * j + 3) * M]}; }
#pragma unroll
    for (int k = 0; k < 4; ++k) if (ok[k]) { float r;
        if (MODE == 0) r = rsqrtf(((sum4(q[k][0]) + sum4(q[k][1])) + (sum4(q[k][2]) + sum4(q[k][3]))) * (1.0f / DM) + EPS);
        else r = pn_[k] < 3 ? rsqrtf(((sum4(q[k][0]) + sum4(q[k][1])) + sum4(q[k][2])) * (1.0f / 384.0f) + EPS) : rsqrtf(sum4(q[k][3]) * (1.0f / 128.0f) + EPS);
        rst[(2 * k + half) * 256 + row] = r; }
    asm volatile("s_nop 15\n\ts_waitcnt vmcnt(0) lgkmcnt(0)\n\ts_barrier" ::: "memory");
}

__device__ __forceinline__ void rope_consts(float (&crev)[4], int i0) {
#pragma unroll
    for (int p = 0; p < 4; ++p) crev[p] = __builtin_amdgcn_exp2f(-(float)(i0 + p) * (13.287712379549449f / 16.0f)) * 0.15915494309189535f;
}
__device__ __forceinline__ void rope8(f32x4& v0, f32x4& v1, int pos, const float (&crev)[4]) {
    float c[4], sn[4];
#pragma unroll
    for (int p = 0; p < 4; ++p) { float rev = (float)pos * crev[p]; rev = __builtin_amdgcn_fractf(rev); c[p] = __builtin_amdgcn_cosf(rev); sn[p] = __builtin_amdgcn_sinf(rev); }
    f32x4 a, b;
    a[0] = v0[0] * c[0] - v0[1] * sn[0]; a[1] = v0[1] * c[0] + v0[0] * sn[0];
    a[2] = v0[2] * c[1] - v0[3] * sn[1]; a[3] = v0[3] * c[1] + v0[2] * sn[1];
    b[0] = v1[0] * c[2] - v1[1] * sn[2]; b[1] = v1[1] * c[2] + v1[0] * sn[2];
    b[2] = v1[2] * c[3] - v1[3] * sn[3]; b[3] = v1[3] * c[3] + v1[2] * sn[3];
    v0 = a; v1 = b;
}
__device__ __forceinline__ float sumsq8(const f32x4& a, const f32x4& b) { return (a[0] * a[0] + a[1] * a[1]) + (a[2] * a[2] + a[3] * a[3]) + (b[0] * b[0] + b[1] * b[1]) + (b[2] * b[2] + b[3] * b[3]); }
__device__ __forceinline__ u32x4 pack8(const f32x4& a, const f32x4& b) { u32x4 w; w.x = cvt_pk_bf16(a[0], a[1]); w.y = cvt_pk_bf16(a[2], a[3]); w.z = cvt_pk_bf16(b[0], b[1]); w.w = cvt_pk_bf16(b[2], b[3]); return w; }

struct EpiProj {
    static constexpr bool PERM = true;
    bf16* O; const float* ssq_x; float* ssq_c; const f32x2* cs;
    __device__ __forceinline__ void operator()(const f32x4 (&acc)[2][2][4][2], const Unit& u, int ui, const LAS float* rst, int wr, int wc, int fr, int fq) const {
        const int row0 = u.pm * BM + wr * 64 + fr, colb = u.pn * BM + wc * 32 + 8 * fq;
        const bool sp = (u.pn >= 4 && u.pn <= 6);
        float crev[4]; rope_consts(crev, 4 * fq);
#pragma unroll
        for (int ai = 0; ai < 2; ++ai)
#pragma unroll
            for (int m = 0; m < 4; ++m) { const int row = row0 + ai * HALF + m * 16; const float rs = rst[ui * 256 + row - u.pm * BM];
                bf16* rowp = O + (size_t)row * PP + colb;
#pragma unroll
                for (int bj = 0; bj < 2; ++bj) { f32x4 v0 = acc[ai][bj][m][0] * rs, v1 = acc[ai][bj][m][1] * rs;
                    if (sp) {
                        if (u.pn == 6 && bj == 1 && wc == 0) rope8(v0, v1, row & (SEQ - 1), crev);
                        const bool is_cq = (u.pn == 4 && bj == 1) || (u.pn == 5), is_ckv = (u.pn == 6 && bj == 0);
                        if (is_cq || is_ckv) { float s = sumsq8(v0, v1); s += swz_xor<16>(s); s = xsum32(s);
                            const int slot = (is_ckv ? 12 : (u.pn == 4 ? 0 : 4 + 4 * bj)) + wc;
                            if (fq == 0) ssq_c[(size_t)slot * M + row] = s; }
                    }
                    *(u32x4*)(rowp + bj * HALF) = pack8(v0, v1); } }
    }
};
struct EpiMla {
    static constexpr bool PERM = true;
    bf16* O; const float* ssq_c; const f32x2* cs;
    __device__ __forceinline__ void operator()(const f32x4 (&acc)[2][2][4][2], const Unit& u, int ui, const LAS float* rst, int wr, int wc, int fr, int fq) const {
        const int row0 = u.pm * BM + wr * 64 + fr, colb = u.pn * BM + wc * 32 + 8 * fq;
        const bool isq = u.pn < 3;
        float crev[4]; rope_consts(crev, 4 * fq);
#pragma unroll
        for (int ai = 0; ai < 2; ++ai)
#pragma unroll
            for (int m = 0; m < 4; ++m) { const int row = row0 + ai * HALF + m * 16;
                const float rs = rst[ui * 256 + row - u.pm * BM];
                bf16* rowp = O + (size_t)row * QP + colb;
#pragma unroll
                for (int bj = 0; bj < 2; ++bj) { f32x4 v0 = acc[ai][bj][m][0] * rs, v1 = acc[ai][bj][m][1] * rs;
                    if ((u.pn == 1 && bj == 1) || (u.pn == 2 && bj == 0)) rope8(v0, v1, row & (SEQ - 1), crev);
                    *(u32x4*)(rowp + bj * HALF) = pack8(v0, v1); } }
    }
};
template <bool RS> struct EpiRes {
    static constexpr bool PERM = true;
    bf16* xb; float* ssq; float ascale;
    __device__ __forceinline__ void operator()(const f32x4 (&acc)[2][2][4][2], const Unit& u, int ui, const LAS float* rst, int wr, int wc, int fr, int fq) const {
        const int row0 = u.pm * BM + wr * 64 + fr, colb = u.pn * BM + wc * 32 + 8 * fq;
        u32x4 old[2][4][2];
#pragma unroll
        for (int ai = 0; ai < 2; ++ai)
#pragma unroll
            for (int m = 0; m < 4; ++m)
#pragma unroll
                for (int bj = 0; bj < 2; ++bj) old[ai][m][bj] = *(const u32x4*)(xb + (size_t)(row0 + ai * HALF + m * 16) * DM + colb + bj * HALF);
#pragma unroll
        for (int ai = 0; ai < 2; ++ai)
#pragma unroll
            for (int m = 0; m < 4; ++m) { const int row = row0 + ai * HALF + m * 16; bf16* rowp = xb + (size_t)row * DM + colb; float s = 0.f;
                const float asc = RS ? ascale * rst[(ui * 256 + row - u.pm * BM) * 4 + 2] : ascale;
#pragma unroll
                for (int bj = 0; bj < 2; ++bj) { const u32x4 o4 = old[ai][m][bj];
                    const f32x4 v0 = acc[ai][bj][m][0] * asc + (f32x4){bf_lo(o4.x), bf_hi(o4.x), bf_lo(o4.y), bf_hi(o4.y)}, v1 = acc[ai][bj][m][1] * asc + (f32x4){bf_lo(o4.z), bf_hi(o4.z), bf_lo(o4.w), bf_hi(o4.w)};
                    s += sumsq8(v0, v1); *(u32x4*)(rowp + bj * HALF) = pack8(v0, v1); }
                s += swz_xor<16>(s); s = xsum32(s);
                if (fq == 0) ssq[(size_t)(u.pn * 4 + wc) * M + row] = s; }
    }
};
struct EpiUp {
    static constexpr bool PERM = true;
    bf16* O; const float* ssq;
    __device__ __forceinline__ void operator()(const f32x4 (&acc)[2][2][4][2], const Unit& u, int ui, const LAS float* rst, int wr, int wc, int fr, int fq) const {
        const int row0 = u.pm * BM + wr * 64 + fr, colb = u.pn * BM + wc * 32 + 8 * fq;
#pragma unroll
        for (int ai = 0; ai < 2; ++ai)
#pragma unroll
            for (int m = 0; m < 4; ++m) { const int row = row0 + ai * HALF + m * 16; const float rs = rst[ui * 256 + row - u.pm * BM];
                bf16* rowp = O + (size_t)row * DFF + colb;
#pragma unroll
                for (int bj = 0; bj < 2; ++bj) { f32x4 v0 = acc[ai][bj][m][0] * rs, v1 = acc[ai][bj][m][1] * rs;
#pragma unroll
                    for (int e = 0; e < 4; ++e) { const float a = fmaxf(v0[e], 0.f), b = fmaxf(v1[e], 0.f); v0[e] = a * a; v1[e] = b * b; }
                    *(u32x4*)(rowp + bj * HALF) = pack8(v0, v1); } }
    }
};
__device__ __forceinline__ unsigned pk4_fp8(const f32x4& v) { unsigned w = 0u; w = __builtin_amdgcn_cvt_pk_fp8_f32(v[0], v[1], w, false); w = __builtin_amdgcn_cvt_pk_fp8_f32(v[2], v[3], w, true); return w; }
struct EpiUp8 {
    static constexpr bool PERM = true;
    unsigned char* O; const float* ssq;
    __device__ __forceinline__ void operator()(const f32x4 (&acc)[2][2][4][2], const Unit& u, int ui, const LAS float* rst, int wr, int wc, int fr, int fq) const {
        const int row0 = u.pm * BM + wr * 64 + fr, colb = u.pn * BM + wc * 32 + 8 * fq;
#pragma unroll
        for (int ai = 0; ai < 2; ++ai)
#pragma unroll
            for (int m = 0; m < 4; ++m) { const int row = row0 + ai * HALF + m * 16; const float rs = rst[ui * 256 + row - u.pm * BM];
                unsigned char* rowp = O + (size_t)row * DFF + colb;
                u32x2 w[2];
#pragma unroll
                for (int bj = 0; bj < 2; ++bj) { f32x4 v0 = acc[ai][bj][m][0] * rs, v1 = acc[ai][bj][m][1] * rs;
#pragma unroll
                    for (int e = 0; e < 4; ++e) { const float a = fmaxf(v0[e], 0.f), b = fmaxf(v1[e], 0.f); v0[e] = fminf(a * a * 8.0f, 448.0f); v1[e] = fminf(b * b * 8.0f, 448.0f); }
                    w[bj].x = pk4_fp8(v0); w[bj].y = pk4_fp8(v1); }
                { auto sx = __builtin_amdgcn_permlane16_swap(w[0].x, w[1].x, false, false); auto sy = __builtin_amdgcn_permlane16_swap(w[0].y, w[1].y, false, false);
                  const u32x4 o = {sx[0], sy[0], sx[1], sy[1]};
                  *(u32x4*)(rowp + ((fq & 1) ? HALF - 8 : 0)) = o; } }
    }
};
}

#define XB_TMO      128
#define XB_XCNT(j)  (256  + 64 * (j))
#define XB_XSUB(j)  (1280 + 64 * (j))
#define XB_XGEN(j)  (2304 + 64 * (j))
#define XB_TOP      3328
#define XB_TOPGEN   3392
#define XCD_BAR_WORDS 3456
#define XB_SPIN_CAP (1u << 18)
__device__ __forceinline__ unsigned xb_ld(unsigned* p)              { return __hip_atomic_load(p, __ATOMIC_RELAXED, __HIP_MEMORY_SCOPE_AGENT); }
__device__ __forceinline__ unsigned xb_add(unsigned* p, unsigned v) { return __hip_atomic_fetch_add(p, v, __ATOMIC_RELAXED, __HIP_MEMORY_SCOPE_AGENT); }
__device__ __forceinline__ unsigned xb_xcc_id() { return (unsigned)__builtin_amdgcn_s_getreg((3 << 11) | 20) & 0xFu; }
#define XB_SPIN(cond, bar) do { unsigned _sp = 0; while (cond) { __builtin_amdgcn_s_sleep(1); \
    if ((++_sp & 255u) == 0u) { if (xb_ld(&(bar)[XB_TMO])) break; if (_sp > XB_SPIN_CAP) { atomicAdd(&(bar)[XB_TMO], 1u); break; } } } } while (0)
struct XcdBarrier { unsigned* bar; unsigned x; volatile LAS unsigned* st; };
__device__ __forceinline__ XcdBarrier xcd_barrier_post(unsigned* bar, volatile LAS unsigned* st, bool t0  ) {
    XcdBarrier b; b.bar = bar; b.x = xb_xcc_id(); b.st = st;
    if (t0) (void)xb_add(&bar[XB_XCNT(b.x)], 1u);
    return b;
}
__device__ __forceinline__ void xcd_barrier_complete(unsigned* bar, unsigned x, unsigned& nloc, unsigned& nx) {
    const unsigned G = gridDim.x * gridDim.y * gridDim.z;
    unsigned sum, cnt, mine, sp = 0u;
    for (;;) {
        sum = 0u; cnt = 0u; mine = 0u;
#pragma unroll
        for (unsigned j = 0; j < 16; ++j) { const unsigned c = xb_ld(&bar[XB_XCNT(j)]); sum += c; cnt += (c > 0u) ? 1u : 0u; mine = (j == x) ? c : mine; }
        if (sum == G) break;
        __builtin_amdgcn_s_sleep(1);
        if ((++sp & 255u) == 0u) { if (xb_ld(&bar[XB_TMO])) break; if (sp > XB_SPIN_CAP) { atomicAdd(&bar[XB_TMO], 1u); break; } }
    }
    nloc = mine > 0u ? mine : 1u; nx = cnt > 0u ? cnt : 1u;
}
__device__ __forceinline__ void xcd_barrier(const XcdBarrier& b, bool t0  ) {
    asm volatile("s_waitcnt vmcnt(0)" ::: "memory");
    __syncthreads();
    if (t0) {
        GAS unsigned* barg_ = (GAS unsigned*)b.bar; unsigned bx = b.x;
        asm volatile("" : "+s"(barg_), "+s"(bx)); unsigned* bar = (unsigned*)barg_;
        __builtin_amdgcn_s_waitcnt(0);
        unsigned nloc = b.st[0], nx = b.st[1];
        if (nloc == 0u) { xcd_barrier_complete(bar, bx, nloc, nx); b.st[0] = nloc; b.st[1] = nx; }
        const unsigned old = xb_add(&bar[XB_XSUB(bx)], 1u);
        const unsigned gen = old / nloc;
        if (old + 1u == (gen + 1u) * nloc) {
            __builtin_amdgcn_fence(__ATOMIC_RELEASE, "agent");
            asm volatile("s_waitcnt vmcnt(0)" ::: "memory");
            const unsigned og = xb_add(&bar[XB_TOP], 1u);
            const unsigned tg = og / nx;
            if (og + 1u == (tg + 1u) * nx) xb_add(&bar[XB_TOPGEN], 1u);
            else XB_SPIN(xb_ld(&bar[XB_TOPGEN]) == tg, bar);
            __builtin_amdgcn_fence(__ATOMIC_ACQUIRE, "agent");
            xb_add(&bar[XB_XGEN(bx)], 1u);
            asm volatile("s_waitcnt vmcnt(0)" ::: "memory");
        } else {
            XB_SPIN(xb_ld(&bar[XB_XGEN(bx)]) == gen, bar);
            __builtin_amdgcn_fence(__ATOMIC_ACQUIRE, "agent");
            asm volatile("s_waitcnt vmcnt(0)" ::: "memory");
        }
    }
    __syncthreads();
}

namespace att {
typedef float f32x16 __attribute__((ext_vector_type(16)));
typedef short s16x4 __attribute__((ext_vector_type(4)));
typedef LAS const char* lds_cptr;
constexpr int THRL = 8;
constexpr int NEXP1 = 8;
__device__ __forceinline__ int crow(int r, int hi) { return (r & 3) + 8 * (r >> 2) + 4 * hi; }
__device__ __forceinline__ void glds16s(const void* sbase  , unsigned voff  , unsigned lds_dst) { unsigned keep;
    asm volatile("s_mov_b32 %0, m0\n\ts_mov_b32 m0, %3\n\ts_nop 0\n\tglobal_load_lds_dwordx4 %1, %2\n\ts_mov_b32 m0, %0" : "=&s"(keep) : "v"(voff), "s"(sbase), "s"(lds_dst) : "memory"); }
__device__ __forceinline__ void glds16(const void* gsrc, unsigned lds_dst) { unsigned keep;
    asm volatile("s_mov_b32 %0, m0\n\ts_mov_b32 m0, %2\n\ts_nop 0\n\tglobal_load_lds_dwordx4 %1, off\n\ts_mov_b32 m0, %0" : "=&s"(keep) : "v"(gsrc), "s"(lds_dst) : "memory"); }
__device__ __forceinline__ float max3f(float a, float b, float c) { return __builtin_fmaxf(__builtin_fmaxf(a, b), c); }
#define ATT_WAIT_BAR(N) asm volatile("s_nop 15\n\ts_waitcnt vmcnt(" #N ") lgkmcnt(0)\n\ts_barrier" ::: "memory")
#define ATT_SBAR() __builtin_amdgcn_sched_barrier(0)
__device__ __forceinline__ float swap_add(float v) { auto rr = __builtin_amdgcn_permlane32_swap(__float_as_uint(v), __float_as_uint(v), false, false); return __uint_as_float(rr[0]) + __uint_as_float(rr[1]); }
__device__ __forceinline__ float swap_max(float v) { auto rr = __builtin_amdgcn_permlane32_swap(__float_as_uint(v), __float_as_uint(v), false, false); return fmaxf(__uint_as_float(rr[0]), __uint_as_float(rr[1])); }

#define MFMA_FENCE1(a) asm volatile("s_nop 15\n\ts_nop 1" : "+v"(a))
#define MFMA_FENCE2(a, b) asm volatile("s_nop 15\n\ts_nop 1" : "+v"(a), "+v"(b))
template <int ND0> __device__ __forceinline__ void qkt_lds(f32x16& p0, f32x16& p1, lds_cptr kslot, const bf16x8* qr, const f32x16& c0, int r32, int hi) {
    lds_cptr kb = kslot + hi * 1024 + r32 * 16;
    bf16x8 kf[2 * ND0];
#pragma unroll
    for (int d0 = 0; d0 < ND0; ++d0) { kf[2 * d0] = *(const LAS bf16x8*)(kb + d0 * 2048); kf[2 * d0 + 1] = *(const LAS bf16x8*)(kb + d0 * 2048 + 512); }
    ATT_SBAR();
#pragma unroll
    for (int d0 = 0; d0 < ND0; ++d0) {
        if (d0 == 0) { p0 = __builtin_amdgcn_mfma_f32_32x32x16_bf16(kf[0], qr[0], c0, 0, 0, 0); p1 = __builtin_amdgcn_mfma_f32_32x32x16_bf16(kf[1], qr[0], c0, 0, 0, 0); }
        else { p0 = __builtin_amdgcn_mfma_f32_32x32x16_bf16(kf[2 * d0], qr[d0], p0, 0, 0, 0); p1 = __builtin_amdgcn_mfma_f32_32x32x16_bf16(kf[2 * d0 + 1], qr[d0], p1, 0, 0, 0); } }
}
struct VFrag { s16x4 lo[8], hi[8]; };
__device__ __forceinline__ void pv64_read(VFrag& v, int vb) {
#pragma unroll
    for (int d0 = 0; d0 < 2; ++d0)
#pragma unroll
        for (int ks = 0; ks < 4; ++ks) {
            asm volatile("ds_read_b64_tr_b16 %0,%1 offset:%c2" : "=&v"(v.lo[d0 * 4 + ks]) : "v"(vb), "i"(d0 * 4096 + ks * 1024) : "memory");
            asm volatile("ds_read_b64_tr_b16 %0,%1 offset:%c2" : "=&v"(v.hi[d0 * 4 + ks]) : "v"(vb), "i"(d0 * 4096 + ks * 1024 + 512) : "memory"); }
}
#define ATT_PK(k) (bf16x8){lo[k][0], lo[k][1], lo[k][2], lo[k][3], hi[k][0], hi[k][1], hi[k][2], hi[k][3]}
__device__ __forceinline__ void pv64_mma(f32x16* o, VFrag& v, bf16x8 pa0, bf16x8 pa1, bf16x8 pa2, bf16x8 pa3) {
    asm volatile("s_waitcnt lgkmcnt(0)" : "+v"(v.lo[0]), "+v"(v.lo[1]), "+v"(v.lo[2]), "+v"(v.lo[3]), "+v"(v.lo[4]), "+v"(v.lo[5]), "+v"(v.lo[6]), "+v"(v.lo[7]),
                 "+v"(v.hi[0]), "+v"(v.hi[1]), "+v"(v.hi[2]), "+v"(v.hi[3]), "+v"(v.hi[4]), "+v"(v.hi[5]), "+v"(v.hi[6]), "+v"(v.hi[7]) :: "memory");
#pragma unroll
    for (int d0 = 0; d0 < 2; ++d0) { const s16x4* lo = v.lo + 4 * d0; const s16x4* hi = v.hi + 4 * d0;
        o[d0] = __builtin_amdgcn_mfma_f32_32x32x16_bf16(pa0, ATT_PK(0), o[d0], 0, 0, 0);
        o[d0] = __builtin_amdgcn_mfma_f32_32x32x16_bf16(pa1, ATT_PK(1), o[d0], 0, 0, 0);
        o[d0] = __builtin_amdgcn_mfma_f32_32x32x16_bf16(pa2, ATT_PK(2), o[d0], 0, 0, 0);
        o[d0] = __builtin_amdgcn_mfma_f32_32x32x16_bf16(pa3, ATT_PK(3), o[d0], 0, 0, 0); }
}
struct V32 { s16x4 lo[4], hi[4]; };
__device__ __forceinline__ void pv32_read(V32& v, int vb) {
#pragma unroll
    for (int d0 = 0; d0 < 2; ++d0)
#pragma unroll
        for (int ks = 0; ks < 2; ++ks) {
            asm volatile("ds_read_b64_tr_b16 %0,%1 offset:%c2" : "=&v"(v.lo[d0 * 2 + ks]) : "v"(vb), "i"(d0 * 4096 + ks * 1024) : "memory");
            asm volatile("ds_read_b64_tr_b16 %0,%1 offset:%c2" : "=&v"(v.hi[d0 * 2 + ks]) : "v"(vb), "i"(d0 * 4096 + ks * 1024 + 512) : "memory"); }
}
__device__ __forceinline__ void pv32_mma(f32x16* o, V32& v, bf16x8 pa0, bf16x8 pa1) {
    asm volatile("s_waitcnt lgkmcnt(0)" : "+v"(v.lo[0]), "+v"(v.lo[1]), "+v"(v.lo[2]), "+v"(v.lo[3]), "+v"(v.hi[0]), "+v"(v.hi[1]), "+v"(v.hi[2]), "+v"(v.hi[3]) :: "memory");
#pragma unroll
    for (int d0 = 0; d0 < 2; ++d0) {
        o[d0] = __builtin_amdgcn_mfma_f32_32x32x16_bf16(pa0, ((bf16x8){v.lo[2 * d0][0], v.lo[2 * d0][1], v.lo[2 * d0][2], v.lo[2 * d0][3], v.hi[2 * d0][0], v.hi[2 * d0][1], v.hi[2 * d0][2], v.hi[2 * d0][3]}), o[d0], 0, 0, 0);
        o[d0] = __builtin_amdgcn_mfma_f32_32x32x16_bf16(pa1, ((bf16x8){v.lo[2 * d0 + 1][0], v.lo[2 * d0 + 1][1], v.lo[2 * d0 + 1][2], v.lo[2 * d0 + 1][3], v.hi[2 * d0 + 1][0], v.hi[2 * d0 + 1][1], v.hi[2 * d0 + 1][2], v.hi[2 * d0 + 1][3]}), o[d0], 0, 0, 0); }
}
__device__ __forceinline__ void pv32(f32x16* o, int vb, bf16x8 pa0, bf16x8 pa1) {
#pragma unroll
    for (int d0 = 0; d0 < 2; ++d0) { s16x4 lo[2], hi[2];
#pragma unroll
        for (int ks = 0; ks < 2; ++ks) {
            asm volatile("ds_read_b64_tr_b16 %0,%1 offset:%c2" : "=&v"(lo[ks]) : "v"(vb), "i"(d0 * 4096 + ks * 1024) : "memory");
            asm volatile("ds_read_b64_tr_b16 %0,%1 offset:%c2" : "=&v"(hi[ks]) : "v"(vb), "i"(d0 * 4096 + ks * 1024 + 512) : "memory"); }
        asm volatile("s_waitcnt lgkmcnt(0)" ::: "memory"); ATT_SBAR();
        o[d0] = __builtin_amdgcn_mfma_f32_32x32x16_bf16(pa0, ATT_PK(0), o[d0], 0, 0, 0);
        o[d0] = __builtin_amdgcn_mfma_f32_32x32x16_bf16(pa1, ATT_PK(1), o[d0], 0, 0, 0);
#undef ATT_PK
    }
}
__device__ __forceinline__ void cmask(f32x16& p0, f32x16& p1, int jb, int qrel, int hi) {
    const int kb = 64 * jb + 4 * hi;
#pragma unroll
    for (int r = 0; r < 16; ++r) { const int kv = kb + (r & 3) + 8 * (r >> 2); if (kv > qrel) p0[r] = -INFINITY; if (kv + 32 > qrel) p1[r] = -INFINITY; }
}
struct SmState { float mhat, l; f32x16 negm; f32x16 o[2]; };
__device__ __forceinline__ void sm_init(SmState& s) { s.mhat = 0.f; s.l = 0.f; s.negm = f32x16{}; s.o[0] = f32x16{}; s.o[1] = f32x16{}; }
__device__ __forceinline__ bool sm_decide64(SmState& s, f32x16& p0, f32x16& p1, LAS float* wsf, int r32, int hi) {
    float a = max3f(p0[0], p0[1], p1[0]), b = max3f(p0[2], p0[3], p1[1]); a = max3f(a, p1[2], p1[3]);
#pragma unroll
    for (int r = 4; r < 16; r += 4) { a = max3f(a, p0[r], p0[r + 1]); b = max3f(b, p0[r + 2], p0[r + 3]); a = max3f(a, p1[r], p1[r + 1]); b = max3f(b, p1[r + 2], p1[r + 3]); }
    const float rm = swap_max(fmaxf(a, b)); bool resc_ = false;
    if (__any(rm > (float)THRL)) { const float dl = fmaxf(rm, 0.f); s.mhat += dl;
#pragma unroll
        for (int r = 0; r < 16; ++r) { p0[r] -= dl; p1[r] -= dl; s.negm[r] = -s.mhat; }
        const float f = __builtin_amdgcn_exp2f(-dl); s.l *= f; if (hi == 0) wsf[r32] = f;
        resc_ = true; }
#pragma unroll
    for (int r = 0; r < NEXP1; ++r) p0[r] = __builtin_amdgcn_exp2f(p0[r]);
    asm volatile("" : "+v"(p0));
    return resc_;
}
__device__ __forceinline__ void sm_exp64(SmState& s, bool resc, f32x16& p0, f32x16& p1, LAS float* wsf, int hi, u32x4& pw0, u32x4& pw1, u32x4& pw2, u32x4& pw3) {
    if (resc) { asm volatile("s_waitcnt lgkmcnt(0)" ::: "memory"); MFMA_FENCE2(s.o[0], s.o[1]);
#pragma unroll
        for (int d = 0; d < 2; ++d)
#pragma unroll
            for (int r = 0; r < 16; ++r) s.o[d][r] *= wsf[crow(r, hi)];
        asm volatile("s_waitcnt lgkmcnt(0)" ::: "memory"); }
    float sa0 = 0.f, sa1 = 0.f, sb0 = 0.f, sb1 = 0.f;
#pragma unroll
    for (int r = 0; r < 16; r += 2) { if (r >= NEXP1) { p0[r] = __builtin_amdgcn_exp2f(p0[r]); p0[r + 1] = __builtin_amdgcn_exp2f(p0[r + 1]); }
        p1[r] = __builtin_amdgcn_exp2f(p1[r]); p1[r + 1] = __builtin_amdgcn_exp2f(p1[r + 1]);
        sa0 += p0[r]; sa1 += p0[r + 1]; sb0 += p1[r]; sb1 += p1[r + 1]; }
    asm volatile("" : "+v"(sa0), "+v"(sa1), "+v"(sb0), "+v"(sb1));
    s.l += (sa0 + sa1) + (sb0 + sb1);
    pw0 = (u32x4){cvt_pk_bf16(p0[0], p0[1]), cvt_pk_bf16(p0[2], p0[3]), cvt_pk_bf16(p0[4], p0[5]), cvt_pk_bf16(p0[6], p0[7])};
    pw1 = (u32x4){cvt_pk_bf16(p0[8], p0[9]), cvt_pk_bf16(p0[10], p0[11]), cvt_pk_bf16(p0[12], p0[13]), cvt_pk_bf16(p0[14], p0[15])};
    pw2 = (u32x4){cvt_pk_bf16(p1[0], p1[1]), cvt_pk_bf16(p1[2], p1[3]), cvt_pk_bf16(p1[4], p1[5]), cvt_pk_bf16(p1[6], p1[7])};
    pw3 = (u32x4){cvt_pk_bf16(p1[8], p1[9]), cvt_pk_bf16(p1[10], p1[11]), cvt_pk_bf16(p1[12], p1[13]), cvt_pk_bf16(p1[14], p1[15])};
}
__device__ __forceinline__ void sm_step32(SmState& s, f32x16& p0, LAS float* wsf, int r32, int hi, u32x4& pw0, u32x4& pw1) {
    float a = max3f(p0[0], p0[1], p0[2]), b = max3f(p0[3], p0[4], p0[5]);
    a = max3f(a, p0[6], p0[7]); b = max3f(b, p0[8], p0[9]); a = max3f(a, p0[10], p0[11]); b = max3f(b, p0[12], p0[13]); a = max3f(a, p0[14], p0[15]);
    const float rm = swap_max(fmaxf(a, b));
    if (__any(rm > (float)THRL)) { const float dl = fmaxf(rm, 0.f); s.mhat += dl;
#pragma unroll
        for (int r = 0; r < 16; ++r) { p0[r] -= dl; s.negm[r] = -s.mhat; }
        const float f = __builtin_amdgcn_exp2f(-dl); s.l *= f; if (hi == 0) wsf[r32] = f;
        asm volatile("s_waitcnt lgkmcnt(0)" ::: "memory"); MFMA_FENCE2(s.o[0], s.o[1]);
#pragma unroll
        for (int d = 0; d < 2; ++d)
#pragma unroll
            for (int r = 0; r < 16; ++r) s.o[d][r] *= wsf[crow(r, hi)];
        asm volatile("s_waitcnt lgkmcnt(0)" ::: "memory"); }
    float sum = 0.f;
#pragma unroll
    for (int r = 0; r < 16; ++r) { p0[r] = __builtin_amdgcn_exp2f(p0[r]); sum += p0[r]; }
    s.l += sum;
    pw0 = (u32x4){cvt_pk_bf16(p0[0], p0[1]), cvt_pk_bf16(p0[2], p0[3]), cvt_pk_bf16(p0[4], p0[5]), cvt_pk_bf16(p0[6], p0[7])};
    pw1 = (u32x4){cvt_pk_bf16(p0[8], p0[9]), cvt_pk_bf16(p0[10], p0[11]), cvt_pk_bf16(p0[12], p0[13]), cvt_pk_bf16(p0[14], p0[15])};
}
__device__ __forceinline__ float sm_finish(SmState& s, LAS float* wsf, LAS bf16* stg, bf16* orow0, long rstride, int lane, int r32, int hi, float* ssq_row0 = nullptr) {
    MFMA_FENCE2(s.o[0], s.o[1]);
    const float lt = swap_add(s.l);
    if (hi == 0) wsf[32 + r32] = lt;
    asm volatile("s_waitcnt lgkmcnt(0)" ::: "memory");
    float rl[16];
#pragma unroll
    for (int r = 0; r < 16; ++r) rl[r] = wsf[32 + crow(r, hi)];
    asm volatile("s_waitcnt lgkmcnt(0)" : "+v"(rl[0]), "+v"(rl[1]), "+v"(rl[2]), "+v"(rl[3]), "+v"(rl[4]), "+v"(rl[5]), "+v"(rl[6]), "+v"(rl[7]), "+v"(rl[8]), "+v"(rl[9]), "+v"(rl[10]), "+v"(rl[11]), "+v"(rl[12]), "+v"(rl[13]), "+v"(rl[14]), "+v"(rl[15]) :: "memory");
#pragma unroll
    for (int r = 0; r < 16; ++r) { const int orow = crow(r, hi); const float ri = __builtin_amdgcn_rcpf(rl[r]);
#pragma unroll
        for (int d0 = 0; d0 < 2; ++d0) stg[orow * 64 + d0 * 32 + r32] = (bf16)(cvt_pk_bf16(s.o[d0][r] * ri, 0.f) & 0xffffu); }
    asm volatile("s_waitcnt lgkmcnt(0)" ::: "memory");
#pragma unroll
    for (int i = 0; i < 4; ++i) { const int row = i * 8 + (lane >> 3), ch = lane & 7; const u32x4 v = *(const LAS u32x4*)(stg + row * 64 + ch * 8); *(u32x4*)(orow0 + (long)row * rstride + ch * 8) = v;
        if (ssq_row0) { float q = bf_lo(v.x) * bf_lo(v.x) + bf_hi(v.x) * bf_hi(v.x) + bf_lo(v.y) * bf_lo(v.y) + bf_hi(v.y) * bf_hi(v.y) + bf_lo(v.z) * bf_lo(v.z) + bf_hi(v.z) * bf_hi(v.z) + bf_lo(v.w) * bf_lo(v.w) + bf_hi(v.w) * bf_hi(v.w);
            q += swz_xor<1>(q); q += swz_xor<2>(q); q += swz_xor<4>(q); if (ch == 0) ssq_row0[row] = q; } }
    asm volatile("s_waitcnt lgkmcnt(0)" ::: "memory");
    return s.mhat + __builtin_amdgcn_logf(lt);
}

constexpr int L_K = 0, KSLOT = 12288, L_V = 3 * KSLOT, VSLOT = 8192, L_WS = L_V + 3 * VSLOT, L_OST = L_WS + 8 * 256, L_TB = L_OST + 8 * 4096, L_Q = L_TB + (256 + 4096) * 4, L_KM = L_Q + 16, L_END = L_KM + 16 * 64 * 4;
static_assert(L_END <= RING_BYTES, "attention LDS map");

__device__ __forceinline__ int wg_next(unsigned* ctr, LAS unsigned char* shm, int slot_off, int wave) {
    volatile LAS unsigned* slot = (volatile LAS unsigned*)(shm + slot_off);
    asm volatile("s_nop 15\n\ts_waitcnt vmcnt(0) lgkmcnt(0)\n\ts_barrier" ::: "memory");
    if (wave == 0 && lane_id() == 0) slot[0] = __hip_atomic_fetch_add(ctr, 1u, __ATOMIC_RELAXED, __HIP_MEMORY_SCOPE_AGENT);
    asm volatile("s_nop 15\n\ts_waitcnt vmcnt(0) lgkmcnt(0)\n\ts_barrier" ::: "memory");
    const unsigned v = slot[0];
    return (int)__builtin_amdgcn_readfirstlane(v);
}

__device__ __forceinline__ unsigned q8_take(unsigned* ctr8, int nloc, int myx) { unsigned r = 0xffffffffu;
    for (int xx = 0; xx < 8; ++xx) { const int x = (myx + xx) & 7; unsigned* c = ctr8 + 64 * x;
        if (__hip_atomic_load(c, __ATOMIC_RELAXED, __HIP_MEMORY_SCOPE_AGENT) >= (unsigned)nloc) continue;
        const unsigned v = __hip_atomic_fetch_add(c, 1u, __ATOMIC_RELAXED, __HIP_MEMORY_SCOPE_AGENT);
        if (v < (unsigned)nloc) { r = ((unsigned)x << 16) | v; break; } }
    return r; }
__device__ __forceinline__ int wg_next8(unsigned* ctr8  , int nloc, int myx, LAS unsigned char* shm, int slot_off, int wave) {
    volatile LAS unsigned* slot = (volatile LAS unsigned*)(shm + slot_off);
    asm volatile("s_nop 15\n\ts_waitcnt vmcnt(0) lgkmcnt(0)\n\ts_barrier" ::: "memory");
    if (wave == 0 && lane_id() == 0) { unsigned r = 0xffffffffu;
        for (int xx = 0; xx < 8; ++xx) { const int x = (myx + xx) & 7; unsigned* c = ctr8 + 64 * x;
            if (__hip_atomic_load(c, __ATOMIC_RELAXED, __HIP_MEMORY_SCOPE_AGENT) >= (unsigned)nloc) continue;
            const unsigned v = __hip_atomic_fetch_add(c, 1u, __ATOMIC_RELAXED, __HIP_MEMORY_SCOPE_AGENT);
            if (v < (unsigned)nloc) { r = ((unsigned)x << 16) | v; break; } }
        slot[0] = r; }
    asm volatile("s_nop 15\n\ts_waitcnt vmcnt(0) lgkmcnt(0)\n\ts_barrier" ::: "memory");
    const unsigned v = slot[0];
    return (int)__builtin_amdgcn_readfirstlane(v);
}

__device__ __forceinline__ void mla_unit(int b, int h, int qb, const bf16* QM, const bf16* PROJ, bf16* OB, float* ssq_mix, LAS unsigned char* shm, const int wid) {
    const int lane = lane_id(), tid = wid * 64 + lane, r32 = lane & 31, hi = lane >> 5; (void)tid;
    const long rowbase = (long)b * SEQ; const int q0 = qb * 256;
    const unsigned lds0 = (unsigned)(uintptr_t)shm;
    LAS float* wsf = (LAS float*)(shm + L_WS) + wid * 64;
    const bf16* Qw = QM + (rowbase + q0 + wid * 32 + r32) * QP;
    bf16x8 qr[6];
#pragma unroll
    for (int d0 = 0; d0 < 4; ++d0) qr[d0] = *(const bf16x8*)(Qw + Q_NOPE + h * 64 + d0 * 16 + hi * 8);
#pragma unroll
    for (int d0 = 0; d0 < 2; ++d0) qr[4 + d0] = *(const bf16x8*)(Qw + Q_ROPE + h * 32 + d0 * 16 + hi * 8);
    asm volatile("" : "+v"(qr[0]), "+v"(qr[1]), "+v"(qr[2]), "+v"(qr[3]), "+v"(qr[4]), "+v"(qr[5]));
    const bf16* ksrc = QM + (rowbase + lane) * QP + Q_KV + h * 128 + wid * 8;
    const bf16* rsrc = PROJ + (rowbase + lane) * PP + C_KR + (wid & 3) * 8;
    const bf16* vsrc = QM + (rowbase + 16 * (wid & 3) + (lane >> 2)) * QP + Q_KV + h * 128 + 64 + (wid >> 2) * 32 + (lane & 3) * 8;
    const unsigned kdst = lds0 + L_K + wid * 1024, rdst = lds0 + L_K + (8 + (wid & 3)) * 1024, vdst = lds0 + L_V + wid * 1024;
    const int vb0 = (int)(lds0 + L_V) + ((lane >> 4) & 1) * 32 + (lane & 3) * 8 + (4 * hi + ((lane & 15) >> 2)) * 64;
    const lds_cptr kbase = (lds_cptr)(shm + L_K);
    const int NT = 4 * qb + 4, qrel = wid * 32 + r32;
    SmState st; sm_init(st);
    const bool halfB = wid >= 4;
#define MLA_K(t, s) do { glds16(ksrc + (long)(t) * 64 * QP, (unsigned)__builtin_amdgcn_readfirstlane(kdst + (s) * KSLOT)); \
        if (wid < 4) glds16(rsrc + (long)(t) * 64 * PP, (unsigned)__builtin_amdgcn_readfirstlane(rdst + (s) * KSLOT)); } while (0)
#define MLA_V(t, s) glds16(vsrc + (long)(t) * 64 * QP, (unsigned)__builtin_amdgcn_readfirstlane(vdst + (s) * VSLOT))
#define MLA_WODD(t) ATT_WAIT_BAR(0)
#define MLA_WEVEN(t) ATT_WAIT_BAR(0)
    f32x16 p0, p1; bool resc = false; u32x4 pw0, pw1, pw2, pw3;
#define ATT_SKIP(t) ((t) >= NT - 4 && 64 * ((t) - (NT - 4)) > 32 * wid + 31)
#define MLA_PART1(t, sl) do { if (ATT_SKIP(t)) resc = false; else { qkt_lds<6>(p0, p1, kbase + (sl) * KSLOT, qr, st.negm, r32, hi); if ((t) >= NT - 4) cmask(p0, p1, (t) - (NT - 4), qrel, hi); resc = sm_decide64(st, p0, p1, wsf, r32, hi); } } while (0)
#define MLA_PART2(t, sl) do { if (!ATT_SKIP(t)) { VFrag vf_; pv64_read(vf_, vb0 + (sl) * VSLOT); sm_exp64(st, resc, p0, p1, wsf, hi, pw0, pw1, pw2, pw3); \
        pv64_mma(st.o, vf_, __builtin_bit_cast(bf16x8, pw0), __builtin_bit_cast(bf16x8, pw1), __builtin_bit_cast(bf16x8, pw2), __builtin_bit_cast(bf16x8, pw3)); } } while (0)
    MLA_K(0, 0); MLA_V(0, 0);
    ATT_WAIT_BAR(0);
    if (!halfB) { int sc = 0;
        for (int t = 0; t < NT; ++t) { const int sn = sc == 2 ? 0 : sc + 1;
            if (t + 1 < NT) { MLA_K(t + 1, sn); MLA_V(t + 1, sn); }
            MLA_PART1(t, sc); MLA_PART2(t, sc); ATT_WAIT_BAR(0);
            sc = sn; }
        ATT_WAIT_BAR(0);
    } else { int sp = 0, sc = 1;
        if (1 < NT) { MLA_K(1, 1); MLA_V(1, 1); }
        MLA_PART1(0, 0); ATT_WAIT_BAR(0);
        for (int t = 1; t < NT; ++t) { const int sn = sc == 2 ? 0 : sc + 1;
            if (t + 1 < NT) { MLA_K(t + 1, sn); MLA_V(t + 1, sn); }
            MLA_PART2(t - 1, sp); MLA_PART1(t, sc); ATT_WAIT_BAR(0);
            sp = sc; sc = sn; }
        MLA_PART2(NT - 1, sp); ATT_WAIT_BAR(0);
    }
#undef MLA_K
#undef MLA_V
#undef MLA_WODD
#undef MLA_WEVEN
#undef MLA_PART1
#undef MLA_PART2
    (void)sm_finish(st, wsf, (LAS bf16*)(shm + L_OST) + wid * 2048, OB + (rowbase + q0 + wid * 32) * DM + O_B + h * 64, DM, lane, r32, hi, ssq_mix + (size_t)h * M + (rowbase + q0 + wid * 32));
}


typedef short v4i16_t __attribute__((ext_vector_type(4)));
__device__ __forceinline__ s16x4 vtr16(lds_cptr p) { return __builtin_bit_cast(s16x4, __builtin_amdgcn_ds_read_tr16_b64_v4i16((LAS v4i16_t*)p)); }
__device__ __forceinline__ float rowmax64(const f32x16& p0, const f32x16& p1) {
    float a = max3f(p0[0], p0[1], p1[0]), b = max3f(p0[2], p0[3], p1[1]); a = max3f(a, p1[2], p1[3]);
#pragma unroll
    for (int r = 4; r < 16; r += 4) { a = max3f(a, p0[r], p0[r + 1]); b = max3f(b, p0[r + 2], p0[r + 3]); a = max3f(a, p1[r], p1[r + 1]); b = max3f(b, p1[r + 2], p1[r + 3]); }
    return swap_max(fmaxf(a, b));
}
#define PINV(x) asm volatile("" : "+v"(x))
#define MF32(a, b, c) __builtin_amdgcn_mfma_f32_32x32x16_bf16(a, b, c, 0, 0, 0)
__device__ __forceinline__ void mla_unit2(int b, int h, int qb, const bf16* QM, const bf16* PROJ, bf16* OB, float* ssq_mix, LAS unsigned char* shm, const int wid) {
    const int lane = lane_id(), r32 = lane & 31, hi = lane >> 5;
    const long rowbase = (long)b * SEQ; const int q0 = qb * 256;
    const unsigned lds0 = (unsigned)(uintptr_t)shm;
    LAS float* wsf = (LAS float*)(shm + L_WS) + wid * 64;
    const bf16* Qw = QM + (rowbase + q0 + wid * 32 + r32) * QP;
    bf16x8 qr[6];
#pragma unroll
    for (int d0 = 0; d0 < 4; ++d0) qr[d0] = *(const bf16x8*)(Qw + Q_NOPE + h * 64 + d0 * 16 + hi * 8);
#pragma unroll
    for (int d0 = 0; d0 < 2; ++d0) qr[4 + d0] = *(const bf16x8*)(Qw + Q_ROPE + h * 32 + d0 * 16 + hi * 8);
    asm volatile("" : "+v"(qr[0]), "+v"(qr[1]), "+v"(qr[2]), "+v"(qr[3]), "+v"(qr[4]), "+v"(qr[5]));
    const bf16* kbase_g = QM + rowbase * QP + Q_KV + h * 128 + wid * 8; const unsigned koff = (unsigned)(lane * QP * 2);
    const bf16* rbase_g = PROJ + rowbase * PP + C_KR + (wid & 3) * 8; const unsigned roff = (unsigned)(lane * PP * 2);
    const bf16* vbase_g = QM + (rowbase + 16 * (wid & 3)) * QP + Q_KV + h * 128 + 64 + (wid >> 2) * 32; const unsigned voff_ = (unsigned)(((lane >> 2) * QP + (lane & 3) * 8) * 2);
    const unsigned kdst = lds0 + L_K + wid * 1024, rdst = lds0 + L_K + (8 + (wid & 3)) * 1024, vdst = lds0 + L_V + wid * 1024;
#define U2_K(t, s) do { glds16s(kbase_g + (long)(t) * 64 * QP, koff, (unsigned)__builtin_amdgcn_readfirstlane(kdst + (s) * KSLOT)); \
        if (wid < 4) glds16s(rbase_g + (long)(t) * 64 * PP, roff, (unsigned)__builtin_amdgcn_readfirstlane(rdst + (s) * KSLOT)); } while (0)
#define U2_V(t, s) glds16s(vbase_g + (long)(t) * 64 * QP, voff_, (unsigned)__builtin_amdgcn_readfirstlane(vdst + (s) * VSLOT))
    const lds_cptr vp0 = (lds_cptr)(shm + L_V) + ((lane >> 4) & 1) * 32 + (lane & 3) * 8 + (4 * hi + ((lane & 15) >> 2)) * 64;
    const lds_cptr kp0 = (lds_cptr)(shm + L_K) + hi * 1024 + r32 * 16;
    const int NT = 4 * qb + 4, qrel = wid * 32 + r32;
    SmState st; sm_init(st); PINV(st.negm);
    bool resc = false;
    f32x16 pA0, pA1, pB0, pB1; bf16x8 kf[8]; s16x4 vlo[8], vhi[8]; u32x4 pw0, pw1, pw2, pw3;
    int sl_prev = 0, sl_cur = 0, sl_next = 1;
#define U2_ROT() do { sl_prev = sl_cur; sl_cur = sl_next; sl_next = (sl_next == 2) ? 0 : sl_next + 1; } while (0)
#define U2_KLOAD2(kp, d0) do { kf[2 * (d0)] = *(const LAS bf16x8*)((kp) + (d0) * 2048); kf[2 * (d0) + 1] = *(const LAS bf16x8*)((kp) + (d0) * 2048 + 512); } while (0)
#define U2_RESC() do { if (resc) { _Pragma("unroll") for (int d_ = 0; d_ < 2; ++d_) _Pragma("unroll") for (int r = 0; r < 16; ++r) st.o[d_][r] *= wsf[crow(r, hi)]; } } while (0)
    U2_K(0, 0); U2_V(0, 0); U2_K(1, 1); U2_K(2, 2); U2_V(1, 1);
    ATT_WAIT_BAR(0);
    { bf16x8 k0[12];
#pragma unroll
      for (int d0 = 0; d0 < 6; ++d0) { k0[2 * d0] = *(const LAS bf16x8*)(kp0 + d0 * 2048); k0[2 * d0 + 1] = *(const LAS bf16x8*)(kp0 + d0 * 2048 + 512); }
      ATT_SBAR();
      pA0 = MF32(k0[0], qr[0], st.negm); pA1 = MF32(k0[1], qr[0], st.negm);
#pragma unroll
      for (int d0 = 1; d0 < 6; ++d0) { pA0 = MF32(k0[2 * d0], qr[d0], pA0); pA1 = MF32(k0[2 * d0 + 1], qr[d0], pA1); } }
    if (NT == 4) cmask(pA0, pA1, 0, qrel, hi);
    { const float rm = rowmax64(pA0, pA1); st.mhat = rm;
#pragma unroll
      for (int r = 0; r < 16; ++r) { pA0[r] = __builtin_amdgcn_exp2f(pA0[r] - rm); pA1[r] = __builtin_amdgcn_exp2f(pA1[r] - rm); st.negm[r] = -rm; } }
    PINV(pA0); PINV(pA1); PINV(st.negm); ATT_SBAR();
    ATT_WAIT_BAR(0);
    U2_ROT();
#pragma unroll
    for (int d0 = 0; d0 < 4; ++d0) U2_KLOAD2(kp0 + sl_cur * KSLOT, d0);
#define U2_PKW(P, i) cvt_pk_bf16(P[i], P[(i) + 1])
#define U2_PAF(k) __builtin_bit_cast(bf16x8, pw##k)
#define U2_VFR(i) (bf16x8){vlo[i][0], vlo[i][1], vlo[i][2], vlo[i][3], vhi[i][0], vhi[i][1], vhi[i][2], vhi[i][3]}
#define U2_VRD(i) do { vlo[i] = vtr16(vp_ + (((i) >> 2) * 4096 + ((i) & 3) * 1024)); vhi[i] = vtr16(vp_ + (((i) >> 2) * 4096 + ((i) & 3) * 1024 + 512)); } while (0)
#define U2_KRD(G, d0) do { if (G) { U2_KLOAD2(kp0 + sl_next * KSLOT, d0); ATT_SBAR(); } } while (0)
#define U2_GAPA(MF, a0, a1, a2, a3, W0, W1, PW) do { MF; sacc += a0; sacc += a1; sacc += a2; sacc += a3; W0; W1; PINV(PW); PINV(sacc); ATT_SBAR(); } while (0)
#define U2_GAPB(MF, X, i) do { MF; X[i] = __builtin_amdgcn_exp2f(X[i]); X[(i) + 1] = __builtin_amdgcn_exp2f(X[(i) + 1]); X[(i) + 2] = __builtin_amdgcn_exp2f(X[(i) + 2]); X[(i) + 3] = __builtin_amdgcn_exp2f(X[(i) + 3]); PINV(X); ATT_SBAR(); } while (0)
#define U2_STEP(C0, C1, P0, P1, t, MASK, GK, GV, GL) do { ATT_SBAR(); \
    if (GK) U2_K((t) + 2, sl_prev); if (GV) U2_V((t) + 1, sl_next); \
    const lds_cptr vp_ = vp0 + sl_prev * VSLOT; \
    float sacc = P0[0] + P0[1]; \
    U2_GAPA(C0 = MF32(kf[0], qr[0], st.negm), P0[2], P0[3], P0[4], P0[5],     pw0[0] = U2_PKW(P0, 0),  pw0[1] = U2_PKW(P0, 2),  pw0); \
    U2_GAPA(C1 = MF32(kf[1], qr[0], st.negm), P0[6], P0[7], P0[8], P0[9],     pw0[2] = U2_PKW(P0, 4),  pw0[3] = U2_PKW(P0, 6),  pw0); \
    U2_GAPA(C0 = MF32(kf[2], qr[1], C0),      P0[10], P0[11], P0[12], P0[13], pw1[0] = U2_PKW(P0, 8),  pw1[1] = U2_PKW(P0, 10), pw1); \
    U2_GAPA(C1 = MF32(kf[3], qr[1], C1),      P0[14], P0[15], P1[0], P1[1],   pw1[2] = U2_PKW(P0, 12), pw1[3] = U2_PKW(P0, 14), pw1); \
    bf16x8 kr_[4]; { const lds_cptr kq_ = kp0 + sl_cur * KSLOT; kr_[0] = *(const LAS bf16x8*)(kq_ + 4 * 2048); kr_[1] = *(const LAS bf16x8*)(kq_ + 4 * 2048 + 512); kr_[2] = *(const LAS bf16x8*)(kq_ + 5 * 2048); kr_[3] = *(const LAS bf16x8*)(kq_ + 5 * 2048 + 512); } ATT_SBAR();     \
    U2_GAPA(C0 = MF32(kf[4], qr[2], C0),      P1[2], P1[3], P1[4], P1[5],     pw2[0] = U2_PKW(P1, 0),  pw2[1] = U2_PKW(P1, 2),  pw2); \
    U2_GAPA(C1 = MF32(kf[5], qr[2], C1),      P1[6], P1[7], P1[8], P1[9],     pw2[2] = U2_PKW(P1, 4),  pw2[3] = U2_PKW(P1, 6),  pw2); \
    U2_GAPA(C0 = MF32(kf[6], qr[3], C0),      P1[10], P1[11], P1[12], P1[13], pw3[0] = U2_PKW(P1, 8),  pw3[1] = U2_PKW(P1, 10), pw3); \
    U2_GAPA(C1 = MF32(kf[7], qr[3], C1),      P1[14], P1[15], 0.f, 0.f,       pw3[2] = U2_PKW(P1, 12), pw3[3] = U2_PKW(P1, 14), pw3); \
    C0 = MF32(kr_[0], qr[4], C0); C1 = MF32(kr_[1], qr[4], C1); C0 = MF32(kr_[2], qr[5], C0); C1 = MF32(kr_[3], qr[5], C1); \
    U2_VRD(0); U2_VRD(4); U2_VRD(1); U2_VRD(5); U2_VRD(2); U2_VRD(6); U2_VRD(3); U2_VRD(7); ATT_SBAR();     \
    st.l += sacc; \
    if (MASK) cmask(C0, C1, (t) - (NT - 4), qrel, hi); \
    { const float rm = rowmax64(C0, C1); resc = false; \
      if (__builtin_expect(__any(rm > (float)THRL), 0)) { const float dl = fmaxf(rm, 0.f); st.mhat += dl; \
          _Pragma("unroll") for (int r = 0; r < 16; ++r) { C0[r] -= dl; C1[r] -= dl; st.negm[r] = -st.mhat; } \
          const float f = __builtin_amdgcn_exp2f(-dl); st.l *= f; if (hi == 0) wsf[r32] = f; resc = true; } } \
    ATT_SBAR(); \
    U2_GAPB(st.o[0] = MF32(U2_PAF(0), U2_VFR(0), st.o[0]), C0, 0); \
    U2_GAPB(st.o[1] = MF32(U2_PAF(0), U2_VFR(4), st.o[1]), C0, 4);  U2_KRD(GL, 0); \
    U2_GAPB(st.o[0] = MF32(U2_PAF(1), U2_VFR(1), st.o[0]), C0, 8); \
    U2_GAPB(st.o[1] = MF32(U2_PAF(1), U2_VFR(5), st.o[1]), C0, 12); U2_KRD(GL, 1); \
    U2_GAPB(st.o[0] = MF32(U2_PAF(2), U2_VFR(2), st.o[0]), C1, 0);  U2_KRD(GL, 2); \
    U2_GAPB(st.o[1] = MF32(U2_PAF(2), U2_VFR(6), st.o[1]), C1, 4);  U2_KRD(GL, 3); \
    U2_GAPB(st.o[0] = MF32(U2_PAF(3), U2_VFR(3), st.o[0]), C1, 8); \
    U2_GAPB(st.o[1] = MF32(U2_PAF(3), U2_VFR(7), st.o[1]), C1, 12); \
    } while (0)
    ATT_WAIT_BAR(0);
    int t = 1;
    for (; t + 1 < NT - 4; t += 2) {
        U2_STEP(pB0, pB1, pA0, pA1, t, false, true, true, true);     ATT_WAIT_BAR(0); U2_RESC(); U2_ROT();
        U2_STEP(pA0, pA1, pB0, pB1, t + 1, false, true, true, true); ATT_WAIT_BAR(0); U2_RESC(); U2_ROT();
    }
    for (; t + 1 < NT; t += 2) {
        U2_STEP(pB0, pB1, pA0, pA1, t, true, (t + 2 < NT), (t + 1 < NT), (t + 1 < NT));         ATT_WAIT_BAR(0); U2_RESC(); U2_ROT();
        U2_STEP(pA0, pA1, pB0, pB1, t + 1, true, (t + 3 < NT), (t + 2 < NT), (t + 2 < NT));     ATT_WAIT_BAR(0); U2_RESC(); U2_ROT();
    }
    U2_STEP(pB0, pB1, pA0, pA1, NT - 1, true, false, false, false); U2_RESC();
    { float sacc = pB0[0] + pB0[1];
#pragma unroll
      for (int r = 2; r < 16; ++r) sacc += pB0[r];
#pragma unroll
      for (int r = 0; r < 16; ++r) sacc += pB1[r];
      st.l += sacc;
      pw0 = (u32x4){U2_PKW(pB0, 0), U2_PKW(pB0, 2), U2_PKW(pB0, 4), U2_PKW(pB0, 6)}; pw1 = (u32x4){U2_PKW(pB0, 8), U2_PKW(pB0, 10), U2_PKW(pB0, 12), U2_PKW(pB0, 14)};
      pw2 = (u32x4){U2_PKW(pB1, 0), U2_PKW(pB1, 2), U2_PKW(pB1, 4), U2_PKW(pB1, 6)}; pw3 = (u32x4){U2_PKW(pB1, 8), U2_PKW(pB1, 10), U2_PKW(pB1, 12), U2_PKW(pB1, 14)};
      const lds_cptr vp_ = vp0 + sl_cur * VSLOT;
#pragma unroll
      for (int i = 0; i < 8; ++i) U2_VRD(i);
      st.o[0] = MF32(U2_PAF(0), U2_VFR(0), st.o[0]); st.o[1] = MF32(U2_PAF(0), U2_VFR(4), st.o[1]); st.o[0] = MF32(U2_PAF(1), U2_VFR(1), st.o[0]); st.o[1] = MF32(U2_PAF(1), U2_VFR(5), st.o[1]);
      st.o[0] = MF32(U2_PAF(2), U2_VFR(2), st.o[0]); st.o[1] = MF32(U2_PAF(2), U2_VFR(6), st.o[1]); st.o[0] = MF32(U2_PAF(3), U2_VFR(3), st.o[0]); st.o[1] = MF32(U2_PAF(3), U2_VFR(7), st.o[1]); }
    ATT_WAIT_BAR(0);
#undef U2_K
#undef U2_V
#undef U2_ROT
#undef U2_KLOAD2
#undef U2_RESC
#undef U2_PKW
#undef U2_PAF
#undef U2_VFR
#undef U2_VRD
#undef U2_KRD
#undef U2_GAPA
#undef U2_GAPB
#undef U2_STEP
    (void)sm_finish(st, wsf, (LAS bf16*)(shm + L_OST) + wid * 2048, OB + (rowbase + q0 + wid * 32) * DM + O_B + h * 64, DM, lane, r32, hi, ssq_mix + (size_t)h * M + (rowbase + q0 + wid * 32));
}

__device__ __forceinline__ void moba_unit(int b, int h, int j, const bf16* PROJ, const float* kmean, const float* tmoba, bf16* OB, float* ssq_mix, LAS unsigned char* shm, const int wid) {
    const int lane = lane_id(), tid = wid * 64 + lane, r32 = lane & 31, hi = lane >> 5;
    const long rowbase = (long)b * SEQ; const int q0 = j * 256;
    const unsigned lds0 = (unsigned)(uintptr_t)shm;
    LAS float* wsf = (LAS float*)(shm + L_WS) + wid * 64;
    LAS float* tb = (LAS float*)(shm + L_TB);
    { float tv[9];
#pragma unroll
      for (int k = 0; k < 9; ++k) { const int i = tid + k * (NWAVES * 64); tv[k] = (i >= 256 && i < 256 + 4096) ? tmoba[h * 4096 + i - 256] : 0.f; }
#pragma unroll
      for (int k = 0; k < 9; ++k) { const int i = tid + k * (NWAVES * 64); if (i < 256 + 4096) tb[i] = tv[k]; } }
    LAS float* kml = (LAS float*)(shm + L_KM);
    for (int i = tid; i < j * 64; i += NWAVES * 64) kml[i] = kmean[((size_t)(b * 16 + (i >> 6)) * 4 + h) * 64 + (i & 63)];
    asm volatile("s_nop 15\n\ts_waitcnt vmcnt(0) lgkmcnt(0)\n\ts_barrier" ::: "memory");
    const float c31 = tb[256 + 4095];
    const bf16* Qw = PROJ + (rowbase + q0 + wid * 32 + r32) * PP + C_QC + h * 64;
    bf16x8 qr[4];
#pragma unroll
    for (int d0 = 0; d0 < 4; ++d0) qr[d0] = *(const bf16x8*)(Qw + d0 * 16 + hi * 8);
    float g1 = -INFINITY, g2 = -INFINITY, g3 = -INFINITY; float gate[16];
#pragma unroll
    for (int blk = 0; blk < 16; ++blk) { float s = -INFINITY;
        if (blk < j) { const LAS float* km = kml + blk * 64 + hi * 8; float a = 0.f;
#pragma unroll
            for (int d0 = 0; d0 < 4; ++d0) { const f32x4 k0 = *(const LAS f32x4*)(km + d0 * 16), k1 = *(const LAS f32x4*)(km + d0 * 16 + 4); const u32x4 q = __builtin_bit_cast(u32x4, qr[d0]);
                a = fmaf(bf_lo(q.x), k0[0], a); a = fmaf(bf_hi(q.x), k0[1], a); a = fmaf(bf_lo(q.y), k0[2], a); a = fmaf(bf_hi(q.y), k0[3], a);
                a = fmaf(bf_lo(q.z), k1[0], a); a = fmaf(bf_hi(q.z), k1[1], a); a = fmaf(bf_lo(q.w), k1[2], a); a = fmaf(bf_hi(q.w), k1[3], a); }
            s = swap_add(a); }
        gate[blk] = s;
        if (s > g1) { g3 = g2; g2 = g1; g1 = s; } else if (s > g2) { g3 = g2; g2 = s; } else if (s > g3) { g3 = s; } }
    unsigned sel = 0u;
#pragma unroll
    for (int blk = 0; blk < 16; ++blk) if (blk < j && gate[blk] >= g3) sel |= 1u << blk;
    const bf16* ksrc = PROJ + (rowbase + lane) * PP + C_KC + h * 64 + wid * 8;
    const bf16* vsrc = PROJ + (rowbase + 16 * (wid & 3) + (lane >> 2)) * PP + C_VC + h * 64 + (wid >> 2) * 32 + (lane & 3) * 8;
    const unsigned kdst = lds0 + L_K + wid * 1024, vdst = lds0 + L_V + wid * 1024;
    const int vb0 = (int)(lds0 + L_V) + ((lane >> 4) & 1) * 32 + (lane & 3) * 8 + (4 * hi + ((lane & 15) >> 2)) * 64;
    const lds_cptr kbase = (lds_cptr)(shm + L_K);
    const int NT = 4 * j + 4, qrel = wid * 32 + r32;
    SmState st; sm_init(st);
    const bool halfB = wid >= 4;
#define MOBA_K(t, s) glds16(ksrc + (long)(t) * 64 * PP, (unsigned)__builtin_amdgcn_readfirstlane(kdst + (s) * KSLOT))
#define MOBA_V(t, s) glds16(vsrc + (long)(t) * 64 * PP, (unsigned)__builtin_amdgcn_readfirstlane(vdst + (s) * VSLOT))
#define MOBA_W(t) ATT_WAIT_BAR(0)
    f32x16 p0, p1; bool resc = false; u32x4 pw0, pw1, pw2, pw3;
#define MOBA_PART1(t, sl) do { if (ATT_SKIP(t)) resc = false; else { const int blk_ = (t) >> 2; const bool on_ = (blk_ == j) || ((sel >> blk_) & 1u); f32x16 c0_; \
        const bool far_ = (q0 - 64 * (t) - 63) >= 1536;     \
        const float cv_ = on_ ? st.negm[0] + (far_ ? c31 : 0.f) : -INFINITY;     \
        _Pragma("unroll") for (int r = 0; r < 16; ++r) c0_[r] = cv_; \
        if (far_) qkt_lds<4>(p0, p1, kbase + (sl) * KSLOT, qr, c0_, r32, hi); \
        else { float tbv_[32];     \
          const LAS float* lb_ = tb + (256 + q0 + qrel - 64 * (t) - 4 * hi - 27 - 32); \
          _Pragma("unroll") for (int r = 0; r < 16; ++r) { const int c_ = (r & 3) + 8 * (r >> 2); tbv_[r] = lb_[32 + 27 - c_]; tbv_[16 + r] = lb_[27 - c_]; } \
          qkt_lds<4>(p0, p1, kbase + (sl) * KSLOT, qr, c0_, r32, hi); \
          if (blk_ == j) cmask(p0, p1, (t) & 3, qrel, hi); \
          _Pragma("unroll") for (int r = 0; r < 16; ++r) { p0[r] += tbv_[r]; p1[r] += tbv_[16 + r]; } } \
        resc = sm_decide64(st, p0, p1, wsf, r32, hi); } } while (0)
#define MOBA_PART2(t, sl) do { if (!ATT_SKIP(t)) { VFrag vf_; pv64_read(vf_, vb0 + (sl) * VSLOT); sm_exp64(st, resc, p0, p1, wsf, hi, pw0, pw1, pw2, pw3); \
        pv64_mma(st.o, vf_, __builtin_bit_cast(bf16x8, pw0), __builtin_bit_cast(bf16x8, pw1), __builtin_bit_cast(bf16x8, pw2), __builtin_bit_cast(bf16x8, pw3)); } } while (0)
    MOBA_K(0, 0); MOBA_V(0, 0);
    ATT_WAIT_BAR(0);
    if (!halfB) { int sc = 0;
        for (int t = 0; t < NT; ++t) { const int sn = sc == 2 ? 0 : sc + 1;
            if (t + 1 < NT) { MOBA_K(t + 1, sn); MOBA_V(t + 1, sn); }
            MOBA_PART1(t, sc); MOBA_PART2(t, sc); ATT_WAIT_BAR(0);
            sc = sn; }
        ATT_WAIT_BAR(0);
    } else { int sp = 0, sc = 1;
        if (1 < NT) { MOBA_K(1, 1); MOBA_V(1, 1); }
        MOBA_PART1(0, 0); ATT_WAIT_BAR(0);
        for (int t = 1; t < NT; ++t) { const int sn = sc == 2 ? 0 : sc + 1;
            if (t + 1 < NT) { MOBA_K(t + 1, sn); MOBA_V(t + 1, sn); }
            MOBA_PART2(t - 1, sp); MOBA_PART1(t, sc); ATT_WAIT_BAR(0);
            sp = sc; sc = sn; }
        MOBA_PART2(NT - 1, sp); ATT_WAIT_BAR(0);
    }
#undef MOBA_K
#undef MOBA_V
#undef MOBA_W
#undef MOBA_PART1
#undef MOBA_PART2
    (void)sm_finish(st, wsf, (LAS bf16*)(shm + L_OST) + wid * 2048, OB + (rowbase + q0 + wid * 32) * DM + O_C + h * 64, DM, lane, r32, hi, ssq_mix + (size_t)(6 + h) * M + (rowbase + q0 + wid * 32));
}

constexpr int D_V = 0, D_WS = 65536, D_OST = D_WS + 8 * 256, D_TB = D_OST + 8 * 4096, D_Q = D_TB + 3 * 6 * 192 * 4, D_END = D_Q + 16;
static_assert(D_END <= RING_BYTES, "dilated LDS map");
__device__ __forceinline__ void dil_task(int p, int b, int h, int r, int m0, const bf16* PROJ, bf16* OPART, float* LSE, LAS unsigned char* shm, int wid, int lane) {
    const int r32 = lane & 31, hi = lane >> 5, sh = 2 * p;
    const long rowbase = (long)b * SEQ;
    const unsigned lds0 = (unsigned)(uintptr_t)shm;
    LAS float* wsf = (LAS float*)(shm + D_WS) + wid * 64;
    const LAS float* tbl = (const LAS float*)(shm + D_TB) + (p * 6 + h) * 192 + 32;
    const unsigned vslot0 = lds0 + D_V + wid * 8192;
    const int tq = r + ((m0 + r32) << sh);
    const bf16* Qw = PROJ + (rowbase + tq) * PP + C_QA + h * 64;
    bf16x8 qr[4];
#pragma unroll
    for (int d0 = 0; d0 < 4; ++d0) qr[d0] = *(const bf16x8*)(Qw + d0 * 16 + hi * 8);
    const int g0 = (4 - (m0 >> 5)) > 0 ? (4 - (m0 >> 5)) : 0;
    bf16x8 kc[4], kn[4];
#define DIL_LOADK(dst, g) do { const int ks_ = m0 - 128 + 32 * (g) + r32; const bf16* kp_ = PROJ + (rowbase + r + ((long)ks_ << sh)) * PP + C_KA + h * 64 + hi * 8; \
        _Pragma("unroll") for (int d0 = 0; d0 < 4; ++d0) dst[d0] = *(const bf16x8*)(kp_ + d0 * 16); } while (0)
#define DIL_LOADV(VD, g) do { _Pragma("unroll") for (int pc = 0; pc < 4; ++pc) { const int dh_ = pc >> 1, rg_ = pc & 1; const int ks_ = m0 - 128 + 32 * (g) + 16 * rg_ + (lane >> 2); \
            VD[pc] = *(const u32x4*)(PROJ + (rowbase + r + ((long)ks_ << sh)) * PP + C_VA + h * 64 + dh_ * 32 + (lane & 3) * 8); } } while (0)
#define DIL_STV(VS, g) do { _Pragma("unroll") for (int pc = 0; pc < 4; ++pc) *(LAS u32x4*)(shm + D_V + wid * 8192 + ((g) & 1) * 2048 + (pc >> 1) * 4096 + (pc & 1) * 1024 + lane * 16) = VS[pc]; } while (0)
    u32x4 vc[4], vn[4], vf[4]; bf16x8 kf[4];
    const int vb0 = (int)vslot0 + ((lane >> 4) & 1) * 32 + (lane & 3) * 8 + (4 * hi + ((lane & 15) >> 2)) * 64;
    SmState st; sm_init(st);
    DIL_LOADV(vc, g0); DIL_LOADK(kc, g0);
    if (g0 + 1 < 5) { DIL_LOADV(vn, g0 + 1); DIL_LOADK(kn, g0 + 1); } else { _Pragma("unroll") for (int d0 = 0; d0 < 4; ++d0) { kn[d0] = kc[d0]; vn[d0] = vc[d0]; } }
    for (int g = g0; g < 5; ++g) {
        if (g + 2 < 5) { DIL_LOADV(vf, g + 2); DIL_LOADK(kf, g + 2); } else { _Pragma("unroll") for (int d0 = 0; d0 < 4; ++d0) { kf[d0] = kn[d0]; vf[d0] = vn[d0]; } }
        DIL_STV(vc, g);
        float tb_[16];
        { const LAS float* lb = tbl + (128 - 32 * g) + r32 - 4 * hi - 27;
#pragma unroll
          for (int rr = 0; rr < 16; ++rr) tb_[rr] = lb[27 - ((rr & 3) + 8 * (rr >> 2))]; }
        ATT_SBAR();
        f32x16 p0;
#pragma unroll
        for (int d0 = 0; d0 < 4; ++d0) p0 = __builtin_amdgcn_mfma_f32_32x32x16_bf16(kc[d0], qr[d0], d0 == 0 ? st.negm : p0, 0, 0, 0);
        MFMA_FENCE1(p0);
        if (g == 0) {
#pragma unroll
            for (int rr = 0; rr < 16; ++rr) if (crow(rr, hi) < r32) p0[rr] = -INFINITY; }
        if (g == 4) {
#pragma unroll
            for (int rr = 0; rr < 16; ++rr) if (crow(rr, hi) > r32) p0[rr] = -INFINITY; }
#pragma unroll
        for (int rr = 0; rr < 16; ++rr) p0[rr] += tb_[rr];
        u32x4 pw0, pw1; sm_step32(st, p0, wsf, r32, hi, pw0, pw1);
        pv32(st.o, vb0 + (g & 1) * 2048, __builtin_bit_cast(bf16x8, pw0), __builtin_bit_cast(bf16x8, pw1));
#pragma unroll
        for (int d0 = 0; d0 < 4; ++d0) { kc[d0] = kn[d0]; kn[d0] = kf[d0]; vc[d0] = vn[d0]; vn[d0] = vf[d0]; }
    }
#undef DIL_LOADV
#undef DIL_LOADK
#undef DIL_STV
    bf16* orow0 = OPART + ((size_t)p * M + rowbase + r + ((long)m0 << sh)) * 384 + h * 64;
    const float lse = sm_finish(st, wsf, (LAS bf16*)(shm + D_OST) + wid * 2048, orow0, (long)384 << sh, lane, r32, hi);
    if (hi == 0) LSE[((size_t)(p * NB + b) * 6 + h) * SEQ + (size_t)r * (SEQ >> sh) + m0 + r32] = lse;
}

constexpr int DU_K = 0, DU_V = 49152, DU_WS = 98304, DU_OST = 0;
static_assert(DU_WS + 8 * 256 == D_TB && DU_V + 6 * 8192 == DU_WS, "dilated unit LDS map");
__device__ __forceinline__ int du_swz(int c) { return (c & 7) ^ ((c & 1) << 3); }
struct DuId { int p, b, h, r, m0u; };
__device__ __forceinline__ DuId du_decode(int id) { DuId d; const int x_ = id >> 16, i_ = id & 0xffff, bh_ = (i_ / 48) * 8 + x_, rem_ = i_ % 48; d.h = bh_ % H_DIL; d.b = bh_ / H_DIL; d.p = rem_ >> 4; const int uu = rem_ & 15, per = 16 >> (2 * d.p); d.r = uu / per; d.m0u = 256 * (uu % per); return d; }
constexpr int DU_NLOC = 3 * NB * 16 * H_DIL / 8;
struct DuRegs { u32x4 kv[6], vv[6]; bf16x8 qr[4]; };
__device__ __forceinline__ void du_load(DuRegs& R, const DuId& u, const bf16* PROJ, int wid, int lane) {
    const int r32 = lane & 31, hi = lane >> 5, sh = 2 * u.p; const long rowbase = (long)u.b * SEQ;
    const bf16* Qw = PROJ + (rowbase + u.r + ((long)(u.m0u + 32 * wid + r32) << sh)) * PP + C_QA + u.h * 64;
#pragma unroll
    for (int d0 = 0; d0 < 4; ++d0) R.qr[d0] = *(const bf16x8*)(Qw + d0 * 16 + hi * 8);
    const int t = wid * 64 + lane, row8 = t >> 3, c8 = t & 7;
#pragma unroll
    for (int n = 0; n < 6; ++n) { const int ks = u.m0u - 128 + n * 64 + row8;
        const bf16* src = PROJ + (rowbase + u.r + ((long)(ks < 0 ? 0 : ks) << sh)) * PP + u.h * 64 + c8 * 8;
        R.kv[n] = *(const u32x4*)(src + C_KA); R.vv[n] = *(const u32x4*)(src + C_VA); }
}
__device__ __forceinline__ void dil_units(unsigned* qctr, int myx, const bf16* PROJ, bf16* OPART, float* LSE, LAS unsigned char* shm, const int wid) {
    const int lane = lane_id(), r32 = lane & 31, hi = lane >> 5;
    const unsigned lds0 = (unsigned)(uintptr_t)shm;
    LAS float* wsf = (LAS float*)(shm + DU_WS) + wid * 64;
    volatile LAS unsigned* slot = (volatile LAS unsigned*)(shm + D_Q);
    int cur = wg_next8(qctr, DU_NLOC, myx, shm, D_Q, wid); if (cur < 0) return;
    int nxt = wg_next8(qctr, DU_NLOC, myx, shm, D_Q, wid);
    DuRegs R; du_load(R, du_decode(cur), PROJ, wid, lane);
    const bool t0 = wid == 0 && lane == 0;
    for (;;) {
        const DuId u = du_decode(cur); const int sh = 2 * u.p; const long rowbase = (long)u.b * SEQ;
        unsigned ahead = 0u; if (t0) ahead = q8_take(qctr, DU_NLOC, myx);
        { const int t = wid * 64 + lane, row8 = t >> 3, c8 = t & 7;
#pragma unroll
          for (int n = 0; n < 6; ++n) { const int i = n * 64 + row8, G = i >> 5, kk = i & 31;
              *(LAS u32x4*)(shm + DU_K + G * 4096 + c8 * 512 + ((kk ^ du_swz(c8)) * 16)) = R.kv[n];
              *(LAS u32x4*)(shm + DU_V + (G >> 1) * 8192 + (G & 1) * 2048 + (c8 >> 2) * 4096 + (kk >> 4) * 1024 + (kk & 15) * 64 + (c8 & 3) * 16) = R.vv[n]; } }
        bf16x8 qr[4];
#pragma unroll
        for (int d0 = 0; d0 < 4; ++d0) qr[d0] = R.qr[d0];
        asm volatile("s_nop 15\n\ts_waitcnt lgkmcnt(0)\n\ts_barrier" ::: "memory");
        if (nxt >= 0) du_load(R, du_decode(nxt), PROJ, wid, lane);
        const LAS float* tbl = (const LAS float*)(shm + D_TB) + (u.p * 6 + u.h) * 192 + 32;
        const int m0 = u.m0u + 32 * wid;
        const int g0 = (4 - (m0 >> 5)) > 0 ? (4 - (m0 >> 5)) : 0;
        const int vbl = (int)(lds0 + DU_V) + ((lane >> 4) & 1) * 32 + (lane & 3) * 8 + (4 * hi + ((lane & 15) >> 2)) * 64;
        SmState st; sm_init(st);
        for (int g = g0; g < 5; ++g) { const int G = wid + g;
            float tb_[16]; bf16x8 kf[4];
            { const LAS float* lb = tbl + (128 - 32 * g) + r32 - 4 * hi - 27;
#pragma unroll
              for (int rr = 0; rr < 16; ++rr) tb_[rr] = lb[27 - ((rr & 3) + 8 * (rr >> 2))]; }
#pragma unroll
            for (int d0 = 0; d0 < 4; ++d0) kf[d0] = *(const LAS bf16x8*)(shm + DU_K + G * 4096 + (2 * d0 + hi) * 512 + ((r32 ^ du_swz(2 * d0 + hi)) * 16));
            ATT_SBAR();
            f32x16 p0;
#pragma unroll
            for (int d0 = 0; d0 < 4; ++d0) p0 = __builtin_amdgcn_mfma_f32_32x32x16_bf16(kf[d0], qr[d0], d0 == 0 ? st.negm : p0, 0, 0, 0);
            V32 vf_; pv32_read(vf_, vbl + (G >> 1) * 8192 + (G & 1) * 2048);
            MFMA_FENCE1(p0);
            if (g == 0) {
#pragma unroll
                for (int rr = 0; rr < 16; ++rr) if (crow(rr, hi) < r32) p0[rr] = -INFINITY; }
            if (g == 4) {
#pragma unroll
                for (int rr = 0; rr < 16; ++rr) if (crow(rr, hi) > r32) p0[rr] = -INFINITY; }
#pragma unroll
            for (int rr = 0; rr < 16; ++rr) p0[rr] += tb_[rr];
            u32x4 pw0, pw1; sm_step32(st, p0, wsf, r32, hi, pw0, pw1);
            pv32_mma(st.o, vf_, __builtin_bit_cast(bf16x8, pw0), __builtin_bit_cast(bf16x8, pw1));
        }
        if (t0) slot[0] = ahead;
        asm volatile("s_nop 15\n\ts_waitcnt lgkmcnt(0)\n\ts_barrier" ::: "memory");
        const int nn = (int)__builtin_amdgcn_readfirstlane(slot[0]);
        bf16* orow0 = OPART + ((size_t)u.p * M + rowbase + u.r + ((long)m0 << sh)) * 384 + u.h * 64;
        const float lse = sm_finish(st, wsf, (LAS bf16*)(shm + DU_OST) + wid * 2048, orow0, (long)384 << sh, lane, r32, hi);
        if (hi == 0) LSE[((size_t)(u.p * NB + u.b) * 6 + u.h) * SEQ + (size_t)u.r * (SEQ >> sh) + m0 + r32] = lse;
        asm volatile("s_nop 15\n\ts_waitcnt lgkmcnt(0)\n\ts_barrier" ::: "memory");
        if (nxt < 0) break;
        cur = nxt; nxt = nn;
    }
}
}

__device__ __forceinline__ int ilv32(int n) { return n < 16 ? 2 * n : 2 * (n - 16) + 1; }
__device__ __forceinline__ void tr_item(const float* W, int N, const float* gain, float cscale, bf16* WT, int ldt, int dcol, int drow, bool il, LAS float* scr, int k0, int n0, int lane) {
    { f32x4 v[8]; float gsc[8];
#pragma unroll
      for (int i = 0; i < 8; ++i) { const int kk = 8 * i + (lane >> 3); v[i] = __builtin_nontemporal_load((const f32x4*)(W + (size_t)(k0 + kk) * N + n0 + 4 * (lane & 7))); gsc[i] = (gain ? gain[k0 + kk] : 1.0f) * cscale; }
#pragma unroll
      for (int i = 0; i < 8; ++i) { const int kk = 8 * i + (lane >> 3); LAS float* d = scr + kk * 33 + 4 * (lane & 7); d[0] = v[i][0] * gsc[i]; d[1] = v[i][1] * gsc[i]; d[2] = v[i][2] * gsc[i]; d[3] = v[i][3] * gsc[i]; } }
    LDS_WAIT(); asm volatile("" ::: "memory");
    const int c = lane & 7;
#pragma unroll
    for (int j = 0; j < 4; ++j) { const int n = (lane >> 3) + 8 * j; const LAS float* s = scr + (8 * c) * 33 + n;
        u32x4 o; o.x = cvt_pk_bf16(s[0 * 33], s[1 * 33]); o.y = cvt_pk_bf16(s[2 * 33], s[3 * 33]); o.z = cvt_pk_bf16(s[4 * 33], s[5 * 33]); o.w = cvt_pk_bf16(s[6 * 33], s[7 * 33]);
        const int dr = drow + (il ? ilv32(n) : n);
        *(u32x4*)(WT + (size_t)dr * ldt + dcol + k0 + 8 * c) = o; }
    LDS_WAIT(); asm volatile("" ::: "memory");
}
__device__ __forceinline__ void tr_item8(const float* W, int N, float cscale, unsigned char* WT, int ldt, int drow, LAS float* scr, int k0, int n0, int lane) {
    { f32x4 v[8];
#pragma unroll
      for (int i = 0; i < 8; ++i) { const int kk = 8 * i + (lane >> 3); v[i] = __builtin_nontemporal_load((const f32x4*)(W + (size_t)(k0 + kk) * N + n0 + 4 * (lane & 7))); }
#pragma unroll
      for (int i = 0; i < 8; ++i) { const int kk = 8 * i + (lane >> 3); LAS float* d = scr + kk * 33 + 4 * (lane & 7); d[0] = v[i][0] * cscale; d[1] = v[i][1] * cscale; d[2] = v[i][2] * cscale; d[3] = v[i][3] * cscale; } }
    LDS_WAIT(); asm volatile("" ::: "memory");
    const int c = lane & 7;
#pragma unroll
    for (int j = 0; j < 4; ++j) { const int n = (lane >> 3) + 8 * j; const LAS float* sp = scr + (8 * c) * 33 + n;
        u32x2 o; o.x = pg8::pk4_fp8((f32x4){sp[0 * 33], sp[1 * 33], sp[2 * 33], sp[3 * 33]}); o.y = pg8::pk4_fp8((f32x4){sp[4 * 33], sp[5 * 33], sp[6 * 33], sp[7 * 33]});
        *(u32x2*)(WT + (size_t)(drow + n) * ldt + k0 + 8 * c) = o; }
    LDS_WAIT(); asm volatile("" ::: "memory");
}
__device__ __forceinline__ int t5_bucket(int n) {
    if (n < 16) return n;
    int large = 16 + (int)(log2f((float)n * (1.0f / 16.0f)) * (16.0f / 7.0f));
    return large < 31 ? large : 31;
}

struct Args { const float* in[14]; float* out; unsigned char* ws; int ph_lo, ph_hi, li, pad; };

__global__ void __launch_bounds__(NWAVES * 64, 2) mk_fwd(Args args) {
    extern __shared__ __attribute__((aligned(16))) unsigned char lds_raw[];
    LAS unsigned char* lds0 = (LAS unsigned char*)lds_raw;
    volatile LAS unsigned* MISC = (volatile LAS unsigned*)(lds0 + MISC_OFF);
    const int wave0 = __builtin_amdgcn_readfirstlane((int)threadIdx.x >> 6);
#define PHASE_LOCALS \
    int z_; asm volatile("s_mov_b32 %0, 0" : "=s"(z_)); const int wave = wave0 + z_; \
    GAS unsigned char* wsg_ = (GAS unsigned char*)args.ws; GAS float* outg_ = (GAS float*)args.out; asm volatile("" : "+s"(wsg_), "+s"(outg_));     \
    unsigned char* ws = (unsigned char*)wsg_; const int G = (int)gridDim.x + z_; float* out = (float*)outg_; LAS unsigned char* lds = lds0 + z_; (void)lds; \
    const int bid = (int)blockIdx.x + z_; const int gw = bid * NWAVES + wave, NGW = G * NWAVES, NGT = NGW * 64; (void)bid; \
    unsigned* ctl = (unsigned*)(ws + WS_CTL); float* ssq_all = (float*)(ws + WS_SSQ); const f32x2* rope_cs = (const f32x2*)(ws + WS_ROPE); \
    float* tmoba = (float*)(ws + WS_TMOBA); float* tdil = (float*)(ws + WS_TDIL); float* kmean = (float*)(ws + WS_KMEAN); \
    bf16* XB = (bf16*)(ws + WS_XB); bf16* PROJ = (bf16*)(ws + WS_PROJ); bf16* QM = (bf16*)(ws + WS_QM); bf16* OB = (bf16*)(ws + WS_O); bf16* UB = (bf16*)(ws + WS_U); \
    (void)out; (void)gw; (void)NGW; (void)NGT; (void)ctl; (void)ssq_all; (void)rope_cs; (void)tmoba; (void)tdil; (void)kmean; (void)XB; (void)PROJ; (void)QM; (void)OB; (void)UB
#define LAYER_LOCALS PHASE_LOCALS; const int lz_ = l + z_; unsigned char* wl = ws + WS_W + (size_t)lz_ * W_STRIDE; float* ssq_x = ssq_all; float* ssq_c = ssq_all + (size_t)M * 16; float* ssq_mlp = ssq_all + (size_t)M * 32; \
    (void)wl; (void)ssq_x; (void)ssq_c; (void)ssq_mlp
    unsigned* ctl0 = (unsigned*)(args.ws + WS_CTL);
    for (int u = wave0 * 64 + lane_id(); u < (LDS_BYTES - LDSCTL_OFF) / 4; u += NWAVES * 64) ((LAS unsigned*)(lds0 + LDSCTL_OFF))[u] = 0u;
    __syncthreads();
    XcdBarrier bar; bar.bar = ctl0 + CW_BAR + args.li * XCD_BAR_WORDS; bar.x = 0; bar.st = nullptr;
    if (!MK_PER_PHASE) bar = xcd_barrier_post(ctl0 + CW_BAR + args.li * XCD_BAR_WORDS, MISC + 8, wave0 == 0 && lane_id() == 0);
    const int lo = MK_PER_PHASE ? args.ph_lo : 0, hi = MK_PER_PHASE ? args.ph_hi : N_PHASES;
#define IN(k) (lo <= (k) && (k) < hi)
#define SEAM(k) do { if (IN(k) && IN((k) + 1)) xcd_barrier(bar, wave0 == 0 && lane_id() == 0); } while (0)

    if (IN(0)) {
        PHASE_LOCALS; const float* x_in = args.in[0];
        const int lane = lane_id(), gt = bid * (NWAVES * 64) + wave * 64 + lane;
        LAS float* scr = (LAS float*)(lds + wave * 16384);
        constexpr int I_IN = 16 * 77, I_UQ = 6 * 18, I_UKV = 2 * 24, I_O = 16 * 32, I_UP = 16 * 128, I_DN = 64 * 32, I_L = I_IN + I_UQ + I_UKV + I_O + I_UP + I_DN;
        for (int it = gw; it < DEPTH * I_L; it += NGW) {
            const int l = it / I_L; int r = it % I_L;
            unsigned char* wl = ws + WS_W + (size_t)l * W_STRIDE;
            if (r < I_IN) { const int kb = r / 77, nb = r % 77, n0 = 32 * nb;
                int drow = n0; bool il = false; float sc = 1.0f;
                if (n0 < 384) sc = QS_64;
                else if (n0 == 1664) il = true;
                else if (n0 >= 1696) { drow = n0 + 32; if (n0 < 1952) sc = QS_64; }
                tr_item(args.in[2] + (size_t)l * DM * DIN, DIN, args.in[1] + l * DM, sc, (bf16*)(wl + W_IN), DM, 0, drow, il, scr, 64 * kb, n0, lane); continue; }
            r -= I_IN;
            if (r < I_UQ) { const int kb = r / 18, nb = r % 18, n0 = 32 * nb, h = n0 / 96, rr = n0 % 96;
                const int drow = (rr < 64) ? (Q_NOPE + 64 * h + rr) : (Q_ROPE + 32 * h);
                tr_item(args.in[5] + (size_t)l * 384 * 576, 576, args.in[3] + l * 384, QS_96, (bf16*)(wl + W_MLA), 512, 0, drow, rr == 64, scr, 64 * kb, n0, lane); continue; }
            r -= I_UQ;
            if (r < I_UKV) { const int kb = r / 24, nb = r % 24, n0 = 32 * nb;
                tr_item(args.in[6] + (size_t)l * 128 * 768, 768, args.in[4] + l * 128, 1.0f, (bf16*)(wl + W_MLA), 512, 384, Q_KV + n0, false, scr, 64 * kb, n0, lane); continue; }
            r -= I_UKV;
            if (r < I_O) { const int kb = r / 32, nb = r % 32;
                tr_item(args.in[9] + (size_t)l * DM * DM, DM, args.in[8] + l * DM, 1.0f, (bf16*)(wl + W_O), DM, 0, 32 * nb, false, scr, 64 * kb, 32 * nb, lane); continue; }
            r -= I_O;
            if (r < I_UP) { const int kb = r / 128, nb = r % 128;
                tr_item(args.in[11] + (size_t)l * DM * DFF, DFF, args.in[10] + l * DM, 1.0f, (bf16*)(wl + W_UP), DM, 0, 32 * nb, false, scr, 64 * kb, 32 * nb, lane); continue; }
            r -= I_UP;
            { const int kb = r % 64, nb = r / 64;
#if FP8_DOWN
                tr_item8(args.in[12] + (size_t)l * DFF * DM, DM, 64.0f, (unsigned char*)(wl + W_DOWN), DFF, 32 * nb, scr, 64 * kb, 32 * nb, lane); }
#else
                tr_item(args.in[12] + (size_t)l * DFF * DM, DM, nullptr, 1.0f, (bf16*)(wl + W_DOWN), DFF, 0, 32 * nb, false, scr, 64 * kb, 32 * nb, lane); }
#endif
        }
        for (int it = gt; it < DEPTH * (96 * 128 + 1536 * 64); it += NGT) {
            const int l = it / (96 * 128 + 1536 * 64); int r = it % (96 * 128 + 1536 * 64);
            unsigned char* wl = ws + WS_W + (size_t)l * W_STRIDE;
            if (r < 96 * 128) { const int rr = r / 128, ch = r % 128; const int row = rr < 32 ? 1696 + rr : 2496 + (rr - 32);
                *(u32x4*)((bf16*)(wl + W_IN) + (size_t)row * DM + ch * 8) = (u32x4){0u, 0u, 0u, 0u}; }
            else { r -= 96 * 128; const int row = r / 64, ch = r % 64; const int col = ch * 8;
                const bool data = (row < 576 && col < 384) || (row >= 768 && col >= 384);
                if (!data) *(u32x4*)((bf16*)(wl + W_MLA) + (size_t)row * 512 + col) = (u32x4){0u, 0u, 0u, 0u}; }
        }
        for (int it = gt; it < SEQ * 16; it += NGT) { const int t = it >> 4, i = it & 15;
            const float inv_freq = exp2f(-(float)i * (13.287712379549449f / 16.0f));
            const float ang = (float)t * inv_freq;
            double rev = (double)ang * 0.15915494309189535; rev -= floor(rev); const float rv = (float)rev;
            ((f32x2*)(ws + WS_ROPE))[it] = (f32x2){__builtin_amdgcn_cosf(rv), __builtin_amdgcn_sinf(rv)}; }
        const float* rel_bias = args.in[7];
        for (int it = gt; it < 4 * 4096; it += NGT) { const int h = it >> 12, d = it & 4095; tmoba[it] = rel_bias[t5_bucket(d) * 10 + 6 + h] * LOG2E; }
        for (int it = gt; it < 3 * 6 * 192; it += NGT) { const int p = it / (6 * 192), h = (it / 192) % 6, d = it % 192 - 32; const int dil = p == 0 ? 1 : (p == 1 ? 4 : 16);
            tdil[it] = (d >= 0 && d <= 128) ? rel_bias[t5_bucket(d * dil) * 10 + h] * LOG2E : 0.f; }
        for (int g32 = bid; g32 < M / 32; g32 += G) { const int m0 = g32 * 32 + 4 * wave;
            f32x4 v[4][4]; float s[4];
#pragma unroll
            for (int q = 0; q < 4; ++q) { const f32x4* xr = (const f32x4*)(x_in + (size_t)(m0 + q) * DM) + 2 * lane;
#pragma unroll
                for (int j = 0; j < 2; ++j) { v[q][2 * j] = __builtin_nontemporal_load(xr + 128 * j); v[q][2 * j + 1] = __builtin_nontemporal_load(xr + 128 * j + 1); } }
#pragma unroll
            for (int q = 0; q < 4; ++q) { const int m = m0 + q;
                s[q] = 0.f;
#pragma unroll
                for (int j = 0; j < 4; ++j) s[q] += (v[q][j][0] * v[q][j][0] + v[q][j][1] * v[q][j][1]) + (v[q][j][2] * v[q][j][2] + v[q][j][3] * v[q][j][3]);
                s[q] = wave_sum(s[q]);
                u32x4* o16 = (u32x4*)(XB + (size_t)m * DM) + lane;
#pragma unroll
                for (int j = 0; j < 2; ++j) { u32x4 w; w.x = cvt_pk_bf16(v[q][2 * j][0], v[q][2 * j][1]); w.y = cvt_pk_bf16(v[q][2 * j][2], v[q][2 * j][3]);
                    w.z = cvt_pk_bf16(v[q][2 * j + 1][0], v[q][2 * j + 1][1]); w.w = cvt_pk_bf16(v[q][2 * j + 1][2], v[q][2 * j + 1][3]); o16[64 * j] = w; } }
            { const int q_ = lane & 3, sl = lane >> 2; const float sv = q_ == 0 ? s[0] : (q_ == 1 ? s[1] : (q_ == 2 ? s[2] : s[3]));
              ssq_all[(size_t)sl * M + m0 + q_] = sl == 0 ? sv : 0.f; }
        }
    }
    SEAM(0);

    for (int l = 0; l < DEPTH; ++l) {
        const int pb = 1 + 7 * l;
        if (pb + 7 <= lo || pb >= hi) continue;

        if (IN(pb + 0)) {
            LAYER_LOCALS;
            pg8::Gemm g{XB, (const bf16*)(wl + W_IN), M, PP, DM, DM}; pg8::StaticOrder S; S.init(M, PP, G, bid);
            pg8::stage_rs<0>((LAS float*)(lds + RS_OFF), ssq_x, S, wave);
            pg8::EpiProj E{PROJ, ssq_x, ssq_c, rope_cs};
            pg8::gemm_phase<pg8::EpiProj>(lds, g, S, E, wave);
        }
        SEAM(pb + 0);
        if (IN(pb + 1)) {
            LAYER_LOCALS;
            pg8::Gemm g{PROJ + C_CQ, (const bf16*)(wl + W_MLA), M, QP, 512, PP}; pg8::MlaOrder S{G == 256 ? bid : (bid == 0 ? 0 : 256)};
            pg8::stage_rs<1>((LAS float*)(lds + RS_OFF), ssq_c, S, wave);
            pg8::EpiMla E{QM, ssq_c, rope_cs};
            pg8::gemm_phase<pg8::EpiMla, false, pg8::MlaOrder>(lds, g, S, E, wave);
            { const int ln = lane_id();
              for (int it = gw; it < NB * 16 * H_MOBA; it += NGW) { const int blk = it >> 2, h = it & 3;
                  const bf16* p = PROJ + ((size_t)blk * 256 + (ln >> 3)) * PP + C_KC + h * 64 + (ln & 7) * 8; float a[8];
#pragma unroll
                  for (int e = 0; e < 8; ++e) a[e] = 0.f;
#pragma unroll 8
                  for (int i = 0; i < 32; ++i) { const u32x4 v = *(const u32x4*)(p + (size_t)i * 8 * PP);
                      a[0] += bf_lo(v.x); a[1] += bf_hi(v.x); a[2] += bf_lo(v.y); a[3] += bf_hi(v.y); a[4] += bf_lo(v.z); a[5] += bf_hi(v.z); a[6] += bf_lo(v.w); a[7] += bf_hi(v.w); }
#pragma unroll
                  for (int e = 0; e < 8; ++e) { a[e] += swz_xor<8>(a[e]); a[e] += swz_xor<16>(a[e]); a[e] = xsum32(a[e]); }
                  if (ln < 8) { float* o = kmean + (size_t)it * 64 + ln * 8;
                      *(f32x4*)o = (f32x4){a[0], a[1], a[2], a[3]} * (1.0f / 256.0f); *(f32x4*)(o + 4) = (f32x4){a[4], a[5], a[6], a[7]} * (1.0f / 256.0f); } } }
        }
        SEAM(pb + 1);
        if (IN(pb + 2)) {
            LAYER_LOCALS;
            const int myx = (int)(xb_xcc_id() & 7u);
            { unsigned* qctr8 = ctl + CW_Q + 64 * (16 + (2 * l + 1) * 8);
              for (;;) { const int r = att::wg_next8(qctr8, (NB * H_MOBA / 8) * 16, myx, lds, att::L_Q, wave); if (r < 0) break;
                  const int x = r >> 16, i = r & 0xffff, j = 15 - i / (NB * H_MOBA / 8), bh = (i % (NB * H_MOBA / 8)) * 8 + x; att::moba_unit(bh / H_MOBA, bh % H_MOBA, j, PROJ, kmean, tmoba, OB, ssq_c, lds, wave); } }
            { unsigned* qctr8 = ctl + CW_Q + 64 * (16 + (2 * l + 0) * 8);
              for (;;) { const int r = att::wg_next8(qctr8, (NB * H_MLA / 8) * 16, myx, lds, att::L_Q, wave); if (r < 0) break;
                  const int x = r >> 16, i = r & 0xffff, qb = 15 - i / (NB * H_MLA / 8), bh = (i % (NB * H_MLA / 8)) * 8 + x; att::mla_unit2(bh / H_MLA, bh % H_MLA, qb, QM, PROJ, OB, ssq_c, lds, wave); } }
            { unsigned* qctr = ctl + CW_Q + 64 * (3 * l + 2);
              asm volatile("s_nop 15\n\ts_waitcnt vmcnt(0) lgkmcnt(0)\n\ts_barrier" ::: "memory");
              { const int t2 = wave * 64 + lane_id(); for (int i = t2; i < 3 * 6 * 192; i += NWAVES * 64) ((LAS float*)(lds + att::D_TB))[i] = tdil[i]; }
              asm volatile("s_nop 15\n\ts_waitcnt vmcnt(0) lgkmcnt(0)\n\ts_barrier" ::: "memory");
              const int ln = lane_id();
              (void)ln; (void)qctr; att::dil_units(ctl + CW_Q + 64 * (80 + 8 * l), myx, PROJ, (bf16*)out, (float*)((unsigned char*)out + 72 * MiB), lds, wave); }
        }
        SEAM(pb + 2);
        if (IN(pb + 3)) {
            LAYER_LOCALS;
            const int lane = lane_id();
            float* rowsc = (float*)(ws + WS_ROWSC);
            for (int m = gw; m < M; m += NGW) {
                float f0[8]; float s0 = 0.f;
                if (lane < 48) {
                    const bf16* op = (const bf16*)out + (size_t)m * 384 + 8 * lane; const float* lp = (const float*)((const unsigned char*)out + 72 * MiB); const int hh_ = lane >> 3, bb_ = m >> 12, tt_ = m & (SEQ - 1);
                    const u32x4 a0 = *(const u32x4*)op, a1 = *(const u32x4*)(op + (size_t)M * 384), a2 = *(const u32x4*)(op + (size_t)2 * M * 384);
                    const float l0 = lp[((size_t)(0 * NB + bb_) * 6 + hh_) * SEQ + tt_],
                                l1 = lp[((size_t)(1 * NB + bb_) * 6 + hh_) * SEQ + (size_t)(tt_ & 3) * (SEQ >> 2) + (tt_ >> 2)],
                                l2 = lp[((size_t)(2 * NB + bb_) * 6 + hh_) * SEQ + (size_t)(tt_ & 15) * (SEQ >> 4) + (tt_ >> 4)]; const float mx = fmaxf(l0, fmaxf(l1, l2));
                    float w0 = exp2f(l0 - mx), w1 = exp2f(l1 - mx), w2 = exp2f(l2 - mx); const float iw = 1.0f / (w0 + w1 + w2); w0 *= iw; w1 *= iw; w2 *= iw;
                    f0[0] = w0 * bf_lo(a0.x) + w1 * bf_lo(a1.x) + w2 * bf_lo(a2.x); f0[1] = w0 * bf_hi(a0.x) + w1 * bf_hi(a1.x) + w2 * bf_hi(a2.x);
                    f0[2] = w0 * bf_lo(a0.y) + w1 * bf_lo(a1.y) + w2 * bf_lo(a2.y); f0[3] = w0 * bf_hi(a0.y) + w1 * bf_hi(a1.y) + w2 * bf_hi(a2.y);
                    f0[4] = w0 * bf_lo(a0.z) + w1 * bf_lo(a1.z) + w2 * bf_lo(a2.z); f0[5] = w0 * bf_hi(a0.z) + w1 * bf_hi(a1.z) + w2 * bf_hi(a2.z);
                    f0[6] = w0 * bf_lo(a0.w) + w1 * bf_lo(a1.w) + w2 * bf_lo(a2.w); f0[7] = w0 * bf_hi(a0.w) + w1 * bf_hi(a1.w) + w2 * bf_hi(a2.w);
                    u32x4 w; w.x = cvt_pk_bf16(f0[0], f0[1]); w.y = cvt_pk_bf16(f0[2], f0[3]); w.z = cvt_pk_bf16(f0[4], f0[5]); w.w = cvt_pk_bf16(f0[6], f0[7]);
                    *((u32x4*)(OB + (size_t)m * DM) + lane) = w;
                    s0 = bf_lo(w.x) * bf_lo(w.x) + bf_hi(w.x) * bf_hi(w.x) + bf_lo(w.y) * bf_lo(w.y) + bf_hi(w.y) * bf_hi(w.y) + bf_lo(w.z) * bf_lo(w.z) + bf_hi(w.z) * bf_hi(w.z) + bf_lo(w.w) * bf_lo(w.w) + bf_hi(w.w) * bf_hi(w.w);
                }
                const float sa = wave_sum(s0);
                if (lane == 0) { float qs[10];
#pragma unroll
                    for (int i = 0; i < 10; ++i) qs[i] = ssq_c[(size_t)i * M + m];
                    const float sb = ((qs[0] + qs[1]) + (qs[2] + qs[3])) + (qs[4] + qs[5]), sc = (qs[6] + qs[7]) + (qs[8] + qs[9]);
                    const float ra = rsqrtf(sa * (1.0f / 384.0f) + EPS), rb_ = rsqrtf(sb * (1.0f / 384.0f) + EPS), rc = rsqrtf(sc * (1.0f / 256.0f) + EPS);
                    *(f32x4*)(rowsc + (size_t)m * 4) = (f32x4){ra / rb_, rb_ / rc, rc, 0.f}; }
            }
        }
        SEAM(pb + 3);
        if (IN(pb + 4)) {
            LAYER_LOCALS;
            pg8::Gemm g{OB, (const bf16*)(wl + W_O), M, DM, DM, DM}; pg8::StaticOrder S; S.init(M, DM, G, bid);
            { const float* rowsc = (const float*)(ws + WS_ROWSC); LAS float* rst = (LAS float*)(lds + RS_OFF); const int t = wave * 64 + lane_id(); pg8::Unit uu;
              for (int i = 0; i < 2 && S.next(i, uu); ++i) if (t < 256) *(LAS f32x4*)(rst + (i * 256 + t) * 4) = *(const f32x4*)(rowsc + (size_t)(uu.pm * 256 + t) * 4);
              asm volatile("s_nop 15\n\ts_waitcnt vmcnt(0) lgkmcnt(0)\n\ts_barrier" ::: "memory"); }
            pg8::EpiRes<true> E{XB, ssq_mlp, 1.0f};
            pg8::gemm_phase<pg8::EpiRes<true>, false, pg8::StaticOrder, true>(lds, g, S, E, wave);
        }
        SEAM(pb + 4);
        if (IN(pb + 5)) {
            LAYER_LOCALS;
            pg8::Gemm g{XB, (const bf16*)(wl + W_UP), M, DFF, DM, DM}; pg8::StaticOrder S; S.init(M, DFF, G, bid);
            pg8::stage_rs<0>((LAS float*)(lds + RS_OFF), ssq_mlp, S, wave);
#if FP8_DOWN
            pg8::EpiUp8 E{(unsigned char*)UB, ssq_mlp};
            pg8::gemm_phase<pg8::EpiUp8>(lds, g, S, E, wave);
#else
            pg8::EpiUp E{UB, ssq_mlp};
            pg8::gemm_phase<pg8::EpiUp>(lds, g, S, E, wave);
#endif
        }
        SEAM(pb + 5);
        if (IN(pb + 6)) {
            LAYER_LOCALS;
            pg8::Gemm g{UB, (const bf16*)(wl + W_DOWN), M, DM, DFF, DFF}; pg8::StaticOrder S; S.init(M, DM, G, bid);
#if FP8_DOWN
            pg8::EpiRes<false> E{XB, ssq_x, 1.0f / 512.0f};
            pg8::gemm_phase<pg8::EpiRes<false>, true>(lds, g, S, E, wave);
#else
            pg8::EpiRes<false> E{XB, ssq_x, 1.0f};
            pg8::gemm_phase<pg8::EpiRes<false>>(lds, g, S, E, wave);
#endif
        }
        SEAM(pb + 6);
    }
    if (IN(29)) {
        PHASE_LOCALS;
        const float* ssq_f = ssq_all; const float* gf = args.in[13];
        const int lane = lane_id();
        for (int m = gw; m < M; m += NGW) {
            const float rs = rsqrtf(ssq16(ssq_f + m, (size_t)M) * (1.0f / DM) + EPS);
#pragma unroll
            for (int j = 0; j < 2; ++j) { const int c = 8 * (lane + 64 * j); const u32x4 v = *(const u32x4*)(XB + (size_t)m * DM + c);
                const f32x4 ga = *(const f32x4*)(gf + c), gb = *(const f32x4*)(gf + c + 4);
                f32x4 oa = (f32x4){bf_lo(v.x), bf_hi(v.x), bf_lo(v.y), bf_hi(v.y)} * rs * ga, ob = (f32x4){bf_lo(v.z), bf_hi(v.z), bf_lo(v.w), bf_hi(v.w)} * rs * gb;
                *(f32x4*)(out + (size_t)m * DM + c) = oa; *(f32x4*)(out + (size_t)m * DM + c + 4) = ob; }
        }
    }
#undef IN
#undef SEAM
}

extern "C" void kernel_launch(void* const* d_in, const int* in_sizes, int n_in, void* d_out, int out_size, void* d_ws, size_t ws_size, hipStream_t stream) {
    static int grid = 0;
    if (grid == 0) {
        if (n_in != 14 || in_sizes[0] != M * DM || out_size != M * DM || ws_size < WS_END) { fprintf(stderr, "kernel_launch: unexpected shapes (n_in %d, in0 %d, out %d, ws %zu); nothing launched\n", n_in, n_in > 0 ? in_sizes[0] : -1, out_size, ws_size); grid = -1; return; }
        int dev = 0, cus = 0, per_cu = 0;
        if (hipGetDevice(&dev) != hipSuccess || hipDeviceGetAttribute(&cus, hipDeviceAttributeMultiprocessorCount, dev) != hipSuccess) { grid = -1; return; }
        if (hipFuncSetAttribute((const void*)mk_fwd, hipFuncAttributeMaxDynamicSharedMemorySize, LDS_BYTES) != hipSuccess) { fprintf(stderr, "kernel_launch: hipFuncSetAttribute failed\n"); grid = -1; return; }
        if (hipOccupancyMaxActiveBlocksPerMultiprocessor(&per_cu, (const void*)mk_fwd, NWAVES * 64, LDS_BYTES) != hipSuccess || per_cu < 1)
            fprintf(stderr, "kernel_launch: note: occupancy query reports %d workgroups per CU\n", per_cu);
        (void)hipGetLastError();
        grid = cus;
    }
    if (grid < 0) return;
    if (hipMemsetAsync((char*)d_ws + WS_CTL, 0, CTL_ZERO_BYTES, stream) != hipSuccess) { fprintf(stderr, "kernel_launch: memset failed\n"); return; }
    Args a{};
    for (int i = 0; i < 14; ++i) a.in[i] = (const float*)d_in[i];
    a.out = (float*)d_out; a.ws = (unsigned char*)d_ws; a.pad = 0;
#if MK_PER_PHASE
    for (int p = 0; p < N_PHASES; ++p) { a.ph_lo = p; a.ph_hi = p + 1; a.li = 0;
        hipLaunchKernelGGL(mk_fwd, dim3(grid), dim3(NWAVES * 64), LDS_BYTES, stream, a); }
#else
    a.ph_lo = 0; a.ph_hi = N_PHASES; a.li = 0;
    hipLaunchKernelGGL(mk_fwd, dim3(grid), dim3(NWAVES * 64), LDS_BYTES, stream, a);
#endif
    const hipError_t le = hipPeekAtLastError();
    if (le != hipSuccess) fprintf(stderr, "kernel_launch: launch failed: %s\n", hipGetErrorName(le));
}
```
